# Optimizing an MI355X kernel written in HIP

```python
import jax, jax.numpy as jnp
from jax import lax
import numpy as np

D_MODEL = 2048
BATCH = 4
SEQ = 4096
DEPTH = 1

GRID_W = 64
CTX_LEN = 256
NORM_EPS = 1e-6

HEAD_WIDTH = 128
MLA_HEADS = D_MODEL // (2 * HEAD_WIDTH)
MLA_Q_RANK = D_MODEL // 4
MLA_KV_RANK = D_MODEL // 8
MLA_NOPE = 128
MLA_ROPE = 64
MLA_V = HEAD_WIDTH
MLA_QK = MLA_NOPE + MLA_ROPE
MLA_SCALE = MLA_QK ** -0.5
Q_BLOCK = 128
ROPE_THETA = 10000.0
HG_HEADS = D_MODEL // (2 * HEAD_WIDTH)
HG_DK = 128
HG_DV = HEAD_WIDTH
HG_CHUNK = 64

MIX_WIDTH = MLA_HEADS * MLA_V + HG_HEADS * HG_DV
IN_SPLITS = (MLA_Q_RANK, MLA_KV_RANK, MLA_ROPE, HG_HEADS * HG_DK, HG_HEADS * HG_DK, HG_HEADS * HG_DK, HG_HEADS * HG_DV, HG_HEADS * HG_DV)
IN_COLS = MLA_Q_RANK + MLA_KV_RANK + MLA_ROPE + 3 * HG_HEADS * HG_DK + 2 * HG_HEADS * HG_DV

N_EXPERTS = 32
TOP_K = 4
D_FF = D_MODEL
SWIGLU_LIMIT = 7.0
SWIGLU_ALPHA = 1.702
MOE_BLOCK = 128

kernel_name = "hybrid_mla_hgrn2_moe_dit_block"


def rms_norm(x, w):
    xf = x.astype(jnp.float32)
    y = xf * lax.rsqrt(jnp.mean(xf * xf, axis=-1, keepdims=True) + NORM_EPS)
    return (y * w.astype(jnp.float32)).astype(x.dtype)


def modulate(x, shift, scale):
    return x * (1.0 + scale) + shift


def split_cols(p):
    out, start = [], 0
    for size in IN_SPLITS:
        out.append(p[..., start:start + size])
        start += size
    return out


def axial_rope(rows):
    r, cl = jnp.meshgrid(jnp.arange(rows), jnp.arange(GRID_W), indexing="ij")
    r = r.reshape(-1).astype(jnp.float32)
    cl = cl.reshape(-1).astype(jnp.float32)
    n_freq = MLA_ROPE // 4
    inv = ROPE_THETA ** (-jnp.arange(n_freq, dtype=jnp.float32) / n_freq)
    ang = jnp.concatenate([r[:, None] * inv, cl[:, None] * inv], axis=-1)
    return jnp.cos(ang), jnp.sin(ang)


def apply_rope(x, cos, sin):
    xf = x.astype(jnp.float32)
    x1, x2 = xf[..., :MLA_ROPE // 2], xf[..., MLA_ROPE // 2:]
    return jnp.concatenate([x1 * cos - x2 * sin, x1 * sin + x2 * cos], axis=-1).astype(x.dtype)


def mla_keys(ckv_raw, kr_raw, kv_norm, w_ukv, cos, sin):
    ckv = rms_norm(ckv_raw, kv_norm)
    kv = jnp.einsum("bnr,rhe->bnhe", ckv, w_ukv)
    k_nope, v = kv[..., :MLA_NOPE], kv[..., MLA_NOPE:]
    k_rope = kr_raw if cos is None else apply_rope(kr_raw, cos, sin)
    return k_nope, k_rope, v


def mla_queries(cq_raw, q_norm, w_uq, cos, sin):
    cq = rms_norm(cq_raw, q_norm)
    q = jnp.einsum("bnr,rhe->bnhe", cq, w_uq)
    q_nope, q_rope = q[..., :MLA_NOPE], q[..., MLA_NOPE:]
    if cos is not None:
        q_rope = apply_rope(q_rope, cos[:, None, :], sin[:, None, :])
    return q_nope, q_rope


def block_attn(q_nope, q_rope, k_nope, k_rope, v):
    s = (jnp.einsum("bqhe,bkhe->bhqk", q_nope, k_nope)
         + jnp.einsum("bqhe,bke->bhqk", q_rope, k_rope)).astype(jnp.float32) * MLA_SCALE
    p = jax.nn.softmax(s, axis=-1).astype(v.dtype)
    return jnp.einsum("bhqk,bkhe->bqhe", p, v)


def latent_attention(q_nope, q_rope, k_nope, k_rope, v):
    B, N = q_nope.shape[:2]
    nb = N // Q_BLOCK
    qn = q_nope.reshape(B, nb, Q_BLOCK, MLA_HEADS, MLA_NOPE).swapaxes(0, 1)
    qr = q_rope.reshape(B, nb, Q_BLOCK, MLA_HEADS, MLA_ROPE).swapaxes(0, 1)
    out = lax.map(lambda qs: block_attn(qs[0], qs[1], k_nope, k_rope, v), (qn, qr))
    return out.swapaxes(0, 1).reshape(B, N, MLA_HEADS * MLA_V)


def hgrn_chunk_scan(q, k, v, g, s0):
    B, N, H, DK = q.shape
    DV = v.shape[-1]
    nc = N // HG_CHUNK

    def to_chunks(a):
        return a.reshape(B, nc, HG_CHUNK, H, a.shape[-1]).transpose(1, 0, 3, 2, 4)

    lower = jnp.tril(jnp.ones((HG_CHUNK, HG_CHUNK), dtype=bool))[:, :, None]

    def step(S, xs):
        qc, kc, vc, gc = xs
        b = jnp.cumsum(gc, axis=2)
        b_last = b[:, :, -1:, :]
        o_inter = jnp.einsum("bhtd,bhde->bhte", qc * jnp.exp(b), S)
        rel = jnp.exp(jnp.where(lower, b[:, :, :, None, :] - b[:, :, None, :, :], -jnp.inf))
        scores = jnp.einsum("bhtd,bhsd,bhtsd->bhts", qc, kc, rel)
        o = o_inter + jnp.einsum("bhts,bhse->bhte", scores, vc)
        S_new = (jnp.exp(b_last[:, :, 0, :])[..., None] * S
                 + jnp.einsum("bhsd,bhse->bhde", kc * jnp.exp(b_last - b), vc))
        return S_new, o

    s_fin, o = lax.scan(step, s0, (to_chunks(q), to_chunks(k), to_chunks(v), to_chunks(g)))
    return s_fin, o.transpose(1, 0, 3, 2, 4).reshape(B, N, H, DV)


def hgrn_direction(q, i, f_raw, lb, s0, reverse):
    B, N = q.shape[:2]
    f = lb + (1.0 - lb) * jax.nn.sigmoid(f_raw.astype(jnp.float32))
    shp = (B, N, HG_HEADS, HG_DK)
    g = jnp.log(f).reshape(shp)
    k = (1.0 - f).reshape(shp)
    seqs = (q, k, i, g)
    if reverse:
        seqs = tuple(jnp.flip(a, axis=1) for a in seqs)
    s_fin, o = hgrn_chunk_scan(*seqs, s0)
    if reverse:
        o = jnp.flip(o, axis=1)
    return s_fin, o


def hgrn_readout(o, gate_raw, g_norm, dtype):
    B, N = o.shape[:2]
    o = rms_norm(o, g_norm).reshape(B, N, HG_HEADS * HG_DV)
    return (o * jax.nn.silu(gate_raw.astype(jnp.float32))).astype(dtype)


def mixer_layer(h, hc, w_in, q_norm, kv_norm, w_uq, w_ukv, lb_fwd, lb_bwd, g_norm, w_out, cos, sin, want_ctx):
    B, N = h.shape[:2]
    M = hc.shape[1]
    cq, ckv, kr, hq, hf_f, hf_b, hi, hg = split_cols(h @ w_in)
    cq_c, ckv_c, kr_c, hq_c, hf_f_c, hf_b_c, hi_c, hg_c = split_cols(hc @ w_in)

    kn_c, krr_c, v_c = mla_keys(ckv_c, kr_c, kv_norm, w_ukv, None, None)
    kn_l, krr_l, v_l = mla_keys(ckv, kr, kv_norm, w_ukv, cos, sin)
    kn_all = jnp.concatenate([kn_c, kn_l], axis=1)
    kr_all = jnp.concatenate([krr_c, krr_l], axis=1)
    v_all = jnp.concatenate([v_c, v_l], axis=1)
    qn, qr = mla_queries(cq, q_norm, w_uq, cos, sin)
    att = latent_attention(qn, qr, kn_all, kr_all, v_all)

    f32 = jnp.float32
    q_h = jax.nn.silu(hq.astype(f32)).reshape(B, N, HG_HEADS, HG_DK)
    i_h = hi.astype(f32).reshape(B, N, HG_HEADS, HG_DV)
    qc_h = jax.nn.silu(hq_c.astype(f32)).reshape(B, M, HG_HEADS, HG_DK)
    ic_h = hi_c.astype(f32).reshape(B, M, HG_HEADS, HG_DV)
    s0 = jnp.zeros((B, HG_HEADS, HG_DK, HG_DV), f32)
    s_f, o_cf = hgrn_direction(qc_h, ic_h, hf_f_c, lb_fwd, s0, False)
    s_b, o_cb = hgrn_direction(qc_h, ic_h, hf_b_c, lb_bwd, s0, True)
    _, o_f = hgrn_direction(q_h, i_h, hf_f, lb_fwd, s_f, False)
    _, o_b = hgrn_direction(q_h, i_h, hf_b, lb_bwd, s_b, True)
    rec = hgrn_readout(o_f + o_b, hg, g_norm, h.dtype)

    mix = jnp.concatenate([att, rec], axis=-1) @ w_out
    if want_ctx:
        qn_c, qr_c = mla_queries(cq_c, q_norm, w_uq, None, None)
        att_c = block_attn(qn_c, qr_c, kn_c, krr_c, v_c).reshape(B, M, MLA_HEADS * MLA_V)
        rec_c = hgrn_readout(o_cf + o_cb, hg_c, g_norm, hc.dtype)
        mix_c = jnp.concatenate([att_c, rec_c], axis=-1) @ w_out
        return mix, mix_c
    return mix, None


def moe_ffn(h, router_w, router_b, w_gu, b_gu, w_dn, b_dn):
    T, D = h.shape
    logits = (h @ router_w + router_b).astype(jnp.float32)
    top_logit, top_expert = lax.top_k(logits, TOP_K)
    gates = jax.nn.softmax(top_logit, axis=-1)
    n_assign = T * TOP_K
    flat_e = top_expert.reshape(-1)
    order = jnp.argsort(flat_e)
    sorted_e = flat_e[order]
    counts = jnp.bincount(flat_e, length=N_EXPERTS)
    padded = (counts + MOE_BLOCK - 1) // MOE_BLOCK * MOE_BLOCK
    pad_end = jnp.cumsum(padded)
    pad_start = pad_end - padded
    start = jnp.cumsum(counts) - counts
    dest = pad_start[sorted_e] + jnp.arange(n_assign) - start[sorted_e]
    n_blocks = -(-n_assign // MOE_BLOCK) + N_EXPERTS
    n_slots = n_blocks * MOE_BLOCK
    slot_tok = jnp.full((n_slots,), T, jnp.int32).at[dest].set((order // TOP_K).astype(jnp.int32))
    slot_gate = jnp.zeros((n_slots,), jnp.float32).at[dest].set(gates.reshape(-1)[order])
    block_e = jnp.minimum(jnp.searchsorted(pad_end, jnp.arange(n_blocks) * MOE_BLOCK, side="right"), N_EXPERTS - 1)
    h_pad = jnp.concatenate([h, jnp.zeros((1, D), h.dtype)], axis=0)

    def expert_block(args):
        tok, gate, e = args
        xs = h_pad[tok]
        gu = xs @ w_gu[e] + b_gu[e]
        glu = jnp.minimum(gu[:, :D_FF], SWIGLU_LIMIT)
        lin = jnp.clip(gu[:, D_FF:], -SWIGLU_LIMIT, SWIGLU_LIMIT)
        act = glu * jax.nn.sigmoid(SWIGLU_ALPHA * glu) * (lin + 1.0)
        return (act @ w_dn[e] + b_dn[e]) * gate[:, None].astype(h.dtype)

    y = lax.map(expert_block, (slot_tok.reshape(n_blocks, MOE_BLOCK), slot_gate.reshape(n_blocks, MOE_BLOCK), block_e))
    return jax.ops.segment_sum(y.reshape(n_slots, D), slot_tok, num_segments=T + 1)[:T]


def setup_inputs(seed: int = 0) -> dict:
    key = jax.random.key(seed)
    ks = jax.random.split(key, 24)
    f32 = jnp.float32
    L = DEPTH

    def nrm(k, shape, scale):
        return jax.random.normal(k, shape, f32) * scale

    def gain(k, shape):
        return 1.0 + 0.05 * jax.random.normal(k, shape, f32)

    return {
        "x": nrm(ks[0], (BATCH, SEQ, D_MODEL), 1.0),
        "c": nrm(ks[1], (BATCH, D_MODEL), 1.0),
        "ctx": nrm(ks[2], (BATCH, CTX_LEN, D_MODEL), 1.0),
        "c_ctx": nrm(ks[3], (D_MODEL,), 1.0),
        "w_mod": nrm(ks[4], (L, D_MODEL, 6 * D_MODEL), 0.5 * D_MODEL ** -0.5),
        "b_mod": nrm(ks[5], (L, 6 * D_MODEL), 0.02),
        "ln_mix_pre": gain(ks[6], (L, D_MODEL)),
        "ln_mix_post": gain(ks[7], (L, D_MODEL)),
        "ln_ffn_pre": gain(ks[8], (L, D_MODEL)),
        "ln_ffn_post": gain(ks[9], (L, D_MODEL)),
        "w_in": nrm(ks[10], (L, D_MODEL, IN_COLS), D_MODEL ** -0.5),
        "q_norm": gain(ks[11], (L, MLA_Q_RANK)),
        "kv_norm": gain(ks[12], (L, MLA_KV_RANK)),
        "w_uq": nrm(ks[13], (L, MLA_Q_RANK, MLA_HEADS, MLA_QK), MLA_Q_RANK ** -0.5),
        "w_ukv": nrm(ks[14], (L, MLA_KV_RANK, MLA_HEADS, MLA_NOPE + MLA_V), MLA_KV_RANK ** -0.5),
        "hgrn_lb": nrm(ks[15], (2, L + 1, HG_HEADS * HG_DK), 0.5),
        "g_norm": gain(ks[16], (L, HG_DV)),
        "w_out": nrm(ks[17], (L, MIX_WIDTH, D_MODEL), MIX_WIDTH ** -0.5),
        "router_w": nrm(ks[18], (L, D_MODEL, N_EXPERTS), D_MODEL ** -0.5),
        "router_b": nrm(ks[19], (L, N_EXPERTS), 0.01),
        "w_gate_up": nrm(ks[20], (L, N_EXPERTS, D_MODEL, 2 * D_FF), D_MODEL ** -0.5),
        "b_gate_up": nrm(ks[21], (L, N_EXPERTS, 2 * D_FF), 0.02),
        "w_down": nrm(ks[22], (L, N_EXPERTS, D_FF, D_MODEL), D_FF ** -0.5),
        "b_down": nrm(ks[23], (L, N_EXPERTS, D_MODEL), 0.02),
    }


def reference(x, c, ctx, c_ctx, w_mod, b_mod, ln_mix_pre, ln_mix_post, ln_ffn_pre, ln_ffn_post, w_in, q_norm, kv_norm, w_uq, w_ukv, hgrn_lb, g_norm, w_out, router_w, router_b, w_gate_up, b_gate_up, w_down, b_down):
    B, N, D = x.shape
    ROWS = N // GRID_W
    cos, sin = axial_rope(ROWS)
    lb = jnp.cumsum(jax.nn.softmax(hgrn_lb.astype(jnp.float32), axis=1), axis=1)
    xc = ctx
    for l in range(DEPTH):
        want_ctx = l < DEPTH - 1
        mod = jax.nn.silu(c) @ w_mod[l] + b_mod[l]
        mod_c = jax.nn.silu(c_ctx) @ w_mod[l] + b_mod[l]
        sh_m, sc_m, gt_m, sh_f, sc_f, gt_f = jnp.split(mod[:, None, :], 6, axis=-1)
        sh_mc, sc_mc, gt_mc, sh_fc, sc_fc, gt_fc = jnp.split(mod_c, 6, axis=-1)

        h = modulate(rms_norm(x, ln_mix_pre[l]), sh_m, sc_m)
        hc = modulate(rms_norm(xc, ln_mix_pre[l]), sh_mc, sc_mc)
        mix, mix_c = mixer_layer(h, hc, w_in[l], q_norm[l], kv_norm[l], w_uq[l], w_ukv[l], lb[0, l], lb[1, l], g_norm[l], w_out[l], cos, sin, want_ctx)
        x = x + gt_m * rms_norm(mix, ln_mix_post[l])

        h2 = modulate(rms_norm(x, ln_ffn_pre[l]), sh_f, sc_f)
        y = moe_ffn(h2.reshape(B * N, D), router_w[l], router_b[l], w_gate_up[l], b_gate_up[l], w_down[l], b_down[l]).reshape(B, N, D)
        x = x + gt_f * rms_norm(y, ln_ffn_post[l])

        if want_ctx:
            M = xc.shape[1]
            xc = xc + gt_mc * rms_norm(mix_c, ln_mix_post[l])
            hc2 = modulate(rms_norm(xc, ln_ffn_pre[l]), sh_fc, sc_fc)
            yc = moe_ffn(hc2.reshape(B * M, D), router_w[l], router_b[l], w_gate_up[l], b_gate_up[l], w_down[l], b_down[l]).reshape(B, M, D)
            xc = xc + gt_fc * rms_norm(yc, ln_ffn_post[l])
    return x
```

```cpp
#include <hip/hip_runtime.h>
#include <stdint.h>
#include <stdio.h>

#define DEV __device__ __forceinline__
typedef unsigned short bf16_t;
typedef short bf16x8 __attribute__((ext_vector_type(8)));
typedef short s16x4 __attribute__((ext_vector_type(4)));
typedef float f32x4 __attribute__((ext_vector_type(4)));
typedef float f32x2 __attribute__((ext_vector_type(2)));
typedef float f32x16 __attribute__((ext_vector_type(16)));
typedef unsigned u32x4 __attribute__((ext_vector_type(4)));
typedef unsigned u32x2 __attribute__((ext_vector_type(2)));

constexpr int DM = 2048, NBATCH = 4, SEQ = 4096, CTX = 256, KEYS = CTX + SEQ;
constexpr int NLAT = NBATCH * SEQ, NCTX = NBATCH * CTX, NROW = NLAT + NCTX;
constexpr int NH = 8, QRANK = 512, KVRANK = 256, ROPE = 64, QK = 192, DV = 128, DK = 128;
constexpr int INC = 5952, INCP = 6144;
constexpr int NE = 32, TOPK = 4, DFF = 2048;
constexpr int MAXSLOT = 65536 + NE * 256;
constexpr int MAXTILES = MAXSLOT / 256;
constexpr int NT = 512;
constexpr float EPS = 1e-6f;
constexpr int FP8_WSCALE_LOG2_ = 6;

struct Params {
  const float *x, *c, *ctx, *c_ctx, *w_mod, *b_mod, *ln_mix_pre, *ln_mix_post, *ln_ffn_pre, *ln_ffn_post, *w_in, *q_norm, *kv_norm, *w_uq, *w_ukv, *hgrn_lb, *g_norm, *w_out,
      *router_w, *router_b, *w_gu, *b_gu, *w_dn, *b_dn;
  float* out;
  bf16_t *wt_in, *wt_uq, *wt_ukv, *wt_out;
  unsigned char *wt_gu8, *wt_dn8;
  unsigned char *h2_8, *act8;
  float* mod;
  float* rope;
  bf16_t* h;
  bf16_t *cq, *cqn;
  bf16_t *ckv, *ckvn;
  float* kr;
  bf16_t* kr2;
  bf16_t* qh;
  float *gf, *gb;
  bf16_t* vh;
  bf16_t* gate;
  bf16_t *qf, *kf, *vf;
  bf16_t* aout;
  bf16_t *of, *ob;
  bf16_t* mix;
  bf16_t* x1;
  int *tok_e, *tok_pos;
  float* tok_gate;
  int* cnt;
  int* idx;
  unsigned char* ys8;
  unsigned* bar;
};

DEV int ltid() { int t = threadIdx.x; asm volatile("" : "+v"(t)); return t; }
typedef const __attribute__((address_space(4))) Params CParams;
DEV CParams* launder(CParams* p) { asm volatile("" : "+s"(p)); return p; }
#define KARGS ((CParams*)__builtin_amdgcn_kernarg_segment_ptr())
typedef __bf16 bf16n2 __attribute__((ext_vector_type(2)));
DEV unsigned cvt_pk_bf16(float lo, float hi) { const f32x2 v = {lo, hi}; const bf16n2 r = __builtin_convertvector(v, bf16n2); return __builtin_bit_cast(unsigned, r); }
DEV unsigned cvt_pk4_fp8(f32x4 v) { unsigned r = 0; r = __builtin_amdgcn_cvt_pk_fp8_f32(v[0], v[1], r, false); r = __builtin_amdgcn_cvt_pk_fp8_f32(v[2], v[3], r, true); return r; }
DEV float bf2f(bf16_t v) { return __uint_as_float(((unsigned)v) << 16); }
DEV float bflo(unsigned v) { return __uint_as_float(v << 16); }
DEV float bfhi(unsigned v) { return __uint_as_float(v & 0xffff0000u); }
DEV bf16_t f2bf(float f) { const __bf16 r = (__bf16)f; return __builtin_bit_cast(bf16_t, r); }
DEV float wave_sum(float v) {
#pragma unroll
  for (int o = 32; o > 0; o >>= 1) v += __shfl_xor(v, o);
  return v;
}
DEV float sigmoidf_(float v) { return __builtin_amdgcn_rcpf(1.f + __builtin_amdgcn_exp2f(-1.4426950408889634f * v)); }
DEV float siluf_(float v) { return v * __builtin_amdgcn_rcpf(1.f + __builtin_amdgcn_exp2f(-1.4426950408889634f * v)); }

DEV void mod_unit(CParams& p, int u) {
  extern __shared__ __attribute__((aligned(16))) char shm[];
  float* sc = (float*)shm;
  float* red = (float*)(shm + 5 * 2048 * 4);
  const int tid = ltid(), wid = tid >> 6, lane = tid & 63;
  for (int i = tid; i < 5 * 2048; i += NT) { const int v = i >> 11, k = i & 2047; const float cv = v < 4 ? p.c[v * 2048 + k] : p.c_ctx[k]; sc[i] = siluf_(cv); }
  __syncthreads();
  const int col = u * 256 + lane * 4;
  f32x4 acc[5];
#pragma unroll
  for (int v = 0; v < 5; ++v) acc[v] = (f32x4){0.f, 0.f, 0.f, 0.f};
  const float* wp = p.w_mod + (long)(wid * 256) * 12288 + col;
  for (int k = 0; k < 256; k += 4) {
    f32x4 w[4];
#pragma unroll
    for (int j = 0; j < 4; ++j) w[j] = *(const f32x4*)(wp + (long)(k + j) * 12288);
#pragma unroll
    for (int j = 0; j < 4; ++j)
#pragma unroll
      for (int v = 0; v < 5; ++v) { const float s = sc[v * 2048 + wid * 256 + k + j]; acc[v] += w[j] * s; }
  }
#pragma unroll
  for (int v = 0; v < 5; ++v) *(f32x4*)(red + (wid * 5 + v) * 256 + lane * 4) = acc[v];
  __syncthreads();
  for (int i = tid; i < 5 * 256; i += NT) {
    const int v = i >> 8, cc = i & 255; float s = p.b_mod[u * 256 + cc];
#pragma unroll
    for (int w = 0; w < 8; ++w) s += red[(w * 5 + v) * 256 + cc];
    p.mod[v * 12288 + u * 256 + cc] = s;
  }
  __syncthreads();
}

DEV int perm_row(int perm, int n) {
  if (perm == 1) return n < 832 ? n : n + 192;
  if (perm == 2) { const int lin = n >= 2048 ? 1 : 0, j = n - lin * 2048; return (j >> 7) * 256 + lin * 128 + (j & 127); }
  return n;
}
struct CvtDesc { const float* src; void* dst; int ldsrc, N, lddst, k0, n0, perm, fp8; };
constexpr int U_MOD = 48, U_ROPE = 16;
constexpr int U_GU = NE * 16 * 32, U_DN = NE * 16 * 16, U_IN = 16 * 47, U_OUT = 16 * 16, U_UQ = 4 * 12, U_UKV = 2 * 16;
constexpr int U_CVT = U_GU + U_DN + U_IN + U_OUT + U_UQ + U_UKV;
DEV CvtDesc cvt_decode(CParams& p, int u) {
  CvtDesc d;
  if (u < U_GU) { const int e = u >> 9, r = u & 511, kt = r >> 5, nt = r & 31;
    d.src = p.w_gu + (long)e * 2048 * 4096; d.ldsrc = 4096; d.N = 4096; d.dst = p.wt_gu8 + (long)e * 4096 * 2048; d.lddst = 2048; d.k0 = kt * 128; d.n0 = nt * 128; d.perm = 2; d.fp8 = 1; return d; }
  u -= U_GU;
  if (u < U_DN) { const int e = u >> 8, r = u & 255, kt = r >> 4, nt = r & 15;
    d.src = p.w_dn + (long)e * 2048 * 2048; d.ldsrc = 2048; d.N = 2048; d.dst = p.wt_dn8 + (long)e * 2048 * 2048; d.lddst = 2048; d.k0 = kt * 128; d.n0 = nt * 128; d.perm = 0; d.fp8 = 1; return d; }
  u -= U_DN;
  if (u < U_IN) { const int kt = u / 47, nt = u % 47; d.src = p.w_in; d.ldsrc = INC; d.N = INC; d.dst = p.wt_in; d.lddst = 2048; d.k0 = kt * 128; d.n0 = nt * 128; d.perm = 1; d.fp8 = 0; return d; }
  u -= U_IN;
  if (u < U_OUT) { const int kt = u >> 4, nt = u & 15; d.src = p.w_out; d.ldsrc = 2048; d.N = 2048; d.dst = p.wt_out; d.lddst = 2048; d.k0 = kt * 128; d.n0 = nt * 128; d.perm = 0; d.fp8 = 0; return d; }
  u -= U_OUT;
  if (u < U_UQ) { const int kt = u / 12, nt = u % 12; d.src = p.w_uq; d.ldsrc = 1536; d.N = 1536; d.dst = p.wt_uq; d.lddst = 512; d.k0 = kt * 128; d.n0 = nt * 128; d.perm = 0; d.fp8 = 0; return d; }
  u -= U_UQ;
  { const int kt = u >> 4, nt = u & 15; d.src = p.w_ukv; d.ldsrc = 2048; d.N = 2048; d.dst = p.wt_ukv; d.lddst = 256; d.k0 = kt * 128; d.n0 = nt * 128; d.perm = 0; d.fp8 = 0; }
  return d;
}
DEV void cvt_load(const CvtDesc& d, f32x4 (&ld)[8]) {
  const int tid = ltid(), tx = tid & 31, ty = tid >> 5;
  const bool ok = (d.n0 + 4 * tx) < d.N;
#pragma unroll
  for (int x = 0; x < 8; ++x) {
    const int row = d.fp8 ? 4 * (ty + 16 * (x >> 2)) + (x & 3) : 2 * (ty + 16 * (x >> 1)) + (x & 1);
    const float* sp = d.src + (long)(d.k0 + row) * d.ldsrc + d.n0 + 4 * tx;
    ld[x] = ok ? __builtin_nontemporal_load((const f32x4*)sp) : (f32x4){0.f, 0.f, 0.f, 0.f};
  }
}
DEV void cvt_store(const CvtDesc& d, const f32x4 (&ld)[8]) {
  extern __shared__ __attribute__((aligned(16))) char shm[];
  unsigned* T = (unsigned*)shm;
  const int tid = ltid(), tx = tid & 31, ty = tid >> 5;
  if (d.fp8) {
    constexpr float WS = (float)(1 << FP8_WSCALE_LOG2_);
#pragma unroll
    for (int i = 0; i < 2; ++i) {
      const int q = ty + 16 * i;
#pragma unroll
      for (int j = 0; j < 4; ++j) T[(4 * tx + j) * 33 + q] = cvt_pk4_fp8((f32x4){ld[4 * i][j] * WS, ld[4 * i + 1][j] * WS, ld[4 * i + 2][j] * WS, ld[4 * i + 3][j] * WS});
    }
    __syncthreads();
#pragma unroll
    for (int j = 0; j < 2; ++j) {
      const int id = tid + NT * j, nl = id >> 3, cc = id & 7, n = d.n0 + nl;
      u32x4 v; v.x = T[nl * 33 + 4 * cc]; v.y = T[nl * 33 + 4 * cc + 1]; v.z = T[nl * 33 + 4 * cc + 2]; v.w = T[nl * 33 + 4 * cc + 3];
      if (n < d.N) *(u32x4*)((unsigned char*)d.dst + (long)perm_row(d.perm, n) * d.lddst + d.k0 + 16 * cc) = v;
    }
  } else {
#pragma unroll
    for (int i = 0; i < 4; ++i) {
      const int q = ty + 16 * i;
#pragma unroll
      for (int j = 0; j < 4; ++j) T[(4 * tx + j) * 65 + q] = cvt_pk_bf16(ld[2 * i][j], ld[2 * i + 1][j]);
    }
    __syncthreads();
#pragma unroll
    for (int j = 0; j < 4; ++j) {
      const int id = tid + NT * j, nl = id >> 4, cc = id & 15, n = d.n0 + nl;
      u32x4 v; v.x = T[nl * 65 + 4 * cc]; v.y = T[nl * 65 + 4 * cc + 1]; v.z = T[nl * 65 + 4 * cc + 2]; v.w = T[nl * 65 + 4 * cc + 3];
      if (n < d.N) *(u32x4*)((bf16_t*)d.dst + (long)perm_row(d.perm, n) * d.lddst + d.k0 + 8 * cc) = v;
    }
  }
  __syncthreads();
}
constexpr int FILL_LDS_OFF = 133120, FILL_TB = 128 * 17 * 4;
constexpr int FILL_HALVES = 2 * (NE * 16 * 32 + NE * 16 * 16);
#ifndef FILL_HG
#define FILL_HG 67
#endif
#ifndef FILL_A0
#define FILL_A0 63
#endif
#ifndef FILL_A1
#define FILL_A1 62
#endif
constexpr int FILL_SLOTS = FILL_HG + FILL_A0 + FILL_A1;
static_assert(FILL_HG <= 67 && FILL_A0 <= 68 && FILL_A1 <= 68 && FILL_SLOTS * 256 <= FILL_HALVES, "filler split");
struct FillDesc { const float* src; unsigned char* dst; int ldsrc, perm, n0, kh; };
DEV FillDesc fill_decode(CParams& p, int wg, int slot) {
  const int h = slot * 256 + wg, t = h >> 1, half = h & 1; FillDesc d;
  if (t < NE * 512) { const int e = t >> 9, r = t & 511; d.src = p.w_gu + (long)e * 2048 * 4096; d.ldsrc = 4096; d.dst = p.wt_gu8 + (long)e * 4096 * 2048; d.perm = 2; d.n0 = (r & 31) * 128 + 64 * half; d.kh = (r >> 5) * 128; }
  else { const int v = t - NE * 512, e = v >> 8, r = v & 255; d.src = p.w_dn + (long)e * 2048 * 2048; d.ldsrc = 2048; d.dst = p.wt_dn8 + (long)e * 2048 * 2048; d.perm = 0; d.n0 = (r & 15) * 128 + 64 * half; d.kh = (r >> 4) * 128; }
  return d;
}
DEV void fill_load(CParams& p, int wg, int slot, f32x4 (&ld)[4]) {
  const FillDesc d = fill_decode(p, wg, slot); const int tid = ltid(), tx = tid & 15, ty = tid >> 4;
  const float* sp = d.src + (long)(d.kh + 4 * ty) * d.ldsrc + d.n0 + 4 * tx;
#pragma unroll
  for (int r = 0; r < 4; ++r) ld[r] = *(const f32x4*)(sp + (long)r * d.ldsrc);
}
DEV void fill_write(const f32x4 (&ld)[4], int bufsel) {
  extern __shared__ __attribute__((aligned(16))) char shm[];
  unsigned* T = (unsigned*)(shm + FILL_LDS_OFF + bufsel * FILL_TB); const int tid = ltid(), tx = tid & 15, ty = tid >> 4;
  constexpr float WS = (float)(1 << FP8_WSCALE_LOG2_);
#pragma unroll
  for (int j = 0; j < 4; ++j) T[(4 * tx + j) * 33 + ty] = cvt_pk4_fp8((f32x4){ld[0][j] * WS, ld[1][j] * WS, ld[2][j] * WS, ld[3][j] * WS});
}
DEV void fill_store(CParams& p, int wg, int slot, int bufsel) {
  extern __shared__ __attribute__((aligned(16))) char shm[];
  const unsigned* T = (const unsigned*)(shm + FILL_LDS_OFF + bufsel * FILL_TB); const int tid = ltid(), nl = tid >> 3, cc = tid & 7;
  const FillDesc d = fill_decode(p, wg, slot);
  u32x4 v; v.x = T[nl * 33 + 4 * cc]; v.y = T[nl * 33 + 4 * cc + 1]; v.z = T[nl * 33 + 4 * cc + 2]; v.w = T[nl * 33 + 4 * cc + 3];
  *(u32x4*)(d.dst + (long)perm_row(d.perm, d.n0 + nl) * 2048 + d.kh + 16 * cc) = v;
}
DEV void rope_unit(CParams& p, int u) {
  for (int i = ltid(); i < 256 * 32; i += NT) {
    const int t = u * 256 + (i >> 5), a = i & 31; const int fi = a & 15;
    const float inv = powf(10000.0f, -(float)fi / 16.0f);
    const float pos = a < 16 ? (float)(t >> 6) : (float)(t & 63);
    const float ang = pos * inv; float s, c; sincosf(ang, &s, &c);
    p.rope[t * 64 + a] = c; p.rope[t * 64 + 32 + a] = s;
  }
}
DEV void phase0(CParams& p, int wg, int nwg) {
  if (wg < U_MOD) mod_unit(p, wg); else if (wg < U_MOD + U_ROPE) rope_unit(p, wg - U_MOD);
  if (nwg < U_MOD + U_ROPE) { for (int u = wg + nwg; u < U_MOD + U_ROPE; u += nwg) { if (u < U_MOD) mod_unit(p, u); else rope_unit(p, u - U_MOD); } }
  f32x4 ld[8], ld2[8];
  int u = (nwg == 256 ? FILL_SLOTS * 128 : 0) + wg;
  if (u < U_CVT) { const CvtDesc d = cvt_decode(p, u); cvt_load(d, ld); }
  for (; u < U_CVT; u += nwg) {
    const CvtDesc d = cvt_decode(p, u);
    const int un = u + nwg;
    if (un < U_CVT) { const CvtDesc dn = cvt_decode(p, un); cvt_load(dn, ld2); }
    cvt_store(d, ld);
#pragma unroll
    for (int i = 0; i < 8; ++i) ld[i] = ld2[i];
  }
}

DEV void phase1_rows(CParams& p, int wg, int nwg) {
  const int wid = ltid() >> 6, lane = ltid() & 63;
  for (int row = wg * 8 + wid; row < NROW; row += nwg * 8) {
    const float* xr; int v;
    if (row < NCTX) { xr = p.ctx + (long)row * DM; v = 4; } else { xr = p.x + (long)(row - NCTX) * DM; v = (row - NCTX) >> 12; }
    const float* sh = p.mod + v * 12288; const float* sc = sh + 2048;
    f32x4 xv[8]; float ss = 0.f;
#pragma unroll
    for (int i = 0; i < 8; ++i) { xv[i] = *(const f32x4*)(xr + i * 256 + lane * 4); ss += xv[i][0] * xv[i][0] + xv[i][1] * xv[i][1] + xv[i][2] * xv[i][2] + xv[i][3] * xv[i][3]; }
    ss = wave_sum(ss);
    const float rstd = rsqrtf(ss * (1.f / DM) + EPS);
#pragma unroll
    for (int i = 0; i < 8; ++i) {
      const int c0 = i * 256 + lane * 4;
      const f32x4 w = *(const f32x4*)(p.ln_mix_pre + c0), s1 = *(const f32x4*)(sc + c0), s0 = *(const f32x4*)(sh + c0);
      f32x4 y;
#pragma unroll
      for (int j = 0; j < 4; ++j) y[j] = xv[i][j] * rstd * w[j] * (1.f + s1[j]) + s0[j];
      u32x2 o; o.x = cvt_pk_bf16(y[0], y[1]); o.y = cvt_pk_bf16(y[2], y[3]);
      *(u32x2*)(p.h + (long)row * DM + c0) = o;
    }
  }
}
#define LAS __attribute__((address_space(3)))
constexpr int BM = 256, BK = 64, HALF = 128, HTB = HALF * BK * 2, GEMM_LDS = 8 * HTB;
constexpr int GEMM_AROW_OFF = GEMM_LDS;
DEV int lds_byte(int r, int c) { const int st = (r >> 4) * 2 + (c >> 5), rr = r & 15, cc = c & 31, ob = rr * 64 + cc * 2; return st * 1024 + (ob ^ (((ob >> 9) & 1) << 5)); }
DEV void stage_rc(int b, int& R, int& C) { const int st = b / 1024, sb = b % 1024, swz = sb ^ (((sb >> 9) & 1) << 5); R = (st >> 1) * 16 + swz / 64; C = (st & 1) * 32 + (swz % 64) / 2; }
typedef f32x4 AccT[2][2][4][2];
struct Unit { int pm, pn, e, r0; };
typedef int i32x8 __attribute__((ext_vector_type(8)));
typedef int i32x4 __attribute__((ext_vector_type(4)));
DEV int g8(int r) { const int q = ((r & 15) >> 1) + 2; return 2 * (q & 3) + 1 - ((q >> 2) & 1); }
constexpr int FP8_WSCALE_LOG2 = FP8_WSCALE_LOG2_;
constexpr int FP8_SCALE_W = 0x01010101 * (127 - FP8_WSCALE_LOG2), FP8_SCALE_1 = 0x7f7f7f7f;

DEV void mfma_fp8(f32x4& acc, const i32x8& w, const i32x8& a, int sw, int sa) {
  asm volatile("v_mfma_scale_f32_16x16x128_f8f6f4 %0, %1, %2, %0, %3, %4 op_sel_hi:[0,0,0]" : "+v"(acc) : "v"(w), "v"(a), "v"(sw), "v"(sa));
}
template <class P>
DEV void gemm_stream(const P& pol) {
  extern __shared__ __attribute__((aligned(16))) char shm[];
  LAS unsigned char* lds = (LAS unsigned char*)shm;
  LAS int* arow = (LAS int*)(shm + GEMM_AROW_OFF);
  const int tid = ltid(), wid = __builtin_amdgcn_readfirstlane(tid >> 6), lane = tid & 63, wr = wid >> 2, wc = wid & 3, fr = lane & 15, fq = lane >> 4;
  const int KB = pol.KB, nt = KB / 128;
  Unit cur, nxt; int ui = 0;
  if (!pol.get(0, cur)) return;
  unsigned voffB[2], vAc[2][2];
#define G_SRC(i_, R_, C_) do { const int b_ = ltid() * 16 + (i_) * 8192; if (P::FP8) { R_ = b_ >> 7; C_ = (((b_ >> 4) & 7) ^ g8(R_)) << 4; } else { stage_rc(b_, R_, C_); C_ *= 2; } } while (0)
#define G_GATHER_OFFS(tab_) do { _Pragma("unroll") for (int i = 0; i < 2; ++i) { int R_, C_; G_SRC(i, R_, C_); \
    vAc[0][i] = (unsigned)((tab_)[R_] * KB + C_); vAc[1][i] = (unsigned)((tab_)[HALF + R_] * KB + C_); } } while (0)
#pragma unroll
  for (int i = 0; i < 2; ++i) { int R_, C_; G_SRC(i, R_, C_); const int rho = R_ & 31, Rb = (R_ & ~31) + 8 * ((rho & 15) >> 2) + 4 * (rho >> 4) + (rho & 3); voffB[i] = (unsigned)(Rb * KB + C_); }
  if (P::GATHER) {
    pol.arow_fill(cur, (int*)(shm + GEMM_AROW_OFF));
    __syncthreads();
    G_GATHER_OFFS(arow);
  } else {
#pragma unroll
    for (int i = 0; i < 2; ++i) { int R_, C_; G_SRC(i, R_, C_); vAc[0][i] = (unsigned)(R_ * KB + C_); vAc[1][i] = vAc[0][i]; }
  }
  const size_t kstep = 128, hstep = (size_t)HALF * KB;
  const unsigned ldsw = (unsigned)wid * 1024u;
  const int aoff = P::FP8 ? (wr * 64 + fr) * 128 + (((2 * fq) ^ g8(fr)) << 4) : lds_byte(wr * 64 + fr, fq * 8);
  const int boff = P::FP8 ? (wc * 32 + fr) * 128 + (((2 * fq) ^ g8(fr)) << 4) : lds_byte(wc * 32 + fr, fq * 8);
  const int aoff1 = (wr * 64 + fr) * 128 + (((2 * fq + 1) ^ g8(fr)) << 4), boff1 = (wc * 32 + fr) * 128 + (((2 * fq + 1) ^ g8(fr)) << 4);
#define G_SA(b, h) (((b) * 2 + (h)) * HTB)
#define G_SB(b, h) ((4 + (b) * 2 + (h)) * HTB)
#define G_STAGE(bufoff, gbase, voff) do { _Pragma("unroll") for (int _i = 0; _i < 2; ++_i) \
    __builtin_amdgcn_global_load_lds((const unsigned*)((const char*)(gbase) + (voff)[_i]), (LAS unsigned*)(lds + (bufoff) + ldsw + _i * 8192), 16, 0, 0); } while (0)
#define G_LD2(o0, o1) __builtin_shufflevector(*(const LAS i32x4*)(lds + (o0)), *(const LAS i32x4*)(lds + (o1)), 0, 1, 2, 3, 4, 5, 6, 7)
#define G_LDA(dst, b, h) do { _Pragma("unroll") for (int m = 0; m < 4; ++m) dst[m] = G_LD2(G_SA(b, h) + aoff + m * 2048, G_SA(b, h) + (P::FP8 ? aoff1 : aoff + 1024) + m * 2048); } while (0)
#define G_LDB(dst, b, h) do { _Pragma("unroll") for (int n = 0; n < 2; ++n) dst[n] = G_LD2(G_SB(b, h) + boff + n * 2048, G_SB(b, h) + (P::FP8 ? boff1 : boff + 1024) + n * 2048); } while (0)
#define G_LO(x_) __builtin_bit_cast(bf16x8, __builtin_shufflevector(x_, x_, 0, 1, 2, 3))
#define G_HI(x_) __builtin_bit_cast(bf16x8, __builtin_shufflevector(x_, x_, 4, 5, 6, 7))
#define G_MMA(ai, bj, At_, Bt_) do { __builtin_amdgcn_s_setprio(1); _Pragma("unroll") for (int m = 0; m < 4; ++m) _Pragma("unroll") for (int n = 0; n < 2; ++n) { \
    if (P::FP8) mfma_fp8(acc[ai][bj][m][n], Bt_[n], At_[m], sclw, scla); \
    else { acc[ai][bj][m][n] = __builtin_amdgcn_mfma_f32_16x16x32_bf16(G_LO(Bt_[n]), G_LO(At_[m]), acc[ai][bj][m][n], 0, 0, 0); \
           acc[ai][bj][m][n] = __builtin_amdgcn_mfma_f32_16x16x32_bf16(G_HI(Bt_[n]), G_HI(At_[m]), acc[ai][bj][m][n], 0, 0, 0); } } \
    __builtin_amdgcn_s_setprio(0); } while (0)
#define G_ZERO() do { _Pragma("unroll") for (int a_ = 0; a_ < 2; ++a_) _Pragma("unroll") for (int b_ = 0; b_ < 2; ++b_) _Pragma("unroll") for (int m_ = 0; m_ < 4; ++m_) _Pragma("unroll") for (int n_ = 0; n_ < 2; ++n_) \
    acc[a_][b_][m_][n_] = (f32x4){0.f, 0.f, 0.f, 0.f}; } while (0)
#define WAIT_V(n) asm volatile("s_waitcnt vmcnt(" #n ")" ::: "memory")
#define WAIT_L(n) asm volatile("s_waitcnt lgkmcnt(" #n ")" ::: "memory")
#define BAR __builtin_amdgcn_s_barrier()
#define SCHED __builtin_amdgcn_sched_barrier(0)
  int sclw = P::SCALE_B, scla = P::SCALE_A;
  f32x4 acc[2][2][4][2];
  f32x4 bv[2][2];
#define G_INIT() do { _Pragma("unroll") for (int a_ = 0; a_ < 2; ++a_) _Pragma("unroll") for (int b_ = 0; b_ < 2; ++b_) _Pragma("unroll") for (int m_ = 0; m_ < 4; ++m_) _Pragma("unroll") for (int n_ = 0; n_ < 2; ++n_) \
    acc[a_][b_][m_][n_] = bv[b_][n_]; } while (0)
  if (P::HASBIAS) { pol.bias_load(cur, bv, wc, fq); G_INIT(); } else G_ZERO();
  i32x8 At[4], B0[2], B1[2];
  const char* cA0 = pol.abase(cur, 0); const char* cA1 = pol.abase(cur, 1); const char* cB = pol.bbase(cur);
  G_STAGE(G_SB(0, 0), cB, voffB); G_STAGE(G_SA(0, 0), cA0, vAc[0]); G_STAGE(G_SB(0, 1), cB + hstep, voffB); G_STAGE(G_SA(0, 1), cA1, vAc[1]);
  if (wr == 1) BAR;
  WAIT_V(4); BAR;
  G_STAGE(G_SB(1, 0), cB + kstep, voffB); G_STAGE(G_SA(1, 0), cA0 + kstep, vAc[0]); G_STAGE(G_SB(1, 1), cB + hstep + kstep, voffB);
  WAIT_V(6); BAR;
  for (;;) {
    const bool has_next = pol.get(ui + 1, nxt);
    const char* nA0 = has_next ? pol.abase(nxt, 0) : cA0; const char* nA1 = has_next ? pol.abase(nxt, 1) : cA1; const char* nB = has_next ? pol.bbase(nxt) : cB;
    if (P::GATHER && has_next) pol.arow_fill(nxt, (int*)(shm + GEMM_AROW_OFF) + ((ui + 1) & 1) * 256);
    for (int t = 0; t < nt; t += 2) {
      const bool last = (t == nt - 2);
      const size_t k1 = (size_t)(t + 1) * kstep, k2 = (size_t)(t + 2) * kstep;
      const char* a20 = last ? nA0 : cA0 + k2; const char* a21 = last ? nA1 : cA1 + k2; const char* b2 = last ? nB : cB + k2;
      G_LDB(B0, 0, 0); SCHED; G_LDA(At, 0, 0); G_STAGE(G_SA(1, 1), cA1 + k1, vAc[1]);
      WAIT_L(8); BAR; WAIT_L(0); G_MMA(0, 0, At, B0); BAR; SCHED;
      if (P::GATHER && last && has_next) { LAS int* tab = arow + ((ui + 1) & 1) * 256; G_GATHER_OFFS(tab); }
      G_LDB(B1, 0, 1); G_STAGE(G_SB(0, 0), b2, voffB);
      BAR; WAIT_L(0); G_MMA(0, 1, At, B1); BAR;
      G_LDA(At, 0, 1); G_STAGE(G_SA(0, 0), a20, vAc[0]);
      BAR; WAIT_L(0); G_MMA(1, 0, At, B0); BAR; SCHED;
      G_STAGE(G_SB(0, 1), b2 + hstep, voffB);
      WAIT_V(6); BAR; G_MMA(1, 1, At, B1); BAR;
      G_LDB(B0, 1, 0); SCHED; G_LDA(At, 1, 0); G_STAGE(G_SA(0, 1), a21, vAc[1]);
      WAIT_L(8); BAR; WAIT_L(0); G_MMA(0, 0, At, B0); BAR; SCHED;
      G_LDB(B1, 1, 1); G_STAGE(G_SB(1, 0), b2 + kstep, voffB);
      BAR; WAIT_L(0); G_MMA(0, 1, At, B1); BAR;
      G_LDA(At, 1, 1); G_STAGE(G_SA(1, 0), a20 + kstep, vAc[0]);
      BAR; WAIT_L(0); G_MMA(1, 0, At, B0); BAR; SCHED;
      G_STAGE(G_SB(1, 1), b2 + hstep + kstep, voffB);
      WAIT_V(6); BAR; G_MMA(1, 1, At, B1); BAR;
    }
    if (P::FP8) asm volatile("s_nop 7\n\ts_nop 7" ::: "memory");
    if (P::HASBIAS) pol.bias_load(has_next ? nxt : cur, bv, wc, fq);
    pol.epi(cur, acc, wr, wc, fr, fq);
    if (!has_next) break;
    if (P::HASBIAS) G_INIT(); else G_ZERO();
    cur = nxt; cA0 = nA0; cA1 = nA1; cB = nB; ++ui;
  }
  WAIT_V(0);
  if (wr == 0) BAR;
  __syncthreads();
#undef G_SA
#undef G_SB
#undef G_STAGE
#undef G_LDA
#undef G_LDB
#undef G_MMA
#undef G_LD2
#undef G_SRC
#undef G_GATHER_OFFS
#undef G_LO
#undef G_HI
#undef G_ZERO
#undef G_INIT
}

constexpr int MOE_TAB_OFF_ = GEMM_AROW_OFF + 2 * 256 * 4;
DEV void st_bf16x4(bf16_t* p, f32x4 v) { u32x2 o; o.x = cvt_pk_bf16(v[0], v[1]); o.y = cvt_pk_bf16(v[2], v[3]); *(u32x2*)p = o; }
DEV void st_bf16x8(bf16_t* p, f32x4 a, f32x4 b) { u32x4 o; o.x = cvt_pk_bf16(a[0], a[1]); o.y = cvt_pk_bf16(a[2], a[3]); o.z = cvt_pk_bf16(b[0], b[1]); o.w = cvt_pk_bf16(b[2], b[3]); *(u32x4*)p = o; }
DEV void st_fp8x8(unsigned char* p, f32x4 a, f32x4 b) { u32x2 o; o.x = cvt_pk4_fp8(a); o.y = cvt_pk4_fp8(b); *(u32x2*)p = o; }

DEV f32x4 sig4(f32x4 v) {
  const f32x4 t = v * -1.4426950408889634f; f32x4 e;
#pragma unroll
  for (int j = 0; j < 4; ++j) e[j] = __builtin_amdgcn_exp2f(t[j]);
  e = e + 1.0f; f32x4 r;
#pragma unroll
  for (int j = 0; j < 4; ++j) r[j] = __builtin_amdgcn_rcpf(e[j]);
  return r;
}
struct EpiIn {
  CParams* p; int pm, pn;
  template <int KIND> DEV void run(const AccT& acc, int wr, int wc, int fr, int fq) const;
  DEV void operator()(const AccT& acc, int wr, int wc, int fr, int fq) const {
    if (pn < 2) run<0>(acc, wr, wc, fr, fq); else if (pn == 2) run<1>(acc, wr, wc, fr, fq); else if (pn == 3) run<2>(acc, wr, wc, fr, fq);
    else if (pn < 8 || pn >= 20) run<3>(acc, wr, wc, fr, fq); else if (pn < 16) run<4>(acc, wr, wc, fr, fq); else run<5>(acc, wr, wc, fr, fq);
  }
};
DEV void row_to_bkey(int row, int& b, int& key) { if (row < NCTX) { b = row >> 8; key = row & 255; } else { const int r = row - NCTX; b = r >> 12; key = CTX + (r & 4095); } }

struct EpiKV {
  CParams* p; int pm, pn;
  DEV void operator()(const AccT& acc, int wr, int wc, int fr, int fq) const {
    CParams& P = *launder(p); const int row0 = pm * BM + wr * 64 + fr;
#pragma unroll
    for (int ai = 0; ai < 2; ++ai)
#pragma unroll
      for (int m = 0; m < 4; ++m) {
        const int row = row0 + ai * HALF + m * 16; int b, key; row_to_bkey(row, b, key);
        const long bh = (long)(b * NH + pn) * KEYS + key; const int c = wc * 32 + 8 * fq;
        st_bf16x8(P.kf + bh * QK + c, acc[ai][0][m][0], acc[ai][0][m][1]);
        st_bf16x8(P.vf + bh * DV + c, acc[ai][1][m][0], acc[ai][1][m][1]);
        if (wc == 0) { const u32x4* kp_ = (const u32x4*)(P.kr2 + (long)row * ROPE + 16 * fq); u32x4* dp_ = (u32x4*)(P.kf + bh * QK + 128 + 16 * fq); dp_[0] = kp_[0]; dp_[1] = kp_[1]; }
      }
  }
};
struct EpiQ {
  CParams* p; int pm, pn;
  DEV void operator()(const AccT& acc, int wr, int wc, int fr, int fq) const {
    CParams& P = *launder(p); const int row0 = pm * BM + wr * 64 + fr;
#pragma unroll
    for (int ai = 0; ai < 2; ++ai)
#pragma unroll
      for (int m = 0; m < 4; ++m) {
        const int row = row0 + ai * HALF + m * 16, b = row >> 12, t = row & 4095;
#pragma unroll
        for (int bj = 0; bj < 2; ++bj) {
          const int col = pn * 256 + bj * HALF + wc * 32 + 8 * fq, hh = col / QK, e = col - hh * QK;
          st_bf16x8(P.qf + ((long)(b * NH + hh) * SEQ + t) * QK + e, acc[ai][bj][m][0], acc[ai][bj][m][1]);
        }
      }
  }
};
struct EpiOut {
  CParams* p; int pm, pn;
  DEV void operator()(const AccT& acc, int wr, int wc, int fr, int fq) const;
};
constexpr int STG_OFF = ((MOE_TAB_OFF_ + (2 * MAXTILES + 2) * 4 + 15) / 16) * 16, STG_HALF = 9216;
template <int LB> DEV void stage_store_block(const unsigned (&v)[4][LB / 4], unsigned char* dst, long row_stride) {
  extern __shared__ __attribute__((aligned(16))) char shm[];
  constexpr int MP = LB == 8 ? 4 : (LB == 16 ? 2 : 1), PITCH = 16 * LB + 16, ROWS = 16 * MP;
  static_assert(ROWS * PITCH <= STG_HALF, "staging region");
  const int tid = ltid(), wr = tid >> 8, wc = (tid >> 6) & 3, fr = tid & 15, fq = (tid >> 4) & 3;
  char* stg = shm + STG_OFF + wr * STG_HALF;
  const int t4 = tid & 255;
#pragma unroll
  for (int ps = 0; ps < 4 / MP; ++ps) {
#pragma unroll
    for (int mm = 0; mm < MP; ++mm) {
      char* wp = stg + (16 * mm + fr) * PITCH + (4 * wc + fq) * LB; const int m = ps * MP + mm;
      if (LB == 8) *(u32x2*)wp = (u32x2){v[m][0], v[m][1]};
      else { *(u32x4*)wp = (u32x4){v[m][0], v[m][1], v[m][2], v[m][3]}; if (LB == 32) *(u32x4*)(wp + 16) = (u32x4){v[m][LB / 4 - 4], v[m][LB / 4 - 3], v[m][LB / 4 - 2], v[m][LB / 4 - 1]}; }
    }
    asm volatile("s_waitcnt lgkmcnt(0)" ::: "memory"); __builtin_amdgcn_s_barrier(); asm volatile("" ::: "memory");
#pragma unroll
    for (int k = 0; k < 2; ++k) { const int idx = k * 256 + t4, row = idx / LB, ch = idx % LB;
      *(u32x4*)(dst + (long)(ps * ROWS + row) * row_stride + ch * 16) = *(const u32x4*)(stg + row * PITCH + ch * 16); }
    asm volatile("s_waitcnt lgkmcnt(0)" ::: "memory"); __builtin_amdgcn_s_barrier(); asm volatile("" ::: "memory");
  }
}
DEV void pk_bf16x8(unsigned (&o)[4], f32x4 a, f32x4 b) { o[0] = cvt_pk_bf16(a[0], a[1]); o[1] = cvt_pk_bf16(a[2], a[3]); o[2] = cvt_pk_bf16(b[0], b[1]); o[3] = cvt_pk_bf16(b[2], b[3]); }
DEV void pk_f32x8(unsigned (&o)[8], f32x4 a, f32x4 b) {
#pragma unroll
  for (int j = 0; j < 4; ++j) { o[j] = __float_as_uint(a[j]); o[4 + j] = __float_as_uint(b[j]); } }
template <int KIND> DEV void EpiIn::run(const AccT& acc, int wr, int wc, int fr, int fq) const {
  CParams& P = *launder(p);
  const int rowh = pm * BM + wr * 64;
  if (KIND == 2) {
#pragma unroll
    for (int ai = 0; ai < 2; ++ai)
#pragma unroll
      for (int m = 0; m < 4; ++m) { const int row = rowh + fr + ai * HALF + m * 16, c = wc * 32 + 8 * fq;
        if (c < 64) { *(f32x4*)(P.kr + (long)row * ROPE + c) = acc[ai][0][m][0]; *(f32x4*)(P.kr + (long)row * ROPE + c + 4) = acc[ai][0][m][1]; } }
    return;
  }
  if (KIND == 0 && pm < 4) return;
  f32x4 lbv[2][2], oml[2][2];
  if (KIND == 4) {
    const int dir = (pn - 8) >> 2;
#pragma unroll
    for (int bj = 0; bj < 2; ++bj)
#pragma unroll
      for (int n = 0; n < 2; ++n) {
        const int col = ((pn - 8) & 3) * 256 + bj * HALF + wc * 32 + 8 * fq + 4 * n;
        const f32x4 a0 = *(const f32x4*)(P.hgrn_lb + dir * 2048 + col), a1 = *(const f32x4*)(P.hgrn_lb + dir * 2048 + 1024 + col);
#pragma unroll
        for (int j = 0; j < 4; ++j) lbv[bj][n][j] = sigmoidf_(a0[j] - a1[j]);
        oml[bj][n] = 1.0f - lbv[bj][n];
      }
  }
#pragma unroll
  for (int ai = 0; ai < 2; ++ai)
#pragma unroll
    for (int bj = 0; bj < 2; ++bj) {
      const long row = rowh + ai * HALF; const int cb = bj * HALF;
      if (KIND == 4) {
        unsigned vals[4][8];
#pragma unroll
        for (int m = 0; m < 4; ++m) pk_f32x8(vals[m], lbv[bj][0] + oml[bj][0] * sig4(acc[ai][bj][m][0]), lbv[bj][1] + oml[bj][1] * sig4(acc[ai][bj][m][1]));
        stage_store_block<32>(vals, (unsigned char*)(((pn - 8) >> 2 ? P.gb : P.gf) + row * 1024 + ((pn - 8) & 3) * 256 + cb), 1024 * 4);
      } else {
        unsigned vals[4][4];
#pragma unroll
        for (int m = 0; m < 4; ++m) {
          if (KIND == 3) pk_bf16x8(vals[m], acc[ai][bj][m][0] * sig4(acc[ai][bj][m][0]), acc[ai][bj][m][1] * sig4(acc[ai][bj][m][1]));
          else pk_bf16x8(vals[m], acc[ai][bj][m][0], acc[ai][bj][m][1]);
        }
        bf16_t* dst;
        if (KIND == 0) dst = P.cq + (row - NCTX) * QRANK + pn * 256 + cb;
        else if (KIND == 1) dst = P.ckv + row * KVRANK + cb;
        else if (KIND == 3) dst = (pn < 8 ? P.qh + (pn - 4) * 256 : P.gate + (pn - 20) * 256) + row * 1024 + cb;
        else dst = P.vh + row * 1024 + (pn - 16) * 256 + cb;
        stage_store_block<16>(vals, (unsigned char*)dst, (KIND == 0 ? QRANK : (KIND == 1 ? KVRANK : 1024)) * 2);
      }
    }
}
DEV void EpiOut::operator()(const AccT& acc, int wr, int wc, int fr, int fq) const {
  CParams& P = *launder(p);
#pragma unroll
  for (int ai = 0; ai < 2; ++ai)
#pragma unroll
    for (int bj = 0; bj < 2; ++bj) {
      unsigned vals[4][4];
#pragma unroll
      for (int m = 0; m < 4; ++m) pk_bf16x8(vals[m], acc[ai][bj][m][0], acc[ai][bj][m][1]);
      stage_store_block<16>(vals, (unsigned char*)(P.mix + (long)(pm * BM + ai * HALF + wr * 64) * DM + pn * 256 + bj * HALF), DM * 2);
    }
}
struct EpiGU {
  CParams* p; int e, srow0, pn;
  DEV static f32x4 act4(f32x4 g, f32x4 l) {
    constexpr float KS = -1.702f * 1.4426950408889634f;
    f32x4 a;
#pragma unroll
    for (int h2 = 0; h2 < 2; ++h2) {
      f32x2 gl, li1, sg;
      gl.x = fminf(g[2 * h2], 7.f); gl.y = fminf(g[2 * h2 + 1], 7.f);
      li1.x = fminf(fmaxf(l[2 * h2], -6.f), 8.f); li1.y = fminf(fmaxf(l[2 * h2 + 1], -6.f), 8.f);
      const f32x2 t = gl * KS;
      f32x2 d; d.x = __builtin_amdgcn_exp2f(t.x); d.y = __builtin_amdgcn_exp2f(t.y);
      d = d + 1.0f;
      sg.x = __builtin_amdgcn_rcpf(d.x); sg.y = __builtin_amdgcn_rcpf(d.y);
      const f32x2 r = (gl * sg) * li1;
      a[2 * h2] = r.x; a[2 * h2 + 1] = r.y;
    }
    return a;
  }
  DEV void operator()(const AccT& acc, int wr, int wc, int fr, int fq) const {
    CParams& P = *launder(p); const int row0 = srow0 + wr * 64 + fr;
    const int c = wc * 32 + 8 * fq;
#pragma unroll
    for (int ai = 0; ai < 2; ++ai) {
      unsigned vals[4][2];
#pragma unroll
      for (int m = 0; m < 4; ++m) { vals[m][0] = cvt_pk4_fp8(act4(acc[ai][0][m][0], acc[ai][1][m][0])); vals[m][1] = cvt_pk4_fp8(act4(acc[ai][0][m][1], acc[ai][1][m][1])); }
      stage_store_block<8>(vals, P.act8 + (long)(srow0 + ai * HALF + wr * 64) * DFF + pn * 128, DFF);
    }
  }
};
struct EpiDN {
  CParams* p; int e, srow0, pn;
  DEV void operator()(const AccT& acc, int wr, int wc, int fr, int fq) const {
    CParams& P = *launder(p); const int row0 = srow0 + wr * 64 + fr;
#pragma unroll
    for (int bj = 0; bj < 2; ++bj)
#pragma unroll
      for (int ai = 0; ai < 2; ++ai) {
        unsigned vals[4][2];
#pragma unroll
        for (int m = 0; m < 4; ++m) { vals[m][0] = cvt_pk4_fp8(acc[ai][bj][m][0]); vals[m][1] = cvt_pk4_fp8(acc[ai][bj][m][1]); }
        stage_store_block<8>(vals, P.ys8 + (long)(srow0 + ai * HALF + wr * 64) * DM + pn * 256 + bj * HALF, DM);
      }
  }
};

struct PolIn {
  static constexpr bool GATHER = false;
  static constexpr bool FP8 = false, HASBIAS = false; static constexpr int SCALE_A = 0, SCALE_B = 0;
  CParams* p; const char* A; const char* B; int wg, nwg, KB, part;
  DEV bool get(int i, Unit& u) const {
    const int id = wg + i * nwg;
    if (part) { if (id >= 64) return false; u.pn = 23; u.pm = 4 + id; u.e = 0; u.r0 = 0; return true; }
    if (id >= 1528) return false;
    if (id < 1472) { u.pn = id >> 6; u.pm = 4 + (id & 63); } else { const int v = id - 1472, j = v >> 2; u.pm = v & 3; u.pn = j < 2 ? 2 + j : 6 + j; }
    u.e = 0; u.r0 = 0; return true; }
  DEV const char* abase(const Unit& u, int half) const { return A + (size_t)(u.pm * BM + half * HALF) * KB; }
  DEV const char* bbase(const Unit& u) const { return B + (size_t)(u.pn * BM) * KB; }
  DEV void arow_fill(const Unit&, int*) const {}
  DEV void bias_load(const Unit&, f32x4 (&)[2][2], int, int) const {}
  DEV void epi(const Unit& u, const AccT& acc, int wr, int wc, int fr, int fq) const { EpiIn e{p, u.pm, u.pn}; e(acc, wr, wc, fr, fq); }
};
DEV void phase2_inproj(CParams& p, int wg, int nwg) { PolIn pol{&p, (const char*)p.h, (const char*)p.wt_in, wg, nwg, DM * 2, 0}; gemm_stream(pol); }

struct PolKV {
  static constexpr bool GATHER = false;
  static constexpr bool FP8 = false, HASBIAS = false; static constexpr int SCALE_A = 0, SCALE_B = 0;
  CParams* p; const char* A; const char* B; int wg, nwg, KB;
  DEV bool get(int i, Unit& u) const { const int id = wg + i * nwg; if (id >= 68 * 8) return false; u.pn = id / 68; u.pm = id % 68; u.e = 0; u.r0 = 0; return true; }
  DEV const char* abase(const Unit& u, int half) const { return A + (size_t)(u.pm * BM + half * HALF) * KB; }
  DEV const char* bbase(const Unit& u) const { return B + (size_t)(u.pn * BM) * KB; }
  DEV void arow_fill(const Unit&, int*) const {}
  DEV void bias_load(const Unit&, f32x4 (&)[2][2], int, int) const {}
  DEV void epi(const Unit& u, const AccT& acc, int wr, int wc, int fr, int fq) const { EpiKV e{p, u.pm, u.pn}; e(acc, wr, wc, fr, fq); }
};
struct PolQ {
  static constexpr bool GATHER = false;
  static constexpr bool FP8 = false, HASBIAS = false; static constexpr int SCALE_A = 0, SCALE_B = 0;
  CParams* p; const char* A; const char* B; int wg, nwg, KB;
  DEV bool get(int i, Unit& u) const { const int id = wg + i * nwg; if (id >= 64 * 6) return false; u.pn = id >> 6; u.pm = id & 63; u.e = 0; u.r0 = 0; return true; }
  DEV const char* abase(const Unit& u, int half) const { return A + (size_t)(u.pm * BM + half * HALF) * KB; }
  DEV const char* bbase(const Unit& u) const { return B + (size_t)(u.pn * BM) * KB; }
  DEV void arow_fill(const Unit&, int*) const {}
  DEV void bias_load(const Unit&, f32x4 (&)[2][2], int, int) const {}
  DEV void epi(const Unit& u, const AccT& acc, int wr, int wc, int fr, int fq) const { EpiQ e{p, u.pm, u.pn}; e(acc, wr, wc, fr, fq); }
};
DEV void phase4_up(CParams& p, int wg, int nwg) {
  if (nwg >= 128) {
    if (wg < 64) { PolIn pol{&p, (const char*)p.h, (const char*)p.wt_in, wg, nwg, DM * 2, 1}; gemm_stream(pol); }
    else {
      { PolKV pol{&p, (const char*)p.ckvn, (const char*)p.wt_ukv, wg - 64, nwg - 64, KVRANK * 2}; gemm_stream(pol); }
      { PolQ pol{&p, (const char*)p.cqn, (const char*)p.wt_uq, (wg - 64 + 32) % (nwg - 64), nwg - 64, QRANK * 2}; gemm_stream(pol); }
    }
  } else {
    { PolIn pol{&p, (const char*)p.h, (const char*)p.wt_in, wg, nwg, DM * 2, 1}; gemm_stream(pol); }
    { PolKV pol{&p, (const char*)p.ckvn, (const char*)p.wt_ukv, wg, nwg, KVRANK * 2}; gemm_stream(pol); }
    { PolQ pol{&p, (const char*)p.cqn, (const char*)p.wt_uq, wg, nwg, QRANK * 2}; gemm_stream(pol); }
  }
}
struct PolOut {
  static constexpr bool GATHER = false;
  static constexpr bool FP8 = false, HASBIAS = false; static constexpr int SCALE_A = 0, SCALE_B = 0;
  CParams* p; const char* A; const char* B; int wg, nwg, KB;
  DEV bool get(int i, Unit& u) const { const int id = wg + i * nwg; if (id >= 64 * 8) return false; u.pn = id >> 6; u.pm = id & 63; u.e = 0; u.r0 = 0; return true; }
  DEV const char* abase(const Unit& u, int half) const { return A + (size_t)(u.pm * BM + half * HALF) * KB; }
  DEV const char* bbase(const Unit& u) const { return B + (size_t)(u.pn * BM) * KB; }
  DEV void arow_fill(const Unit&, int*) const {}
  DEV void bias_load(const Unit&, f32x4 (&)[2][2], int, int) const {}
  DEV void epi(const Unit& u, const AccT& acc, int wr, int wc, int fr, int fq) const { EpiOut e{p, u.pm, u.pn}; e(acc, wr, wc, fr, fq); }
};
DEV void phase6_outproj(CParams& p, int wg, int nwg) { PolOut pol{&p, (const char*)p.aout, (const char*)p.wt_out, wg, nwg, DM * 2}; gemm_stream(pol); }

constexpr int MOE_TAB_OFF = MOE_TAB_OFF_;
DEV int moe_prefix(CParams& p, int* tile_e, int* tile_r0) {
  const int t = ltid();
  if (t < 64) {
    const int c = t < NE ? p.cnt[t] : 0, n = (c + 255) >> 8; int inc = n;
#pragma unroll
    for (int st = 1; st < 32; st <<= 1) { const int v = __shfl_up(inc, st); if ((t & 63) >= st) inc += v; }
    const int first = inc - n;
    if (t < NE) for (int i = 0; i < n; ++i) { tile_e[first + i] = t; tile_r0[first + i] = i * 256; }
    if (t == NE - 1) tile_e[MAXTILES] = inc;
  }
  __syncthreads();
  return tile_e[MAXTILES];
}
struct PolGU {
  static constexpr bool GATHER = true, FP8 = true, HASBIAS = true; static constexpr int SCALE_A = FP8_SCALE_1, SCALE_B = FP8_SCALE_W;
  CParams* p; const char* A; const char* B; const int* tile_e; const int* tile_r0; int ntot, rbase, rstep, pncol, KB, noepi;
  DEV bool get(int i, Unit& u) const {
    u.pm = rstep * i + rbase; u.pn = pncol; if (u.pm >= ntot) return false;
    u.e = __builtin_amdgcn_readfirstlane(tile_e[u.pm]); u.r0 = __builtin_amdgcn_readfirstlane(tile_r0[u.pm]); return true; }
  DEV const char* abase(const Unit&, int) const { return A; }
  DEV const char* bbase(const Unit& u) const { return B + ((size_t)u.e * 4096 + u.pn * BM) * KB; }
  DEV void arow_fill(const Unit& u, int* tab) const { const int t = ltid(); if (t < 256) { const int r = u.r0 + t; tab[t] = r < p->cnt[u.e] ? p->idx[u.e * NLAT + r] : 0; } }
  DEV void bias_load(const Unit& u, f32x4 (&bv)[2][2], int wc, int fq) const {
    const float* bg = p->b_gu + (long)u.e * 4096 + u.pn * 128 + wc * 32 + 8 * fq;
    bv[0][0] = *(const f32x4*)bg; bv[0][1] = *(const f32x4*)(bg + 4); bv[1][0] = *(const f32x4*)(bg + 2048) + 1.0f; bv[1][1] = *(const f32x4*)(bg + 2052) + 1.0f; }
  DEV void epi(const Unit& u, const AccT& acc, int wr, int wc, int fr, int fq) const { if (noepi) return; EpiGU e{p, u.e, u.pm * 256, u.pn}; e(acc, wr, wc, fr, fq); }
};
struct PolDN {
  static constexpr bool GATHER = false, FP8 = true, HASBIAS = true; static constexpr int SCALE_A = FP8_SCALE_1, SCALE_B = FP8_SCALE_W;
  CParams* p; const char* A; const char* B; const int* tile_e; int ntot, rbase, rstep, pncol, KB, noepi;
  DEV bool get(int i, Unit& u) const {
    u.pm = rstep * i + rbase; u.pn = pncol; if (u.pm >= ntot) return false;
    u.e = __builtin_amdgcn_readfirstlane(tile_e[u.pm]); u.r0 = 0; return true; }
  DEV const char* abase(const Unit& u, int half) const { return A + (size_t)(u.pm * BM + half * HALF) * KB; }
  DEV const char* bbase(const Unit& u) const { return B + ((size_t)u.e * 2048 + u.pn * BM) * KB; }
  DEV void arow_fill(const Unit&, int*) const {}
  DEV void bias_load(const Unit& u, f32x4 (&bv)[2][2], int wc, int fq) const {
    const float* bd = p->b_dn + (long)u.e * 2048 + u.pn * 256 + wc * 32 + 8 * fq;
    bv[0][0] = *(const f32x4*)bd; bv[0][1] = *(const f32x4*)(bd + 4); bv[1][0] = *(const f32x4*)(bd + HALF); bv[1][1] = *(const f32x4*)(bd + HALF + 4); }
  DEV void epi(const Unit& u, const AccT& acc, int wr, int wc, int fr, int fq) const { if (noepi) return; EpiDN e{p, u.e, u.pm * 256, u.pn}; e(acc, wr, wc, fr, fq); }
};
template <int WHICH> DEV void phase_moe(CParams& p, int wg, int nwg, int noepi = 0) {
  extern __shared__ __attribute__((aligned(16))) char shm[];
  int* tile_e = (int*)(shm + MOE_TAB_OFF); int* tile_r0 = tile_e + MAXTILES + 1;
  const int ntiles = moe_prefix(p, tile_e, tile_r0);
  constexpr int NC = WHICH == 0 ? 16 : 8;
  int rbase, rstep, pncol;
  if (nwg == 256) { const int x = wg & 7, y = wg >> 3; rstep = 256 / NC; if (WHICH == 0) { rbase = 4 * (x >> 1) + (y >> 3); pncol = 8 * (x & 1) + (y & 7); } else { rbase = 4 * x + (y >> 3); pncol = y & 7; } }
  else { rbase = wg / NC; rstep = nwg / NC; pncol = wg % NC; }
  if (WHICH == 0) { PolGU pol{&p, (const char*)p.h2_8, (const char*)p.wt_gu8, tile_e, tile_r0, ntiles, rbase, rstep, pncol, DM, noepi}; gemm_stream(pol); }
  else { PolDN pol{&p, (const char*)p.act8, (const char*)p.wt_dn8, tile_e, ntiles, rbase, rstep, pncol, DFF, noepi}; gemm_stream(pol); }
}
DEV void phase3_rows(CParams& p, int wg, int nwg) {
  const int wid = ltid() >> 6, lane = ltid() & 63;
  for (int row = wg * 8 + wid; row < NROW; row += nwg * 8) {
    if (row >= NCTX) {
      const int lr = row - NCTX;
      const u32x4 raw = *(const u32x4*)(p.cq + (long)lr * QRANK + lane * 8);
      float v[8]; v[0] = bflo(raw.x); v[1] = bfhi(raw.x); v[2] = bflo(raw.y); v[3] = bfhi(raw.y); v[4] = bflo(raw.z); v[5] = bfhi(raw.z); v[6] = bflo(raw.w); v[7] = bfhi(raw.w);
      float ss = 0.f;
#pragma unroll
      for (int j = 0; j < 8; ++j) ss += v[j] * v[j];
      ss = wave_sum(ss); const float rstd = rsqrtf(ss * (1.f / QRANK) + EPS);
      const f32x4 w0 = *(const f32x4*)(p.q_norm + lane * 8), w1 = *(const f32x4*)(p.q_norm + lane * 8 + 4);
      u32x4 o; o.x = cvt_pk_bf16(v[0] * rstd * w0[0], v[1] * rstd * w0[1]); o.y = cvt_pk_bf16(v[2] * rstd * w0[2], v[3] * rstd * w0[3]);
      o.z = cvt_pk_bf16(v[4] * rstd * w1[0], v[5] * rstd * w1[1]); o.w = cvt_pk_bf16(v[6] * rstd * w1[2], v[7] * rstd * w1[3]);
      *(u32x4*)(p.cqn + (long)lr * QRANK + lane * 8) = o;
    }
    {
      const u32x2 raw = *(const u32x2*)(p.ckv + (long)row * KVRANK + lane * 4);
      float v[4]; v[0] = bflo(raw.x); v[1] = bfhi(raw.x); v[2] = bflo(raw.y); v[3] = bfhi(raw.y);
      float ss = v[0] * v[0] + v[1] * v[1] + v[2] * v[2] + v[3] * v[3];
      ss = wave_sum(ss); const float rstd = rsqrtf(ss * (1.f / KVRANK) + EPS);
      const f32x4 w0 = *(const f32x4*)(p.kv_norm + lane * 4);
      u32x2 o; o.x = cvt_pk_bf16(v[0] * rstd * w0[0], v[1] * rstd * w0[1]); o.y = cvt_pk_bf16(v[2] * rstd * w0[2], v[3] * rstd * w0[3]);
      *(u32x2*)(p.ckvn + (long)row * KVRANK + lane * 4) = o;
    }
    {
      const float kv = p.kr[(long)row * ROPE + lane];
      const float other = __shfl_xor(kv, 32);
      float o = kv;
      int b, key; row_to_bkey(row, b, key);
      if (row >= NCTX) {
        const int t = (row - NCTX) & 4095, a = lane & 31;
        const float cs = p.rope[t * 64 + a], sn = p.rope[t * 64 + 32 + a];
        o = lane < 32 ? kv * cs - other * sn : other * sn + kv * cs;
      }
      p.kr2[(long)row * ROPE + lane] = f2bf(o);
    }
  }
}

DEV void phase5c_rec(CParams& p, int wg, int nwg) {
  const int wid = ltid() >> 6, lane = ltid() & 63;
  for (int row = wg * 8 + wid; row < NLAT; row += nwg * 8) {
    const bf16_t* a = p.of + (long)row * 1024 + lane * 16; const bf16_t* b = p.ob + (long)row * 1024 + lane * 16;
    const u32x4 a0 = *(const u32x4*)a, a1 = *(const u32x4*)(a + 8), b0 = *(const u32x4*)b, b1 = *(const u32x4*)(b + 8);
    const unsigned aw[8] = {a0.x, a0.y, a0.z, a0.w, a1.x, a1.y, a1.z, a1.w}, bw[8] = {b0.x, b0.y, b0.z, b0.w, b1.x, b1.y, b1.z, b1.w};
    float v[16]; float ss = 0.f;
#pragma unroll
    for (int i = 0; i < 8; ++i) { v[2 * i] = bflo(aw[i]) + bflo(bw[i]); v[2 * i + 1] = bfhi(aw[i]) + bfhi(bw[i]); ss += v[2 * i] * v[2 * i] + v[2 * i + 1] * v[2 * i + 1]; }
    ss += __shfl_xor(ss, 1); ss += __shfl_xor(ss, 2); ss += __shfl_xor(ss, 4);
    const float rstd = rsqrtf(ss * (1.f / DV) + EPS);
    const bf16_t* gp = p.gate + (long)(NCTX + row) * 1024 + lane * 16;
    const u32x4 g0 = *(const u32x4*)gp, g1 = *(const u32x4*)(gp + 8);
    float gt[16]; gt[0] = bflo(g0.x); gt[1] = bfhi(g0.x); gt[2] = bflo(g0.y); gt[3] = bfhi(g0.y); gt[4] = bflo(g0.z); gt[5] = bfhi(g0.z); gt[6] = bflo(g0.w); gt[7] = bfhi(g0.w);
    gt[8] = bflo(g1.x); gt[9] = bfhi(g1.x); gt[10] = bflo(g1.y); gt[11] = bfhi(g1.y); gt[12] = bflo(g1.z); gt[13] = bfhi(g1.z); gt[14] = bflo(g1.w); gt[15] = bfhi(g1.w);
    const float* gn = p.g_norm + (lane & 7) * 16;
    unsigned o[8];
#pragma unroll
    for (int j = 0; j < 8; ++j) o[j] = cvt_pk_bf16(v[2 * j] * rstd * gn[2 * j] * gt[2 * j], v[2 * j + 1] * rstd * gn[2 * j + 1] * gt[2 * j + 1]);
    bf16_t* op = p.aout + (long)row * DM + 1024 + lane * 16;
    *(u32x4*)op = (u32x4){o[0], o[1], o[2], o[3]}; *(u32x4*)(op + 8) = (u32x4){o[4], o[5], o[6], o[7]};
  }
}

constexpr int H2S_LD = 2052;
template <bool ROUTE> DEV void phase7_post(CParams& p, int wg, int nwg) {
  extern __shared__ __attribute__((aligned(16))) char shm[];
  float* h2s = (float*)shm;
  float* red = (float*)(shm + 16 * H2S_LD * 4);
  const int tid = ltid(), wid = tid >> 6, lane = tid & 63;
  for (int g = wg; g < NLAT / 16; g += nwg) {
#pragma unroll 1
    for (int rr = 0; rr < 2; ++rr) {
      const int lr = wid * 2 + rr, row = g * 16 + lr, b = row >> 12;
      const float* mod = p.mod + b * 12288;
      const bf16_t* mr = p.mix + (long)row * DM; const float* xr = p.x + (long)row * DM;
      f32x4 v[8], xv[8]; u32x2 m2[8]; float ss = 0.f;
#pragma unroll
      for (int i = 0; i < 8; ++i) m2[i] = *(const u32x2*)(mr + i * 256 + lane * 4);
#pragma unroll
      for (int i = 0; i < 8; ++i) xv[i] = *(const f32x4*)(xr + i * 256 + lane * 4);
#pragma unroll
      for (int i = 0; i < 8; ++i) { v[i] = (f32x4){bflo(m2[i].x), bfhi(m2[i].x), bflo(m2[i].y), bfhi(m2[i].y)};
        ss += v[i][0] * v[i][0] + v[i][1] * v[i][1] + v[i][2] * v[i][2] + v[i][3] * v[i][3]; }
      ss = wave_sum(ss); const float rstd = rsqrtf(ss * (1.f / DM) + EPS);
      float s2 = 0.f;
#pragma unroll
      for (int i = 0; i < 8; ++i) {
        const int c0 = i * 256 + lane * 4;
        const f32x4 w = *(const f32x4*)(p.ln_mix_post + c0), gm = *(const f32x4*)(mod + 4096 + c0), xx = xv[i];
#pragma unroll
        for (int j = 0; j < 4; ++j) { v[i][j] = xx[j] + gm[j] * (v[i][j] * rstd * w[j]); s2 += v[i][j] * v[i][j]; }
        st_bf16x4(p.x1 + (long)row * DM + c0, v[i]);
      }
      s2 = wave_sum(s2); const float rstd2 = rsqrtf(s2 * (1.f / DM) + EPS);
#pragma unroll
      for (int i = 0; i < 8; ++i) {
        const int c0 = i * 256 + lane * 4;
        const f32x4 w = *(const f32x4*)(p.ln_ffn_pre + c0), s1 = *(const f32x4*)(mod + 8192 + c0), s0 = *(const f32x4*)(mod + 6144 + c0);
        f32x4 y;
#pragma unroll
        for (int j = 0; j < 4; ++j) y[j] = v[i][j] * rstd2 * w[j] * (1.f + s1[j]) + s0[j];
        *(unsigned*)(p.h2_8 + (long)row * DM + c0) = cvt_pk4_fp8(y);
        *(f32x4*)(h2s + lr * H2S_LD + c0) = y;
      }
    }
    {
      f32x4 a0 = {0.f, 0.f, 0.f, 0.f}, a1 = {0.f, 0.f, 0.f, 0.f};
      const int r16 = lane & 15, kq = lane >> 4;
      const float* ap = h2s + r16 * H2S_LD + wid * 256 + kq;
      const float* bp = p.router_w + (long)(wid * 256 + kq) * NE + r16;
      float bw0[16], bw1[16];
#pragma unroll
      for (int s = 0; s < 16; ++s) { bw0[s] = bp[(long)(4 * s) * NE]; bw1[s] = bp[(long)(4 * s) * NE + 16]; }
      __syncthreads();
#pragma unroll
      for (int s = 0; s < 16; ++s) {
        const float av = ap[4 * s];
        a0 = __builtin_amdgcn_mfma_f32_16x16x4f32(av, bw0[s], a0, 0, 0, 0);
        a1 = __builtin_amdgcn_mfma_f32_16x16x4f32(av, bw1[s], a1, 0, 0, 0);
      }
#pragma unroll 16
      for (int s = 16; s < 64; ++s) {
        const float av = ap[4 * s], b0 = bp[(long)(4 * s) * NE], b1 = bp[(long)(4 * s) * NE + 16];
        a0 = __builtin_amdgcn_mfma_f32_16x16x4f32(av, b0, a0, 0, 0, 0);
        a1 = __builtin_amdgcn_mfma_f32_16x16x4f32(av, b1, a1, 0, 0, 0);
      }
#pragma unroll
      for (int j = 0; j < 4; ++j) { red[(wid * 16 + 4 * kq + j) * 32 + r16] = a0[j]; red[(wid * 16 + 4 * kq + j) * 32 + 16 + r16] = a1[j]; }
    }
    __syncthreads();
    {
      const int r = tid >> 5, e = tid & 31; float sl = p.router_b[e];
#pragma unroll
      for (int w = 0; w < 8; ++w) sl += red[(w * 16 + r) * 32 + e];
      if (ROUTE) {
        const int row = g * 16 + r;
        float sv[4]; int sel[4];
#pragma unroll
        for (int k = 0; k < 4; ++k) {
          float bv = sl; int bi = e;
#pragma unroll
          for (int st = 1; st < 32; st <<= 1) { const float ov = __shfl_xor(bv, st); const int oi = __shfl_xor(bi, st); const bool take = ov > bv || (ov == bv && oi < bi); bv = take ? ov : bv; bi = take ? oi : bi; }
          sv[k] = bv; sel[k] = bi; if (e == bi) sl = -3.0e38f;
        }
        const float e1 = __expf(sv[1] - sv[0]), e2 = __expf(sv[2] - sv[0]), e3 = __expf(sv[3] - sv[0]), inv = 1.f / (1.f + e1 + e2 + e3);
        if (e < 4) {
          const int se = e == 0 ? sel[0] : (e == 1 ? sel[1] : (e == 2 ? sel[2] : sel[3]));
          const float gk = (e == 0 ? 1.f : (e == 1 ? e1 : (e == 2 ? e2 : e3))) * inv;
          const int pos = atomicAdd(p.cnt + se, 1);
          p.idx[se * NLAT + pos] = row;
          p.tok_e[row * 4 + e] = se; p.tok_pos[row * 4 + e] = pos; p.tok_gate[row * 4 + e] = gk;
        }
      }
    }
  }
}

DEV void phase11_final(CParams& p, int wg, int nwg) {
  extern __shared__ __attribute__((aligned(16))) char shm[];
  int* rowbase = (int*)shm;
  if (ltid() == 0) { int nt = 0; for (int e = 0; e < NE; ++e) { rowbase[e] = nt * 256; nt += (p.cnt[e] + 255) >> 8; } }
  __syncthreads();
  const int wid = ltid() >> 6, lane = ltid() & 63;
  i32x4 te_n, tp_n; f32x4 tg_n;
  { const int r0 = wg * 8 + wid; if (r0 < NLAT) { te_n = *(const i32x4*)(p.tok_e + r0 * 4); tp_n = *(const i32x4*)(p.tok_pos + r0 * 4); tg_n = *(const f32x4*)(p.tok_gate + r0 * 4); } }
  for (int row = wg * 8 + wid; row < NLAT; row += nwg * 8) {
    const int b = row >> 12; const float* mod = p.mod + b * 12288;
    const i32x4 te = te_n, tp = tp_n; const f32x4 tg = tg_n;
    { const int rn = row + nwg * 8; if (rn < NLAT) { te_n = *(const i32x4*)(p.tok_e + rn * 4); tp_n = *(const i32x4*)(p.tok_pos + rn * 4); tg_n = *(const f32x4*)(p.tok_gate + rn * 4); } }
    f32x4 y[2][4]; u32x4 xr[2][2];
#pragma unroll
    for (int i = 0; i < 2; ++i) { const bf16_t* xp = p.x1 + (long)row * DM + 1024 * i + lane * 16; xr[i][0] = *(const u32x4*)xp; xr[i][1] = *(const u32x4*)(xp + 8); }
#pragma unroll
    for (int i = 0; i < 2; ++i)
#pragma unroll
      for (int j = 0; j < 4; ++j) y[i][j] = (f32x4){0.f, 0.f, 0.f, 0.f};
#pragma unroll
    for (int k = 0; k < 4; ++k) {
      const int e = te[k], pos = tp[k]; const float gt = tg[k];
      const unsigned char* yr = p.ys8 + (long)(rowbase[e] + pos) * DM + lane * 16;
#pragma unroll
      for (int i = 0; i < 2; ++i) {
        const u32x4 r = *(const u32x4*)(yr + 1024 * i); const unsigned rw[4] = {r.x, r.y, r.z, r.w};
#pragma unroll
        for (int j = 0; j < 4; ++j) { const f32x2 lo = __builtin_amdgcn_cvt_pk_f32_fp8(rw[j], false), hi = __builtin_amdgcn_cvt_pk_f32_fp8(rw[j], true);
          y[i][j][0] += gt * lo.x; y[i][j][1] += gt * lo.y; y[i][j][2] += gt * hi.x; y[i][j][3] += gt * hi.y; }
      }
    }
    float ss = 0.f;
#pragma unroll
    for (int i = 0; i < 2; ++i)
#pragma unroll
      for (int j = 0; j < 4; ++j) ss += y[i][j][0] * y[i][j][0] + y[i][j][1] * y[i][j][1] + y[i][j][2] * y[i][j][2] + y[i][j][3] * y[i][j][3];
    ss = wave_sum(ss); const float rstd = rsqrtf(ss * (1.f / DM) + EPS);
#pragma unroll
    for (int i = 0; i < 2; ++i)
#pragma unroll
      for (int j = 0; j < 4; ++j) {
        const int c0 = 1024 * i + lane * 16 + 4 * j;
        const f32x4 w = *(const f32x4*)(p.ln_ffn_post + c0), gf = *(const f32x4*)(mod + 10240 + c0);
        const unsigned x01 = xr[i][j >> 1][(j & 1) * 2], x23 = xr[i][j >> 1][(j & 1) * 2 + 1]; const f32x4 xx = {bflo(x01), bfhi(x01), bflo(x23), bfhi(x23)};
        f32x4 o;
#pragma unroll
        for (int jj = 0; jj < 4; ++jj) o[jj] = xx[jj] + gf[jj] * (y[i][j][jj] * rstd * w[jj]);
        *(f32x4*)(p.out + (long)row * DM + c0) = o;
      }
  }
}
namespace att {
constexpr int NW = 8, QBLK = 32, KVBLK = 64;
constexpr float SCALE = 0.07216878364870322f;
constexpr float THR = 8.f;
constexpr int SHM_V = KVBLK * DV * 2, SHM_K = KVBLK * 512;
constexpr int LDS_BYTES = 2 * SHM_V + 2 * SHM_K + NW * 64 * 4;
#define KSWZ2(row, colB) ((row) * 512 + ((colB) ^ (((row) & 15) << 4)))
#define SBAR() __builtin_amdgcn_sched_barrier(0)
DEV int crow(int r, int hi) { return (r & 3) + 8 * (r >> 2) + 4 * hi; }

DEV void partialSM(f32x16& p0, f32x16& p1, float& m_reg, float& mn, float& alpha) {
  constexpr float C = SCALE * 1.4426950408889634f;
  float pmax = p0[0];
#pragma unroll
  for (int r = 1; r < 16; ++r) pmax = fmaxf(pmax, p0[r]);
#pragma unroll
  for (int r = 0; r < 16; ++r) pmax = fmaxf(pmax, p1[r]);
  { auto rr = __builtin_amdgcn_permlane32_swap(__float_as_uint(pmax), __float_as_uint(pmax), false, false);
    pmax = fmaxf(__uint_as_float(rr[0]), __uint_as_float(rr[1])); }
  if (__builtin_expect(__all(pmax - m_reg <= THR / SCALE), 1)) { mn = m_reg; alpha = 1.f; }
  else { mn = fmaxf(m_reg, pmax); alpha = __builtin_amdgcn_exp2f((m_reg - mn) * C); m_reg = mn; }
  const float mnC = -mn * C;
#pragma unroll
  for (int r = 0; r < 16; ++r) p0[r] = fmaf(p0[r], C, mnC);
#pragma unroll
  for (int r = 0; r < 16; ++r) p1[r] = fmaf(p1[r], C, mnC);
#pragma unroll
  for (int r = 0; r < 16; ++r) p0[r] = __builtin_amdgcn_exp2f(p0[r]);
}
DEV void finishSM(f32x16& p0, f32x16& p1, float alpha, float& l_reg, bf16x8& pa0, bf16x8& pa1, bf16x8& pa2, bf16x8& pa3) {
#pragma unroll
  for (int r = 0; r < 16; ++r) p1[r] = __builtin_amdgcn_exp2f(p1[r]);
  float ps = 0;
#pragma unroll
  for (int r = 0; r < 16; ++r) ps += p0[r];
#pragma unroll
  for (int r = 0; r < 16; ++r) ps += p1[r];
  { auto rr = __builtin_amdgcn_permlane32_swap(__float_as_uint(ps), __float_as_uint(ps), false, false);
    ps = __uint_as_float(rr[0]) + __uint_as_float(rr[1]); }
  l_reg = l_reg * alpha + ps;
#define PK4(P, BASE, OUT) do { unsigned a0 = cvt_pk_bf16(P[BASE + 0], P[BASE + 1]), a1 = cvt_pk_bf16(P[BASE + 2], P[BASE + 3]);   \
    unsigned b0 = cvt_pk_bf16(P[BASE + 4], P[BASE + 5]), b1 = cvt_pk_bf16(P[BASE + 6], P[BASE + 7]);                              \
    auto r0 = __builtin_amdgcn_permlane32_swap(a0, b0, false, false); auto r1 = __builtin_amdgcn_permlane32_swap(a1, b1, false, false); \
    u32x4 w = {r0[0], r1[0], r0[1], r1[1]}; OUT = *reinterpret_cast<bf16x8*>(&w); } while (0)
  PK4(p0, 0, pa0); PK4(p0, 8, pa1); PK4(p1, 0, pa2); PK4(p1, 8, pa3);
#undef PK4
}
DEV void qkt(f32x16& p0, f32x16& p1, const char* Ks, const bf16x8* qr, int r32, int hi) {
  p0 = f32x16{}; p1 = f32x16{};
#pragma unroll
  for (int d0 = 0; d0 < 12; ++d0) { const int cb = (d0 * 16 + hi * 8) * 2;
    const bf16x8 b0 = *reinterpret_cast<const bf16x8*>(Ks + KSWZ2(r32, cb));
    const bf16x8 b1 = *reinterpret_cast<const bf16x8*>(Ks + KSWZ2(32 + r32, cb));
    p0 = __builtin_amdgcn_mfma_f32_32x32x16_bf16(b0, qr[d0], p0, 0, 0, 0);
    p1 = __builtin_amdgcn_mfma_f32_32x32x16_bf16(b1, qr[d0], p1, 0, 0, 0); }
}
DEV int v_st(int k, int c) { const int kk = (k & ~0xC) | ((k & 4) << 1) | ((k & 8) >> 1); return ((kk >> 3) * 4 + (c >> 5)) * 512 + ((kk & 7) * 32 + (c & 31)) * 2; }
DEV int v_rd_base(int lane) { return ((lane & 3) << 3) | (((lane >> 2) & 3) << 6) | (((lane >> 4) & 1) << 5) | (((lane >> 5) & 1) << 8); }
constexpr int v_rd_off(int d0, int ks, int half) { return d0 * 512 + ks * 4096 + half * 2048; }
template <int OFF> DEV s16x4 tr_read(int vb) { s16x4 r; asm volatile("ds_read_b64_tr_b16 %0, %1 offset:%2" : "=&v"(r) : "v"(vb), "i"(OFF) : "memory"); return r; }
struct VFrag { s16x4 l0, h0, l1, h1, l2, h2, l3, h3; };
template <int D0> DEV void pv_read(VFrag& f, int vb) {
  f.l0 = tr_read<v_rd_off(D0, 0, 0)>(vb); f.h0 = tr_read<v_rd_off(D0, 0, 1)>(vb); f.l1 = tr_read<v_rd_off(D0, 1, 0)>(vb); f.h1 = tr_read<v_rd_off(D0, 1, 1)>(vb);
  f.l2 = tr_read<v_rd_off(D0, 2, 0)>(vb); f.h2 = tr_read<v_rd_off(D0, 2, 1)>(vb); f.l3 = tr_read<v_rd_off(D0, 3, 0)>(vb); f.h3 = tr_read<v_rd_off(D0, 3, 1)>(vb);
}
DEV void pv_mma(f32x16& od, const VFrag& f, bf16x8 pa0, bf16x8 pa1, bf16x8 pa2, bf16x8 pa3) {
#define PK(L, H) (bf16x8){L[0], L[1], L[2], L[3], H[0], H[1], H[2], H[3]}
  od = __builtin_amdgcn_mfma_f32_32x32x16_bf16(pa0, PK(f.l0, f.h0), od, 0, 0, 0);
  od = __builtin_amdgcn_mfma_f32_32x32x16_bf16(pa1, PK(f.l1, f.h1), od, 0, 0, 0);
  od = __builtin_amdgcn_mfma_f32_32x32x16_bf16(pa2, PK(f.l2, f.h2), od, 0, 0, 0);
  od = __builtin_amdgcn_mfma_f32_32x32x16_bf16(pa3, PK(f.l3, f.h3), od, 0, 0, 0);
#undef PK
}
#define PV_WAIT(n) do { asm volatile("s_waitcnt lgkmcnt(" #n ")" ::: "memory"); SBAR(); } while (0)
DEV void pv_d0(f32x16* o, int vb, bf16x8 pa0, bf16x8 pa1, bf16x8 pa2, bf16x8 pa3) {
  VFrag fa, fb;
  pv_read<0>(fa, vb);
  pv_read<1>(fb, vb); PV_WAIT(8); pv_mma(o[0], fa, pa0, pa1, pa2, pa3); SBAR();
  pv_read<2>(fa, vb); PV_WAIT(8); pv_mma(o[1], fb, pa0, pa1, pa2, pa3); SBAR();
  pv_read<3>(fb, vb); PV_WAIT(8); pv_mma(o[2], fa, pa0, pa1, pa2, pa3); SBAR();
  PV_WAIT(0); pv_mma(o[3], fb, pa0, pa1, pa2, pa3);
}

DEV void attn_unit(const bf16_t* __restrict__ Qb, const bf16_t* __restrict__ Kh, const bf16_t* __restrict__ Vh, const float* __restrict__ rp, bf16_t* __restrict__ Ob, CParams& fp, int fwg, int fbase, int fn) {
  extern __shared__ __attribute__((aligned(16))) char shm[];
  const int tid = ltid(), wid = tid >> 6, lane = tid & 63, r32 = lane & 31, hi = lane >> 5;
  char* V_lds = shm; char* K_lds = shm + 2 * SHM_V;
  float* ws = (float*)(shm + 2 * SHM_V + 2 * SHM_K) + wid * 64; float* li_l = ws; float* al_l = ws + 32;
  float m_reg = -1e30f, l_reg = 0; f32x16 o[4] = {}; bf16x8 qr[12];
  {
    const bf16_t* Qw = Qb + (long)(wid * QBLK + r32) * QK + hi * 8;
#pragma unroll
    for (int d0 = 0; d0 < 12; ++d0) qr[d0] = *reinterpret_cast<const bf16x8*>(Qw + d0 * 16);
    const float* rr = rp + (long)(wid * QBLK + r32) * 64;
#pragma unroll
    for (int dd = 0; dd < 2; ++dd) {
      const int a0 = 16 * dd + 8 * hi;
      const f32x4 c0 = *(const f32x4*)(rr + a0), c1 = *(const f32x4*)(rr + a0 + 4), s0 = *(const f32x4*)(rr + 32 + a0), s1 = *(const f32x4*)(rr + 32 + a0 + 4);
      float cs[8] = {c0[0], c0[1], c0[2], c0[3], c1[0], c1[1], c1[2], c1[3]}, sn[8] = {s0[0], s0[1], s0[2], s0[3], s1[0], s1[1], s1[2], s1[3]};
      const bf16x8 x1 = qr[8 + dd], x2 = qr[10 + dd]; bf16x8 y1, y2;
#pragma unroll
      for (int j = 0; j < 8; j += 2) {
        const float a1 = bf2f((bf16_t)x1[j]), a2 = bf2f((bf16_t)x2[j]), b1 = bf2f((bf16_t)x1[j + 1]), b2 = bf2f((bf16_t)x2[j + 1]);
        const unsigned u1 = cvt_pk_bf16(a1 * cs[j] - a2 * sn[j], b1 * cs[j + 1] - b2 * sn[j + 1]);
        const unsigned u2 = cvt_pk_bf16(a1 * sn[j] + a2 * cs[j], b1 * sn[j + 1] + b2 * cs[j + 1]);
        y1[j] = (short)(u1 & 0xffff); y1[j + 1] = (short)(u1 >> 16); y2[j] = (short)(u2 & 0xffff); y2[j + 1] = (short)(u2 >> 16);
      }
      qr[8 + dd] = y1; qr[10 + dd] = y2;
    }
  }
  const int sr = tid >> 4, sc = (tid & 15) * 8, vst0 = v_st(sr, sc), vst1 = v_st(32 + sr, sc);
  int kst[3];
#pragma unroll
  for (int i = 0; i < 3; ++i) { const int id = tid + 512 * i, row = id / 24, ch = id % 24; kst[i] = KSWZ2(row, ch * 16); }
  const int vb0 = (int)(uintptr_t)V_lds + v_rd_base(lane);
  bf16x8 vs0, vs1, ks0, ks1, ks2;
#define SLOAD(k0) do { vs0 = *reinterpret_cast<const bf16x8*>(Vh + (long)((k0) + sr) * DV + sc); vs1 = *reinterpret_cast<const bf16x8*>(Vh + (long)((k0) + 32 + sr) * DV + sc); \
    const bf16_t* kp_ = Kh + (long)(k0) * QK + tid * 8; ks0 = *reinterpret_cast<const bf16x8*>(kp_); ks1 = *reinterpret_cast<const bf16x8*>(kp_ + 4096); ks2 = *reinterpret_cast<const bf16x8*>(kp_ + 8192); } while (0)
#define SWRITE(b) do { *(bf16x8*)(V_lds + (b) * SHM_V + vst0) = vs0; *(bf16x8*)(V_lds + (b) * SHM_V + vst1) = vs1; \
    *(bf16x8*)(K_lds + (b) * SHM_K + kst[0]) = ks0; *(bf16x8*)(K_lds + (b) * SHM_K + kst[1]) = ks1; *(bf16x8*)(K_lds + (b) * SHM_K + kst[2]) = ks2; } while (0)
#define SWAIT() asm volatile("s_waitcnt vmcnt(0)" ::: "memory")
#define RESC(a) do { if (__any((a) < 1.f)) { if (hi == 0) al_l[r32] = (a); asm volatile("s_waitcnt lgkmcnt(0)" ::: "memory"); \
    _Pragma("unroll") for (int d = 0; d < 4; ++d) _Pragma("unroll") for (int r = 0; r < 16; ++r) o[d][r] *= al_l[crow(r, hi)]; } } while (0)
  f32x16 p0, p1; float mn, al; bf16x8 pa0, pa1, pa2, pa3; constexpr int NTL = KEYS / KVBLK;
  f32x4 fld[4];
  if (fn > 0) fill_load(fp, fwg, fbase, fld);
  SLOAD(0); SWAIT(); SWRITE(0); SLOAD(KVBLK); __syncthreads();
#pragma unroll 1
  for (int j = 0; j < NTL; ++j) {
    const int cb = j & 1;
    if (j + 1 < NTL) { if (j >= 2 && j < fn) asm volatile("s_waitcnt vmcnt(5)" ::: "memory"); else SWAIT(); SWRITE(cb ^ 1); }
    if (j + 2 < NTL) SLOAD((j + 2) * KVBLK);
    if (j > 0 && j <= fn) fill_store(fp, fwg, fbase + j - 1, (j - 1) & 1);
    SBAR(); qkt(p0, p1, K_lds + cb * SHM_K, qr, r32, hi);
    partialSM(p0, p1, m_reg, mn, al);
    RESC(al);
    finishSM(p0, p1, al, l_reg, pa0, pa1, pa2, pa3); SBAR();
    pv_d0(o, vb0 + cb * SHM_V, pa0, pa1, pa2, pa3);
    if (j < fn) { fill_write(fld, j & 1); if (j + 1 < fn) fill_load(fp, fwg, fbase + j + 1, fld); }
    __syncthreads();
  }
  if (fn == NTL) fill_store(fp, fwg, fbase + NTL - 1, (NTL - 1) & 1);
  if (hi == 0) li_l[r32] = l_reg;
  asm volatile("s_waitcnt lgkmcnt(0)" ::: "memory");
  float rli[16];
#pragma unroll
  for (int r = 0; r < 16; ++r) rli[r] = __builtin_amdgcn_rcpf(li_l[crow(r, hi)]);
  bf16_t* Ow = Ob + (long)(wid * QBLK) * DM;
#pragma unroll
  for (int r = 0; r < 16; ++r) { const int orow = crow(r, hi);
#pragma unroll
    for (int d0 = 0; d0 < 4; ++d0) Ow[(long)orow * DM + d0 * 32 + r32] = f2bf(o[d0][r] * rli[r]); }
  __syncthreads();
#undef SLOAD
#undef SWRITE
#undef SWAIT
#undef RESC
}
}

DEV void phase5a_attn(CParams& p, int u, int fwg = 0, int fbase = 0, int fn = 0) {
  const int qb = u & 15, h = (u >> 4) & 7, b = u >> 7;
  const long bh = b * NH + h;
  att::attn_unit(p.qf + (bh * SEQ + qb * 256) * QK, p.kf + bh * KEYS * QK, p.vf + bh * KEYS * DV, p.rope + (long)(qb * 256) * 64,
                 p.aout + (long)(b * SEQ + qb * 256) * DM + h * DV, p, fwg, fbase, fn);
}
namespace hg {
constexpr int LQ = 136, LS = 72;
constexpr int O_QT = 0, O_KT = O_QT + 64 * LQ * 2, O_KHT = O_KT + 64 * LQ * 2, O_VT = O_KHT + 128 * LS * 2, O_ST = O_VT + 32 * LS * 2, BUF = O_ST + 32 * LQ * 2;
constexpr int LDS_BYTES = 2 * BUF;
DEV bf16x8 ld8(const char* p) { return *reinterpret_cast<const bf16x8*>(p); }
DEV bf16x8 ld44(const char* p0, const char* p1) { const s16x4 a = *reinterpret_cast<const s16x4*>(p0), b = *reinterpret_cast<const s16x4*>(p1); return (bf16x8){a[0], a[1], a[2], a[3], b[0], b[1], b[2], b[3]}; }

DEV void hgrn_unit(CParams& p, int u, int wg, bool fill) {
  extern __shared__ __attribute__((aligned(16))) char shm[];
  const int sl = u & 3, dir = (u >> 2) & 1, h = (u >> 3) & 7, b = u >> 6;
  const int tid = ltid(), wid = tid >> 6, lane = tid & 63, fr = lane & 15, fq = lane >> 4;
  const int dp = lane & 7, seg = lane >> 3, d0 = 16 * wid + 2 * dp;
  const float* G = dir ? p.gb : p.gf;
  bf16_t* O = dir ? p.ob : p.of;
  const int sgn = dir ? -1 : 1;
#define HG_ROW0(c_, r0_) do { if ((c_) < 4) r0_ = dir ? b * 256 + 255 - 64 * (c_) : b * 256 + 64 * (c_); \
    else r0_ = dir ? NCTX + b * 4096 + 4095 - 64 * ((c_) - 4) : NCTX + b * 4096 + 64 * ((c_) - 4); } while (0)
#define HG_LOAD(c_, G_, Q_, V_) do { int r0n_; HG_ROW0(c_, r0n_); \
    _Pragma("unroll") for (int ii = 0; ii < 8; ++ii) { const long row_ = r0n_ + sgn * (8 * seg + ii); G_[ii] = *(const f32x2*)(G + row_ * 1024 + h * 128 + d0); Q_[ii] = *(const unsigned*)(p.qh + row_ * 1024 + h * 128 + d0); } \
    { const long row_ = r0n_ + sgn * (tid >> 3); V_ = *(const u32x2*)(p.vh + row_ * 1024 + h * 128 + sl * 32 + (tid & 7) * 4); } } while (0)
  f32x4 S[2] = {{0.f, 0.f, 0.f, 0.f}, {0.f, 0.f, 0.f, 0.f}};
  float dec = 0.f;
  f32x2 g[8]; unsigned q[8]; u32x2 v;
  f32x2 gN[8]; unsigned qN[8]; u32x2 vN;
#define HG_ELEM(cn_, LATN_) do { char* bufn = shm + ((cn_) & 1) * BUF; \
    { bf16_t* VT = (bf16_t*)(bufn + O_VT); const int i = tid >> 3, e4 = (tid & 7) * 4; \
      VT[(e4 + 0) * LS + i] = (bf16_t)(v.x & 0xffff); VT[(e4 + 1) * LS + i] = (bf16_t)(v.x >> 16); VT[(e4 + 2) * LS + i] = (bf16_t)(v.y & 0xffff); VT[(e4 + 3) * LS + i] = (bf16_t)(v.y >> 16); } \
    f32x2 cp[8]; cp[0] = g[0]; \
    _Pragma("unroll") for (int ii = 1; ii < 8; ++ii) cp[ii] = cp[ii - 1] * g[ii]; \
    f32x2 inc = cp[7]; \
    _Pragma("unroll") for (int st = 8; st < 64; st <<= 1) { const float t0 = __shfl_up(inc[0], st), t1 = __shfl_up(inc[1], st); if (lane >= st) { inc[0] *= t0; inc[1] *= t1; } } \
    f32x2 off; { const float t0 = __shfl_up(inc[0], 8), t1 = __shfl_up(inc[1], 8); off[0] = lane >= 8 ? t0 : 1.f; off[1] = lane >= 8 ? t1 : 1.f; } \
    f32x2 BL, R; BL[0] = __shfl(inc[0], dp + 56); BL[1] = __shfl(inc[1], dp + 56); R[0] = __shfl(inc[0], dp + 24); R[1] = __shfl(inc[1], dp + 24); \
    const float Ri0 = __builtin_amdgcn_rcpf(fmaxf(R[0], 1e-35f)), Ri1 = __builtin_amdgcn_rcpf(fmaxf(R[1], 1e-35f)); \
    const float ebl0 = BL[0] * Ri0, ebl1 = BL[1] * Ri1; \
    const float b0s = __shfl(BL[0], fr >> 1), b1s = __shfl(BL[1], fr >> 1), r0s = __shfl(R[0], fr >> 1), r1s = __shfl(R[1], fr >> 1); \
    dec = (fr & 1) ? b1s : b0s; \
    if (LATN_) { const float er = (fr & 1) ? r1s : r0s; bf16_t* ST = (bf16_t*)(bufn + O_ST); \
      _Pragma("unroll") for (int eb = 0; eb < 2; ++eb) _Pragma("unroll") for (int j = 0; j < 4; ++j) ST[(eb * 16 + 4 * fq + j) * LQ + wid * 16 + fr] = f2bf(S[eb][j] * er); } \
    unsigned kh0[4], kh1[4]; \
    _Pragma("unroll") for (int ii = 0; ii < 8; ii += 2) { float k0v[2], k1v[2]; \
      _Pragma("unroll") for (int z = 0; z < 2; ++z) { const int i = 8 * seg + ii + z; \
        const float E0 = fminf(fmaxf(off[0] * cp[ii + z][0] * Ri0, 1e-30f), 1e30f), E1 = fminf(fmaxf(off[1] * cp[ii + z][1] * Ri1, 1e-30f), 1e30f); \
        const float Ei0 = __builtin_amdgcn_rcpf(E0), Ei1 = __builtin_amdgcn_rcpf(E1); \
        const float kt0 = (1.f - g[ii + z][0]) * Ei0, kt1 = (1.f - g[ii + z][1]) * Ei1; \
        *(unsigned*)(bufn + O_KT + (i * LQ + d0) * 2) = cvt_pk_bf16(kt0, kt1); \
        if (LATN_) *(unsigned*)(bufn + O_QT + (i * LQ + d0) * 2) = cvt_pk_bf16(bflo(q[ii + z]) * E0, bfhi(q[ii + z]) * E1); \
        k0v[z] = kt0 * ebl0; k1v[z] = kt1 * ebl1; } \
      kh0[ii >> 1] = cvt_pk_bf16(k0v[0], k0v[1]); kh1[ii >> 1] = cvt_pk_bf16(k1v[0], k1v[1]); } \
    *(u32x4*)(bufn + O_KHT + (d0 * LS + 8 * seg) * 2) = (u32x4){kh0[0], kh0[1], kh0[2], kh0[3]}; \
    *(u32x4*)(bufn + O_KHT + ((d0 + 1) * LS + 8 * seg) * 2) = (u32x4){kh1[0], kh1[1], kh1[2], kh1[3]}; } while (0)
#define HG_MMA(c_, LATC_) do { const char* bufc = shm + ((c_) & 1) * BUF; \
    if (LATC_) { const int tb = wid >> 1, eb = wid & 1; f32x4 P[4]; \
      _Pragma("unroll") for (int sb = 0; sb < 4; ++sb) { P[sb] = (f32x4){0.f, 0.f, 0.f, 0.f}; \
        if (sb <= tb) { \
          _Pragma("unroll") for (int ks = 0; ks < 4; ++ks) { \
            const bf16x8 a = ld8(bufc + O_KT + ((sb * 16 + fr) * LQ + 32 * ks + 8 * fq) * 2), bq = ld8(bufc + O_QT + ((tb * 16 + fr) * LQ + 32 * ks + 8 * fq) * 2); \
            P[sb] = __builtin_amdgcn_mfma_f32_16x16x32_bf16(a, bq, P[sb], 0, 0, 0); }        \
          if (sb == tb) { _Pragma("unroll") for (int j = 0; j < 4; ++j) P[sb][j] = (4 * fq + j <= fr) ? P[sb][j] : 0.f; } } } \
      f32x4 acc = {0.f, 0.f, 0.f, 0.f}; \
      _Pragma("unroll") for (int pr = 0; pr < 2; ++pr) {        \
        if (2 * pr <= tb) { \
          const u32x4 pw = {cvt_pk_bf16(P[2 * pr][0], P[2 * pr][1]), cvt_pk_bf16(P[2 * pr][2], P[2 * pr][3]), cvt_pk_bf16(P[2 * pr + 1][0], P[2 * pr + 1][1]), cvt_pk_bf16(P[2 * pr + 1][2], P[2 * pr + 1][3])}; \
          const char* vrow = bufc + O_VT + ((eb * 16 + fr) * LS + 32 * pr + 4 * fq) * 2; \
          acc = __builtin_amdgcn_mfma_f32_16x16x32_bf16(ld44(vrow, vrow + 32), __builtin_bit_cast(bf16x8, pw), acc, 0, 0, 0); } } \
      _Pragma("unroll") for (int ks = 0; ks < 4; ++ks) { \
        const bf16x8 a = ld8(bufc + O_ST + ((eb * 16 + fr) * LQ + 32 * ks + 8 * fq) * 2), bq = ld8(bufc + O_QT + ((tb * 16 + fr) * LQ + 32 * ks + 8 * fq) * 2); \
        acc = __builtin_amdgcn_mfma_f32_16x16x32_bf16(a, bq, acc, 0, 0, 0); } \
      int r0; HG_ROW0(c_, r0); const long row = r0 + sgn * (tb * 16 + fr) - NCTX; \
      st_bf16x4(O + row * 1024 + h * 128 + sl * 32 + eb * 16 + 4 * fq, acc); }        \
    _Pragma("unroll") for (int eb = 0; eb < 2; ++eb) { f32x4 acc = S[eb] * dec; \
      _Pragma("unroll") for (int ks = 0; ks < 2; ++ks) { \
        const bf16x8 a = ld8(bufc + O_VT + ((eb * 16 + fr) * LS + 32 * ks + 8 * fq) * 2), bk = ld8(bufc + O_KHT + ((wid * 16 + fr) * LS + 32 * ks + 8 * fq) * 2); \
        acc = __builtin_amdgcn_mfma_f32_16x16x32_bf16(a, bk, acc, 0, 0, 0); } \
      S[eb] = acc; } } while (0)
#define HG_STEP(c_, LATC_, LATN_, FLD_) do { HG_LOAD((c_) + 2 < 68 ? (c_) + 2 : 67, gN, qN, vN); if (fill && (c_) > 0 && (c_) <= FILL_HG) fill_store(p, wg, (c_) - 1, ((c_) - 1) & 1); \
    HG_MMA(c_, LATC_); HG_ELEM((c_) + 1, LATN_); if (fill && (c_) < FILL_HG) { fill_write(FLD_, (c_) & 1); if ((c_) + 2 < FILL_HG) fill_load(p, wg, (c_) + 2, FLD_); } __syncthreads(); \
    _Pragma("unroll") for (int ii = 0; ii < 8; ++ii) { g[ii] = gN[ii]; q[ii] = qN[ii]; } v = vN; } while (0)
  f32x4 fldA[4], fldB[4];
  if (fill && FILL_HG > 0) { fill_load(p, wg, 0, fldA); if (FILL_HG > 1) fill_load(p, wg, 1, fldB); }
  HG_LOAD(0, g, q, v);
  HG_ELEM(0, false);
  HG_LOAD(1, g, q, v);
  __syncthreads();
  HG_STEP(0, false, false, fldA); HG_STEP(1, false, false, fldB); HG_STEP(2, false, false, fldA);
  HG_STEP(3, false, true, fldB);
#pragma unroll 1
  for (int c = 4; c < 66; c += 2) { HG_STEP(c, true, true, fldA); HG_STEP(c + 1, true, true, fldB); }
  HG_STEP(66, true, true, fldA);
  HG_MMA(67, true);
  __syncthreads();
  if (fill && FILL_HG == 67) fill_store(p, wg, 66, 0);
#undef HG_ELEM
#undef HG_MMA
#undef HG_STEP
#undef HG_ROW0
#undef HG_LOAD
}
}

#define XB_TMO      128
#define XB_XCNT(j)  (256  + 64 * (j))
#define XB_XSUB(j)  (1280 + 64 * (j))
#define XB_XGEN(j)  (2304 + 64 * (j))
#define XB_TOP      3328
#define XB_TOPGEN   3392
#define XCD_BAR_WORDS 3456
#define XB_SPIN_CAP (1u << 21)

__device__ __forceinline__ unsigned xb_ld(unsigned* p)              { return __hip_atomic_load(p, __ATOMIC_RELAXED, __HIP_MEMORY_SCOPE_AGENT); }
__device__ __forceinline__ unsigned xb_add(unsigned* p, unsigned v) { return __hip_atomic_fetch_add(p, v, __ATOMIC_RELAXED, __HIP_MEMORY_SCOPE_AGENT); }
__device__ __forceinline__ unsigned xb_xcc_id() { return (unsigned)__builtin_amdgcn_s_getreg((3 << 11) | 20) & 0xFu; }
#define XB_SPIN(cond, bar) do { unsigned _sp = 0; while (cond) { __builtin_amdgcn_s_sleep(1); \
    if ((++_sp & 255u) == 0u) { if (xb_ld(&(bar)[XB_TMO])) break; if (_sp > XB_SPIN_CAP) { atomicAdd(&(bar)[XB_TMO], 1u); break; } } } } while (0)

struct XcdBarrier {
    unsigned* bar; unsigned x;
    volatile LAS unsigned* st;
};

__device__ __forceinline__ XcdBarrier xcd_barrier_post(unsigned* bar, volatile LAS unsigned* st) {
    XcdBarrier b; b.bar = bar; b.x = xb_xcc_id(); b.st = st;
    if (threadIdx.x == 0) (void)xb_add(&bar[XB_XCNT(b.x)], 1u);
    return b;
}
__device__ __forceinline__ void xcd_barrier_complete(unsigned* bar, unsigned x, unsigned& nloc, unsigned& nx) {
    const unsigned G = gridDim.x * gridDim.y * gridDim.z;
    unsigned sum, cnt, mine, sp = 0u;
    for (;;) {
        sum = 0u; cnt = 0u; mine = 0u;
#pragma unroll
        for (unsigned j = 0; j < 16; ++j) { const unsigned c = xb_ld(&bar[XB_XCNT(j)]); sum += c; cnt += (c > 0u) ? 1u : 0u; mine = (j == x) ? c : mine; }
        if (sum == G) break;
        __builtin_amdgcn_s_sleep(1);
        if ((++sp & 255u) == 0u) { if (xb_ld(&bar[XB_TMO])) break; if (sp > XB_SPIN_CAP) { atomicAdd(&bar[XB_TMO], 1u); break; } }
    }
    nloc = mine > 0u ? mine : 1u; nx = cnt > 0u ? cnt : 1u;
}

__device__ __forceinline__ void xcd_barrier(const XcdBarrier& b) {
    asm volatile("s_waitcnt vmcnt(0)" ::: "memory");
    __syncthreads();
    if (threadIdx.x == 0) {
        unsigned* bar = b.bar;
        __builtin_amdgcn_s_waitcnt(0);
        unsigned nloc = b.st[0], nx = b.st[1];
        if (nloc == 0u) { xcd_barrier_complete(bar, b.x, nloc, nx); b.st[0] = nloc; b.st[1] = nx; }
        const unsigned old = xb_add(&bar[XB_XSUB(b.x)], 1u);
        const unsigned gen = old / nloc;
        if (old + 1u == (gen + 1u) * nloc) {
            __builtin_amdgcn_fence(__ATOMIC_RELEASE, "agent");
            asm volatile("s_waitcnt vmcnt(0)" ::: "memory");
            const unsigned og = xb_add(&bar[XB_TOP], 1u);
            const unsigned tg = og / nx;
            if (og + 1u == (tg + 1u) * nx) xb_add(&bar[XB_TOPGEN], 1u);
            else XB_SPIN(xb_ld(&bar[XB_TOPGEN]) == tg, bar);
            __builtin_amdgcn_fence(__ATOMIC_ACQUIRE, "agent");
            xb_add(&bar[XB_XGEN(b.x)], 1u);
            asm volatile("s_waitcnt vmcnt(0)" ::: "memory");
        } else {
            XB_SPIN(xb_ld(&bar[XB_XGEN(b.x)]) == gen, bar);
            __builtin_amdgcn_fence(__ATOMIC_ACQUIRE, "agent");
            asm volatile("s_waitcnt vmcnt(0)" ::: "memory");
        }
    }
    __syncthreads();
}


constexpr int LDS_MAX = 160 * 1024;
constexpr int XB_LDS_OFF = LDS_MAX - 16;

__global__ void __launch_bounds__(NT, 2) k_mega(Params p) {
  extern __shared__ __attribute__((aligned(16))) char shm[];
  const int wg = blockIdx.x, nwg = gridDim.x;
  CParams* kp = KARGS;
  if (threadIdx.x == 0) *(uint4*)(shm + XB_LDS_OFF) = make_uint4(0u, 0u, 0u, 0u);
  __syncthreads();
  XcdBarrier bar = xcd_barrier_post(kp->bar, (volatile LAS unsigned*)(shm + XB_LDS_OFF));
  phase0(*launder(kp), wg, nwg);
  xcd_barrier(bar);
  phase1_rows(*launder(kp), wg, nwg);
  xcd_barrier(bar);
  phase2_inproj(*launder(kp), wg, nwg);
  xcd_barrier(bar);
  phase3_rows(*launder(kp), wg, nwg);
  xcd_barrier(bar);
  phase4_up(*launder(kp), wg, nwg);
  xcd_barrier(bar);
  if (nwg == 256) {
    const int x = wg & 7, y = wg >> 3; const bool late = (y >> 2) & 1;
    if (!late) hg::hgrn_unit(*launder(kp), 4 * (x + 8 * (y >> 2)) + (y & 3), wg, true);
    phase5a_attn(*launder(kp), 16 * (2 * x + (y >> 4)) + (y & 15), wg, FILL_HG, FILL_A0);
    if (late) hg::hgrn_unit(*launder(kp), 4 * (x + 8 * (y >> 2)) + (y & 3), wg, true);
    phase5a_attn(*launder(kp), 16 * (16 + 2 * x + (y >> 4)) + (y & 15), wg, FILL_HG + FILL_A0, FILL_A1);
  } else {
    for (int u = wg; u < 256; u += nwg) hg::hgrn_unit(*launder(kp), u, wg, false);
    for (int u = wg; u < 512; u += nwg) phase5a_attn(*launder(kp), u);
  }
  xcd_barrier(bar);
  phase5c_rec(*launder(kp), wg, nwg);
  xcd_barrier(bar);
  phase6_outproj(*launder(kp), wg, nwg);
  xcd_barrier(bar);
  phase7_post<true>(*launder(kp), wg, nwg);
  xcd_barrier(bar);
  phase_moe<0>(*launder(kp), wg, nwg);
  xcd_barrier(bar);
  phase_moe<1>(*launder(kp), wg, nwg);
  xcd_barrier(bar);
  phase11_final(*launder(kp), wg, nwg);
}

static size_t carve(size_t& off, size_t bytes) { const size_t o = off; off += (bytes + 255) & ~(size_t)255; return o; }

extern "C" void kernel_launch(void* const* d_in, const int* in_sizes, int n_in, void* d_out, int out_size, void* d_ws, size_t ws_size, hipStream_t stream) {
  Params p{};
  p.x = (const float*)d_in[0]; p.c = (const float*)d_in[1]; p.ctx = (const float*)d_in[2]; p.c_ctx = (const float*)d_in[3]; p.w_mod = (const float*)d_in[4]; p.b_mod = (const float*)d_in[5];
  p.ln_mix_pre = (const float*)d_in[6]; p.ln_mix_post = (const float*)d_in[7]; p.ln_ffn_pre = (const float*)d_in[8]; p.ln_ffn_post = (const float*)d_in[9]; p.w_in = (const float*)d_in[10];
  p.q_norm = (const float*)d_in[11]; p.kv_norm = (const float*)d_in[12]; p.w_uq = (const float*)d_in[13]; p.w_ukv = (const float*)d_in[14]; p.hgrn_lb = (const float*)d_in[15];
  p.g_norm = (const float*)d_in[16]; p.w_out = (const float*)d_in[17]; p.router_w = (const float*)d_in[18]; p.router_b = (const float*)d_in[19]; p.w_gu = (const float*)d_in[20];
  p.b_gu = (const float*)d_in[21]; p.w_dn = (const float*)d_in[22]; p.b_dn = (const float*)d_in[23];
  p.out = (float*)d_out;
  char* ws = (char*)d_ws; size_t off = 0;
  p.bar = (unsigned*)(ws + carve(off, 16384));
  p.cnt = (int*)(ws + carve(off, 256));
  const size_t zero_bytes = off;
  p.wt_in = (bf16_t*)(ws + carve(off, (size_t)INCP * 2048 * 2)); p.wt_uq = (bf16_t*)(ws + carve(off, (size_t)1536 * 512 * 2)); p.wt_ukv = (bf16_t*)(ws + carve(off, (size_t)2048 * 256 * 2));
  p.wt_out = (bf16_t*)(ws + carve(off, (size_t)2048 * 2048 * 2)); p.wt_gu8 = (unsigned char*)(ws + carve(off, (size_t)NE * 4096 * 2048)); p.wt_dn8 = (unsigned char*)(ws + carve(off, (size_t)NE * 2048 * 2048));
  p.mod = (float*)(ws + carve(off, 5 * 12288 * 4)); p.rope = (float*)(ws + carve(off, 4096 * 64 * 4));
  p.h = (bf16_t*)(ws + carve(off, (size_t)NROW * DM * 2));
  p.cq = (bf16_t*)(ws + carve(off, (size_t)NLAT * QRANK * 2)); p.cqn = (bf16_t*)(ws + carve(off, (size_t)NLAT * QRANK * 2));
  p.ckv = (bf16_t*)(ws + carve(off, (size_t)NROW * KVRANK * 2)); p.ckvn = (bf16_t*)(ws + carve(off, (size_t)NROW * KVRANK * 2));
  p.kr = (float*)(ws + carve(off, (size_t)NROW * ROPE * 4)); p.kr2 = (bf16_t*)(ws + carve(off, (size_t)NROW * ROPE * 2));
  p.qh = (bf16_t*)(ws + carve(off, (size_t)NROW * 1024 * 2)); p.gf = (float*)(ws + carve(off, (size_t)NROW * 1024 * 4)); p.gb = (float*)(ws + carve(off, (size_t)NROW * 1024 * 4));
  p.vh = (bf16_t*)(ws + carve(off, (size_t)NROW * 1024 * 2)); p.gate = (bf16_t*)(ws + carve(off, (size_t)NROW * 1024 * 2));
  p.qf = (bf16_t*)(ws + carve(off, (size_t)NBATCH * NH * SEQ * QK * 2)); p.kf = (bf16_t*)(ws + carve(off, (size_t)NBATCH * NH * KEYS * QK * 2)); p.vf = (bf16_t*)(ws + carve(off, (size_t)NBATCH * NH * KEYS * DV * 2));
  p.aout = (bf16_t*)(ws + carve(off, (size_t)NLAT * DM * 2)); p.of = (bf16_t*)(ws + carve(off, (size_t)NLAT * 1024 * 2)); p.ob = (bf16_t*)(ws + carve(off, (size_t)NLAT * 1024 * 2));
  p.mix = (bf16_t*)(ws + carve(off, (size_t)NLAT * DM * 2)); p.x1 = (bf16_t*)(ws + carve(off, (size_t)NLAT * DM * 2)); p.h2_8 = (unsigned char*)(ws + carve(off, (size_t)NLAT * DM));
  p.tok_e = (int*)(ws + carve(off, (size_t)NLAT * 4 * 4)); p.tok_pos = (int*)(ws + carve(off, (size_t)NLAT * 4 * 4)); p.tok_gate = (float*)(ws + carve(off, (size_t)NLAT * 4 * 4));
  p.idx = (int*)(ws + carve(off, (size_t)NE * NLAT * 4));
  p.act8 = (unsigned char*)(ws + carve(off, (size_t)MAXSLOT * DFF)); p.ys8 = (unsigned char*)(ws + carve(off, (size_t)MAXSLOT * DM));
  if (off > ws_size) { fprintf(stderr, "kernel_launch: workspace too small: need %zu have %zu\n", off, ws_size); return; }
  static int grid = 0;
  if (!grid) {
    if (hipFuncSetAttribute((const void*)k_mega, hipFuncAttributeMaxDynamicSharedMemorySize, LDS_MAX) != hipSuccess) { fprintf(stderr, "kernel_launch: hipFuncSetAttribute failed\n"); return; }
    int dev = 0, cus = 0, per_cu = 0;
    (void)hipGetDevice(&dev);
    (void)hipDeviceGetAttribute(&cus, hipDeviceAttributeMultiprocessorCount, dev);
    (void)hipOccupancyMaxActiveBlocksPerMultiprocessor(&per_cu, k_mega, NT, LDS_MAX);
    if (per_cu < 1 || cus < 1) { fprintf(stderr, "kernel_launch: occupancy query says %d blocks per CU on %d CUs\n", per_cu, cus); return; }
    grid = cus & ~15;
  }
  (void)hipMemsetAsync(ws, 0, zero_bytes, stream);
  hipLaunchKernelGGL(k_mega, dim3(grid), dim3(NT), LDS_MAX, stream, p);
  const hipError_t le = hipPeekAtLastError();
  if (le != hipSuccess) fprintf(stderr, "kernel_launch: launch failed: %s\n", hipGetErrorName(le));
}
```

```cpp
#include <hip/hip_runtime.h>
#include <stdint.h>
#include <stdio.h>

#define DEV __device__ __forceinline__
typedef unsigned short bf16_t;
typedef short bf16x8 __attribute__((ext_vector_type(8)));
typedef short s16x4 __attribute__((ext_vector_type(4)));
typedef float f32x4 __attribute__((ext_vector_type(4)));
typedef float f32x2 __attribute__((ext_vector_type(2)));
typedef float f32x16 __attribute__((ext_vector_type(16)));
typedef unsigned u32x4 __attribute__((ext_vector_type(4)));
typedef unsigned u32x2 __attribute__((ext_vector_type(2)));

constexpr int DM = 2048, NBATCH = 4, SEQ = 4096, CTX = 256, KEYS = CTX + SEQ;
constexpr int NLAT = NBATCH * SEQ, NCTX = NBATCH * CTX, NROW = NLAT + NCTX;
constexpr int NH = 8, QRANK = 512, KVRANK = 256, ROPE = 64, QK = 192, DV = 128, DK = 128;
constexpr int INC = 5952, INCP = 6144;
constexpr int NE = 32, TOPK = 4, DFF = 2048;
constexpr int MAXSLOT = 65536 + NE * 256;
constexpr int MAXTILES = MAXSLOT / 256;
constexpr int NT = 512;
constexpr float EPS = 1e-6f;
constexpr int FP8_WSCALE_LOG2_ = 6;

struct Params {
  const float *x, *c, *ctx, *c_ctx, *w_mod, *b_mod, *ln_mix_pre, *ln_mix_post, *ln_ffn_pre, *ln_ffn_post, *w_in, *q_norm, *kv_norm, *w_uq, *w_ukv, *hgrn_lb, *g_norm, *w_out,
      *router_w, *router_b, *w_gu, *b_gu, *w_dn, *b_dn;
  float* out;
  bf16_t *wt_in, *wt_uq, *wt_ukv, *wt_out;
  unsigned char *wt_gu8, *wt_dn8;
  unsigned char *h2_8, *act8;
  float* mod;
  float* rope;
  bf16_t* h;
  bf16_t *cq, *cqn;
  bf16_t *ckv, *ckvn;
  float* kr;
  bf16_t* kr2;
  bf16_t* qh;
  float *gf, *gb;
  bf16_t* vh;
  bf16_t* gate;
  bf16_t *qf, *kf, *vf;
  bf16_t* aout;
  bf16_t *of, *ob;
  bf16_t* mix;
  bf16_t* x1;
  int *tok_e, *tok_pos;
  float* tok_gate;
  int* cnt;
  int* idx;
  unsigned char* ys8;
  unsigned* bar;
};

DEV int ltid() { int t = threadIdx.x; asm volatile("" : "+v"(t)); return t; }
typedef const __attribute__((address_space(4))) Params CParams;
DEV CParams* launder(CParams* p) { asm volatile("" : "+s"(p)); return p; }
#define KARGS ((CParams*)__builtin_amdgcn_kernarg_segment_ptr())
typedef __bf16 bf16n2 __attribute__((ext_vector_type(2)));
DEV unsigned cvt_pk_bf16(float lo, float hi) { const f32x2 v = {lo, hi}; const bf16n2 r = __builtin_convertvector(v, bf16n2); return __builtin_bit_cast(unsigned, r); }
DEV unsigned cvt_pk4_fp8(f32x4 v) { unsigned r = 0; r = __builtin_amdgcn_cvt_pk_fp8_f32(v[0], v[1], r, false); r = __builtin_amdgcn_cvt_pk_fp8_f32(v[2], v[3], r, true); return r; }
DEV float bf2f(bf16_t v) { return __uint_as_float(((unsigned)v) << 16); }
DEV float bflo(unsigned v) { return __uint_as_float(v << 16); }
DEV float bfhi(unsigned v) { return __uint_as_float(v & 0xffff0000u); }
DEV bf16_t f2bf(float f) { const __bf16 r = (__bf16)f; return __builtin_bit_cast(bf16_t, r); }
DEV float wave_sum(float v) {
#pragma unroll
  for (int o = 32; o > 0; o >>= 1) v += __shfl_xor(v, o);
  return v;
}
DEV float sigmoidf_(float v) { return __builtin_amdgcn_rcpf(1.f + __builtin_amdgcn_exp2f(-1.4426950408889634f * v)); }
DEV float siluf_(float v) { return v * __builtin_amdgcn_rcpf(1.f + __builtin_amdgcn_exp2f(-1.4426950408889634f * v)); }

DEV void mod_unit(CParams& p, int u) {
  extern __shared__ __attribute__((aligned(16))) char shm[];
  float* sc = (float*)shm;
  float* red = (float*)(shm + 5 * 2048 * 4);
  const int tid = ltid(), wid = tid >> 6, lane = tid & 63;
  for (int i = tid; i < 5 * 2048; i += NT) { const int v = i >> 11, k = i & 2047; const float cv = v < 4 ? p.c[v * 2048 + k] : p.c_ctx[k]; sc[i] = siluf_(cv); }
  __syncthreads();
  const int col = u * 256 + lane * 4;
  f32x4 acc[5];
#pragma unroll
  for (int v = 0; v < 5; ++v) acc[v] = (f32x4){0.f, 0.f, 0.f, 0.f};
  const float* wp = p.w_mod + (long)(wid * 256) * 12288 + col;
  for (int k = 0; k < 256; k += 4) {
    f32x4 w[4];
#pragma unroll
    for (int j = 0; j < 4; ++j) w[j] = *(const f32x4*)(wp + (long)(k + j) * 12288);
#pragma unroll
    for (int j = 0; j < 4; ++j)
#pragma unroll
      for (int v = 0; v < 5; ++v) { const float s = sc[v * 2048 + wid * 256 + k + j]; acc[v] += w[j] * s; }
  }
#pragma unroll
  for (int v = 0; v < 5; ++v) *(f32x4*)(red + (wid * 5 + v) * 256 + lane * 4) = acc[v];
  __syncthreads();
  for (int i = tid; i < 5 * 256; i += NT) {
    const int v = i >> 8, cc = i & 255; float s = p.b_mod[u * 256 + cc];
#pragma unroll
    for (int w = 0; w < 8; ++w) s += red[(w * 5 + v) * 256 + cc];
    p.mod[v * 12288 + u * 256 + cc] = s;
  }
  __syncthreads();
}

DEV int perm_row(int perm, int n) {
  if (perm == 1) return n < 832 ? n : n + 192;
  if (perm == 2) { const int lin = n >= 2048 ? 1 : 0, j = n - lin * 2048; return (j >> 7) * 256 + lin * 128 + (j & 127); }
  return n;
}
struct CvtDesc { const float* src; void* dst; int ldsrc, N, lddst, k0, n0, perm, fp8; };
constexpr int U_MOD = 48, U_ROPE = 16;
constexpr int U_GU = NE * 16 * 32, U_DN = NE * 16 * 16, U_IN = 16 * 47, U_OUT = 16 * 16, U_UQ = 4 * 12, U_UKV = 2 * 16;
constexpr int U_CVT = U_GU + U_DN + U_IN + U_OUT + U_UQ + U_UKV;
DEV CvtDesc cvt_decode(CParams& p, int u) {
  CvtDesc d;
  if (u < U_GU) { const int e = u >> 9, r = u & 511, kt = r >> 5, nt = r & 31;
    d.src = p.w_gu + (long)e * 2048 * 4096; d.ldsrc = 4096; d.N = 4096; d.dst = p.wt_gu8 + (long)e * 4096 * 2048; d.lddst = 2048; d.k0 = kt * 128; d.n0 = nt * 128; d.perm = 2; d.fp8 = 1; return d; }
  u -= U_GU;
  if (u < U_DN) { const int e = u >> 8, r = u & 255, kt = r >> 4, nt = r & 15;
    d.src = p.w_dn + (long)e * 2048 * 2048; d.ldsrc = 2048; d.N = 2048; d.dst = p.wt_dn8 + (long)e * 2048 * 2048; d.lddst = 2048; d.k0 = kt * 128; d.n0 = nt * 128; d.perm = 0; d.fp8 = 1; return d; }
  u -= U_DN;
  if (u < U_IN) { const int kt = u / 47, nt = u % 47; d.src = p.w_in; d.ldsrc = INC; d.N = INC; d.dst = p.wt_in; d.lddst = 2048; d.k0 = kt * 128; d.n0 = nt * 128; d.perm = 1; d.fp8 = 0; return d; }
  u -= U_IN;
  if (u < U_OUT) { const int kt = u >> 4, nt = u & 15; d.src = p.w_out; d.ldsrc = 2048; d.N = 2048; d.dst = p.wt_out; d.lddst = 2048; d.k0 = kt * 128; d.n0 = nt * 128; d.perm = 0; d.fp8 = 0; return d; }
  u -= U_OUT;
  if (u < U_UQ) { const int kt = u / 12, nt = u % 12; d.src = p.w_uq; d.ldsrc = 1536; d.N = 1536; d.dst = p.wt_uq; d.lddst = 512; d.k0 = kt * 128; d.n0 = nt * 128; d.perm = 0; d.fp8 = 0; return d; }
  u -= U_UQ;
  { const int kt = u >> 4, nt = u & 15; d.src = p.w_ukv; d.ldsrc = 2048; d.N = 2048; d.dst = p.wt_ukv; d.lddst = 256; d.k0 = kt * 128; d.n0 = nt * 128; d.perm = 0; d.fp8 = 0; }
  return d;
}
DEV void cvt_load(const CvtDesc& d, f32x4 (&ld)[8]) {
  const int tid = ltid(), tx = tid & 31, ty = tid >> 5;
  const bool ok = (d.n0 + 4 * tx) < d.N;
#pragma unroll
  for (int x = 0; x < 8; ++x) {
    const int row = d.fp8 ? 4 * (ty + 16 * (x >> 2)) + (x & 3) : 2 * (ty + 16 * (x >> 1)) + (x & 1);
    const float* sp = d.src + (long)(d.k0 + row) * d.ldsrc + d.n0 + 4 * tx;
    ld[x] = ok ? __builtin_nontemporal_load((const f32x4*)sp) : (f32x4){0.f, 0.f, 0.f, 0.f};
  }
}
DEV void cvt_store(const CvtDesc& d, const f32x4 (&ld)[8]) {
  extern __shared__ __attribute__((aligned(16))) char shm[];
  unsigned* T = (unsigned*)shm;
  const int tid = ltid(), tx = tid & 31, ty = tid >> 5;
  if (d.fp8) {
    constexpr float WS = (float)(1 << FP8_WSCALE_LOG2_);
#pragma unroll
    for (int i = 0; i < 2; ++i) {
      const int q = ty + 16 * i;
#pragma unroll
      for (int j = 0; j < 4; ++j) T[(4 * tx + j) * 33 + q] = cvt_pk4_fp8((f32x4){ld[4 * i][j] * WS, ld[4 * i + 1][j] * WS, ld[4 * i + 2][j] * WS, ld[4 * i + 3][j] * WS});
    }
    __syncthreads();
#pragma unroll
    for (int j = 0; j < 2; ++j) {
      const int id = tid + NT * j, nl = id >> 3, cc = id & 7, n = d.n0 + nl;
      u32x4 v; v.x = T[nl * 33 + 4 * cc]; v.y = T[nl * 33 + 4 * cc + 1]; v.z = T[nl * 33 + 4 * cc + 2]; v.w = T[nl * 33 + 4 * cc + 3];
      if (n < d.N) *(u32x4*)((unsigned char*)d.dst + (long)perm_row(d.perm, n) * d.lddst + d.k0 + 16 * cc) = v;
    }
  } else {
#pragma unroll
    for (int i = 0; i < 4; ++i) {
      const int q = ty + 16 * i;
#pragma unroll
      for (int j = 0; j < 4; ++j) T[(4 * tx + j) * 65 + q] = cvt_pk_bf16(ld[2 * i][j], ld[2 * i + 1][j]);
    }
    __syncthreads();
#pragma unroll
    for (int j = 0; j < 4; ++j) {
      const int id = tid + NT * j, nl = id >> 4, cc = id & 15, n = d.n0 + nl;
      u32x4 v; v.x = T[nl * 65 + 4 * cc]; v.y = T[nl * 65 + 4 * cc + 1]; v.z = T[nl * 65 + 4 * cc + 2]; v.w = T[nl * 65 + 4 * cc + 3];
      if (n < d.N) *(u32x4*)((bf16_t*)d.dst + (long)perm_row(d.perm, n) * d.lddst + d.k0 + 8 * cc) = v;
    }
  }
  __syncthreads();
}
constexpr int FILL_LDS_OFF = 133120, FILL_TB = 128 * 17 * 4;
constexpr int FILL_HALVES = 2 * (NE * 16 * 32 + NE * 16 * 16);
#ifndef FILL_HG
#define FILL_HG 67
#endif
#ifndef FILL_A0
#define FILL_A0 63
#endif
#ifndef FILL_A1
#define FILL_A1 62
#endif
constexpr int FILL_SLOTS = FILL_HG + FILL_A0 + FILL_A1;
static_assert(FILL_HG <= 67 && FILL_A0 <= 68 && FILL_A1 <= 68 && FILL_SLOTS * 256 <= FILL_HALVES, "filler split");
struct FillDesc { const float* src; unsigned char* dst; int ldsrc, perm, n0, kh; };
DEV FillDesc fill_decode(CParams& p, int wg, int slot) {
  const int h = slot * 256 + wg, t = h >> 1, half = h & 1; FillDesc d;
  if (t < NE * 512) { const int e = t >> 9, r = t & 511; d.src = p.w_gu + (long)e * 2048 * 4096; d.ldsrc = 4096; d.dst = p.wt_gu8 + (long)e * 4096 * 2048; d.perm = 2; d.n0 = (r & 31) * 128 + 64 * half; d.kh = (r >> 5) * 128; }
  else { const int v = t - NE * 512, e = v >> 8, r = v & 255; d.src = p.w_dn + (long)e * 2048 * 2048; d.ldsrc = 2048; d.dst = p.wt_dn8 + (long)e * 2048 * 2048; d.perm = 0; d.n0 = (r & 15) * 128 + 64 * half; d.kh = (r >> 4) * 128; }
  return d;
}
DEV void fill_load(CParams& p, int wg, int slot, f32x4 (&ld)[4]) {
  const FillDesc d = fill_decode(p, wg, slot); const int tid = ltid(), tx = tid & 15, ty = tid >> 4;
  const float* sp = d.src + (long)(d.kh + 4 * ty) * d.ldsrc + d.n0 + 4 * tx;
#pragma unroll
  for (int r = 0; r < 4; ++r) ld[r] = *(const f32x4*)(sp + (long)r * d.ldsrc);
}
DEV void fill_write(const f32x4 (&ld)[4], int bufsel) {
  extern __shared__ __attribute__((aligned(16))) char shm[];
  unsigned* T = (unsigned*)(shm + FILL_LDS_OFF + bufsel * FILL_TB); const int tid = ltid(), tx = tid & 15, ty = tid >> 4;
  constexpr float WS = (float)(1 << FP8_WSCALE_LOG2_);
#pragma unroll
  for (int j = 0; j < 4; ++j) T[(4 * tx + j) * 33 + ty] = cvt_pk4_fp8((f32x4){ld[0][j] * WS, ld[1][j] * WS, ld[2][j] * WS, ld[3][j] * WS});
}
DEV void fill_store(CParams& p, int wg, int slot, int bufsel) {
  extern __shared__ __attribute__((aligned(16))) char shm[];
  const unsigned* T = (const unsigned*)(shm + FILL_LDS_OFF + bufsel * FILL_TB); const int tid = ltid(), nl = tid >> 3, cc = tid & 7;
  const FillDesc d = fill_decode(p, wg, slot);
  u32x4 v; v.x = T[nl * 33 + 4 * cc]; v.y = T[nl * 33 + 4 * cc + 1]; v.z = T[nl * 33 + 4 * cc + 2]; v.w = T[nl * 33 + 4 * cc + 3];
  *(u32x4*)(d.dst + (long)perm_row(d.perm, d.n0 + nl) * 2048 + d.kh + 16 * cc) = v;
}
DEV void rope_unit(CParams& p, int u) {
  for (int i = ltid(); i < 256 * 32; i += NT) {
    const int t = u * 256 + (i >> 5), a = i & 31; const int fi = a & 15;
    const float inv = powf(10000.0f, -(float)fi / 16.0f);
    const float pos = a < 16 ? (float)(t >> 6) : (float)(t & 63);
    const float ang = pos * inv; float s, c; sincosf(ang, &s, &c);
    p.rope[t * 64 + a] = c; p.rope[t * 64 + 32 + a] = s;
  }
}
DEV void phase0(CParams& p, int wg, int nwg) {
  if (wg < U_MOD) mod_unit(p, wg); else if (wg < U_MOD + U_ROPE) rope_unit(p, wg - U_MOD);
  if (nwg < U_MOD + U_ROPE) { for (int u = wg + nwg; u < U_MOD + U_ROPE; u += nwg) { if (u < U_MOD) mod_unit(p, u); else rope_unit(p, u - U_MOD); } }
  f32x4 ld[8], ld2[8];
  int u = (nwg == 256 ? FILL_SLOTS * 128 : 0) + wg;
  if (u < U_CVT) { const CvtDesc d = cvt_decode(p, u); cvt_load(d, ld); }
  for (; u < U_CVT; u += nwg) {
    const CvtDesc d = cvt_decode(p, u);
    const int un = u + nwg;
    if (un < U_CVT) { const CvtDesc dn = cvt_decode(p, un); cvt_load(dn, ld2); }
    cvt_store(d, ld);
#pragma unroll
    for (int i = 0; i < 8; ++i) ld[i] = ld2[i];
  }
}

DEV void phase1_rows(CParams& p, int wg, int nwg) {
  const int wid = ltid() >> 6, lane = ltid() & 63;
  for (int row = wg * 8 + wid; row < NROW; row += nwg * 8) {
    const float* xr; int v;
    if (row < NCTX) { xr = p.ctx + (long)row * DM; v = 4; } else { xr = p.x + (long)(row - NCTX) * DM; v = (row - NCTX) >> 12; }
    const float* sh = p.mod + v * 12288; const float* sc = sh + 2048;
    f32x4 xv[8]; float ss = 0.f;
#pragma unroll
    for (int i = 0; i < 8; ++i) { xv[i] = *(const f32x4*)(xr + i * 256 + lane * 4); ss += xv[i][0] * xv[i][0] + xv[i][1] * xv[i][1] + xv[i][2] * xv[i][2] + xv[i][3] * xv[i][3]; }
    ss = wave_sum(ss);
    const float rstd = rsqrtf(ss * (1.f / DM) + EPS);
#pragma unroll
    for (int i = 0; i < 8; ++i) {
      const int c0 = i * 256 + lane * 4;
      const f32x4 w = *(const f32x4*)(p.ln_mix_pre + c0), s1 = *(const f32x4*)(sc + c0), s0 = *(const f32x4*)(sh + c0);
      f32x4 y;
#pragma unroll
      for (int j = 0; j < 4; ++j) y[j] = xv[i][j] * rstd * w[j] * (1.f + s1[j]) + s0[j];
      u32x2 o; o.x = cvt_pk_bf16(y[0], y[1]); o.y = cvt_pk_bf16(y[2], y[3]);
      *(u32x2*)(p.h + (long)row * DM + c0) = o;
    }
  }
}
#define LAS __attribute__((address_space(3)))
constexpr int BM = 256, BK = 64, HALF = 128, HTB = HALF * BK * 2, GEMM_LDS = 8 * HTB;
constexpr int GEMM_AROW_OFF = GEMM_LDS;
DEV int lds_byte(int r, int c) { const int st = (r >> 4) * 2 + (c >> 5), rr = r & 15, cc = c & 31, ob = rr * 64 + cc * 2; return st * 1024 + (ob ^ (((ob >> 9) & 1) << 5)); }
DEV void stage_rc(int b, int& R, int& C) { const int st = b / 1024, sb = b % 1024, swz = sb ^ (((sb >> 9) & 1) << 5); R = (st >> 1) * 16 + swz / 64; C = (st & 1) * 32 + (swz % 64) / 2; }
typedef f32x4 AccT[2][2][4][2];
struct Unit { int pm, pn, e, r0; };
typedef int i32x8 __attribute__((ext_vector_type(8)));
typedef int i32x4 __attribute__((ext_vector_type(4)));
DEV int g8(int r) { const int q = ((r & 15) >> 1) + 2; return 2 * (q & 3) + 1 - ((q >> 2) & 1); }
constexpr int FP8_WSCALE_LOG2 = FP8_WSCALE_LOG2_;
constexpr int FP8_SCALE_W = 0x01010101 * (127 - FP8_WSCALE_LOG2), FP8_SCALE_1 = 0x7f7f7f7f;

DEV void mfma_fp8(f32x4& acc, const i32x8& w, const i32x8& a, int sw, int sa) {
  asm volatile("v_mfma_scale_f32_16x16x128_f8f6f4 %0, %1, %2, %0, %3, %4 op_sel_hi:[0,0,0]" : "+v"(acc) : "v"(w), "v"(a), "v"(sw), "v"(sa));
}
template <class P>
DEV void gemm_stream(const P& pol) {
  extern __shared__ __attribute__((aligned(16))) char shm[];
  LAS unsigned char* lds = (LAS unsigned char*)shm;
  LAS int* arow = (LAS int*)(shm + GEMM_AROW_OFF);
  const int tid = ltid(), wid = __builtin_amdgcn_readfirstlane(tid >> 6), lane = tid & 63, wr = wid >> 2, wc = wid & 3, fr = lane & 15, fq = lane >> 4;
  const int KB = pol.KB, nt = KB / 128;
  Unit cur, nxt; int ui = 0;
  if (!pol.get(0, cur)) return;
  unsigned voffB[2], vAc[2][2];
#define G_SRC(i_, R_, C_) do { const int b_ = ltid() * 16 + (i_) * 8192; if (P::FP8) { R_ = b_ >> 7; C_ = (((b_ >> 4) & 7) ^ g8(R_)) << 4; } else { stage_rc(b_, R_, C_); C_ *= 2; } } while (0)
#define G_GATHER_OFFS(tab_) do { _Pragma("unroll") for (int i = 0; i < 2; ++i) { int R_, C_; G_SRC(i, R_, C_); \
    vAc[0][i] = (unsigned)((tab_)[R_] * KB + C_); vAc[1][i] = (unsigned)((tab_)[HALF + R_] * KB + C_); } } while (0)
#pragma unroll
  for (int i = 0; i < 2; ++i) { int R_, C_; G_SRC(i, R_, C_); const int rho = R_ & 31, Rb = (R_ & ~31) + 8 * ((rho & 15) >> 2) + 4 * (rho >> 4) + (rho & 3); voffB[i] = (unsigned)(Rb * KB + C_); }
  if (P::GATHER) {
    pol.arow_fill(cur, (int*)(shm + GEMM_AROW_OFF));
    __syncthreads();
    G_GATHER_OFFS(arow);
  } else {
#pragma unroll
    for (int i = 0; i < 2; ++i) { int R_, C_; G_SRC(i, R_, C_); vAc[0][i] = (unsigned)(R_ * KB + C_); vAc[1][i] = vAc[0][i]; }
  }
  const size_t kstep = 128, hstep = (size_t)HALF * KB;
  const unsigned ldsw = (unsigned)wid * 1024u;
  const int aoff = P::FP8 ? (wr * 64 + fr) * 128 + (((2 * fq) ^ g8(fr)) << 4) : lds_byte(wr * 64 + fr, fq * 8);
  const int boff = P::FP8 ? (wc * 32 + fr) * 128 + (((2 * fq) ^ g8(fr)) << 4) : lds_byte(wc * 32 + fr, fq * 8);
  const int aoff1 = (wr * 64 + fr) * 128 + (((2 * fq + 1) ^ g8(fr)) << 4), boff1 = (wc * 32 + fr) * 128 + (((2 * fq + 1) ^ g8(fr)) << 4);
#define G_SA(b, h) (((b) * 2 + (h)) * HTB)
#define G_SB(b, h) ((4 + (b) * 2 + (h)) * HTB)
#define G_STAGE(bufoff, gbase, voff) do { _Pragma("unroll") for (int _i = 0; _i < 2; ++_i) \
    __builtin_amdgcn_global_load_lds((const unsigned*)((const char*)(gbase) + (voff)[_i]), (LAS unsigned*)(lds + (bufoff) + ldsw + _i * 8192), 16, 0, 0); } while (0)
#define G_LD2(o0, o1) __builtin_shufflevector(*(const LAS i32x4*)(lds + (o0)), *(const LAS i32x4*)(lds + (o1)), 0, 1, 2, 3, 4, 5, 6, 7)
#define G_LDA(dst, b, h) do { _Pragma("unroll") for (int m = 0; m < 4; ++m) dst[m] = G_LD2(G_SA(b, h) + aoff + m * 2048, G_SA(b, h) + (P::FP8 ? aoff1 : aoff + 1024) + m * 2048); } while (0)
#define G_LDB(dst, b, h) do { _Pragma("unroll") for (int n = 0; n < 2; ++n) dst[n] = G_LD2(G_SB(b, h) + boff + n * 2048, G_SB(b, h) + (P::FP8 ? boff1 : boff + 1024) + n * 2048); } while (0)
#define G_LO(x_) __builtin_bit_cast(bf16x8, __builtin_shufflevector(x_, x_, 0, 1, 2, 3))
#define G_HI(x_) __builtin_bit_cast(bf16x8, __builtin_shufflevector(x_, x_, 4, 5, 6, 7))
#define G_MMA(ai, bj, At_, Bt_) do { __builtin_amdgcn_s_setprio(1); _Pragma("unroll") for (int m = 0; m < 4; ++m) _Pragma("unroll") for (int n = 0; n < 2; ++n) { \
    if (P::FP8) mfma_fp8(acc[ai][bj][m][n], Bt_[n], At_[m], sclw, scla); \
    else { acc[ai][bj][m][n] = __builtin_amdgcn_mfma_f32_16x16x32_bf16(G_LO(Bt_[n]), G_LO(At_[m]), acc[ai][bj][m][n], 0, 0, 0); \
           acc[ai][bj][m][n] = __builtin_amdgcn_mfma_f32_16x16x32_bf16(G_HI(Bt_[n]), G_HI(At_[m]), acc[ai][bj][m][n], 0, 0, 0); } } \
    __builtin_amdgcn_s_setprio(0); } while (0)
#define G_ZERO() do { _Pragma("unroll") for (int a_ = 0; a_ < 2; ++a_) _Pragma("unroll") for (int b_ = 0; b_ < 2; ++b_) _Pragma("unroll") for (int m_ = 0; m_ < 4; ++m_) _Pragma("unroll") for (int n_ = 0; n_ < 2; ++n_) \
    acc[a_][b_][m_][n_] = (f32x4){0.f, 0.f, 0.f, 0.f}; } while (0)
#define WAIT_V(n) asm volatile("s_waitcnt vmcnt(" #n ")" ::: "memory")
#define WAIT_L(n) asm volatile("s_waitcnt lgkmcnt(" #n ")" ::: "memory")
#define BAR __builtin_amdgcn_s_barrier()
#define SCHED __builtin_amdgcn_sched_barrier(0)
  int sclw = P::SCALE_B, scla = P::SCALE_A;
  f32x4 acc[2][2][4][2];
  f32x4 bv[2][2];
#define G_INIT() do { _Pragma("unroll") for (int a_ = 0; a_ < 2; ++a_) _Pragma("unroll") for (int b_ = 0; b_ < 2; ++b_) _Pragma("unroll") for (int m_ = 0; m_ < 4; ++m_) _Pragma("unroll") for (int n_ = 0; n_ < 2; ++n_) \
    acc[a_][b_][m_][n_] = bv[b_][n_]; } while (0)
  if (P::HASBIAS) { pol.bias_load(cur, bv, wc, fq); G_INIT(); } else G_ZERO();
  i32x8 At[4], B0[2], B1[2];
  const char* cA0 = pol.abase(cur, 0); const char* cA1 = pol.abase(cur, 1); const char* cB = pol.bbase(cur);
  G_STAGE(G_SB(0, 0), cB, voffB); G_STAGE(G_SA(0, 0), cA0, vAc[0]); G_STAGE(G_SB(0, 1), cB + hstep, voffB); G_STAGE(G_SA(0, 1), cA1, vAc[1]);
  if (wr == 1) BAR;
  WAIT_V(4); BAR;
  G_STAGE(G_SB(1, 0), cB + kstep, voffB); G_STAGE(G_SA(1, 0), cA0 + kstep, vAc[0]); G_STAGE(G_SB(1, 1), cB + hstep + kstep, voffB);
  WAIT_V(6); BAR;
  for (;;) {
    const bool has_next = pol.get(ui + 1, nxt);
    const char* nA0 = has_next ? pol.abase(nxt, 0) : cA0; const char* nA1 = has_next ? pol.abase(nxt, 1) : cA1; const char* nB = has_next ? pol.bbase(nxt) : cB;
    if (P::GATHER && has_next) pol.arow_fill(nxt, (int*)(shm + GEMM_AROW_OFF) + ((ui + 1) & 1) * 256);
    for (int t = 0; t < nt; t += 2) {
      const bool last = (t == nt - 2);
      const size_t k1 = (size_t)(t + 1) * kstep, k2 = (size_t)(t + 2) * kstep;
      const char* a20 = last ? nA0 : cA0 + k2; const char* a21 = last ? nA1 : cA1 + k2; const char* b2 = last ? nB : cB + k2;
      G_LDB(B0, 0, 0); SCHED; G_LDA(At, 0, 0); G_STAGE(G_SA(1, 1), cA1 + k1, vAc[1]);
      WAIT_L(8); BAR; WAIT_L(0); G_MMA(0, 0, At, B0); BAR; SCHED;
      if (P::GATHER && last && has_next) { LAS int* tab = arow + ((ui + 1) & 1) * 256; G_GATHER_OFFS(tab); }
      G_LDB(B1, 0, 1); G_STAGE(G_SB(0, 0), b2, voffB);
      BAR; WAIT_L(0); G_MMA(0, 1, At, B1); BAR;
      G_LDA(At, 0, 1); G_STAGE(G_SA(0, 0), a20, vAc[0]);
      BAR; WAIT_L(0); G_MMA(1, 0, At, B0); BAR; SCHED;
      G_STAGE(G_SB(0, 1), b2 + hstep, voffB);
      WAIT_V(6); BAR; G_MMA(1, 1, At, B1); BAR;
      G_LDB(B0, 1, 0); SCHED; G_LDA(At, 1, 0); G_STAGE(G_SA(0, 1), a21, vAc[1]);
      WAIT_L(8); BAR; WAIT_L(0); G_MMA(0, 0, At, B0); BAR; SCHED;
      G_LDB(B1, 1, 1); G_STAGE(G_SB(1, 0), b2 + kstep, voffB);
      BAR; WAIT_L(0); G_MMA(0, 1, At, B1); BAR;
      G_LDA(At, 1, 1); G_STAGE(G_SA(1, 0), a20 + kstep, vAc[0]);
      BAR; WAIT_L(0); G_MMA(1, 0, At, B0); BAR; SCHED;
      G_STAGE(G_SB(1, 1), b2 + hstep + kstep, voffB);
      WAIT_V(6); BAR; G_MMA(1, 1, At, B1); BAR;
    }
    if (P::FP8) asm volatile("s_nop 7\n\ts_nop 7" ::: "memory");
    if (P::HASBIAS) pol.bias_load(has_next ? nxt : cur, bv, wc, fq);
    pol.epi(cur, acc, wr, wc, fr, fq);
    if (!has_next) break;
    if (P::HASBIAS) G_INIT(); else G_ZERO();
    cur = nxt; cA0 = nA0; cA1 = nA1; cB = nB; ++ui;
  }
  WAIT_V(0);
  if (wr == 0) BAR;
  __syncthreads();
#undef G_SA
#undef G_SB
#undef G_STAGE
#undef G_LDA
#undef G_LDB
#undef G_MMA
#undef G_LD2
#undef G_SRC
#undef G_GATHER_OFFS
#undef G_LO
#undef G_HI
#undef G_ZERO
#undef G_INIT
}

constexpr int MOE_TAB_OFF_ = GEMM_AROW_OFF + 2 * 256 * 4;
DEV void st_bf16x4(bf16_t* p, f32x4 v) { u32x2 o; o.x = cvt_pk_bf16(v[0], v[1]); o.y = cvt_pk_bf16(v[2], v[3]); *(u32x2*)p = o; }
DEV void st_bf16x8(bf16_t* p, f32x4 a, f32x4 b) { u32x4 o; o.x = cvt_pk_bf16(a[0], a[1]); o.y = cvt_pk_bf16(a[2], a[3]); o.z = cvt_pk_bf16(b[0], b[1]); o.w = cvt_pk_bf16(b[2], b[3]); *(u32x4*)p = o; }
DEV void st_fp8x8(unsigned char* p, f32x4 a, f32x4 b) { u32x2 o; o.x = cvt_pk4_fp8(a); o.y = cvt_pk4_fp8(b); *(u32x2*)p = o; }

DEV f32x4 sig4(f32x4 v) {
  const f32x4 t = v * -1.4426950408889634f; f32x4 e;
#pragma unroll
  for (int j = 0; j < 4; ++j) e[j] = __builtin_amdgcn_exp2f(t[j]);
  e = e + 1.0f; f32x4 r;
#pragma unroll
  for (int j = 0; j < 4; ++j) r[j] = __builtin_amdgcn_rcpf(e[j]);
  return r;
}
struct EpiIn {
  CParams* p; int pm, pn;
  template <int KIND> DEV void run(const AccT& acc, int wr, int wc, int fr, int fq) const;
  DEV void operator()(const AccT& acc, int wr, int wc, int fr, int fq) const {
    if (pn < 2) run<0>(acc, wr, wc, fr, fq); else if (pn == 2) run<1>(acc, wr, wc, fr, fq); else if (pn == 3) run<2>(acc, wr, wc, fr, fq);
    else if (pn < 8 || pn >= 20) run<3>(acc, wr, wc, fr, fq); else if (pn < 16) run<4>(acc, wr, wc, fr, fq); else run<5>(acc, wr, wc, fr, fq);
  }
};
DEV void row_to_bkey(int row, int& b, int& key) { if (row < NCTX) { b = row >> 8; key = row & 255; } else { const int r = row - NCTX; b = r >> 12; key = CTX + (r & 4095); } }

struct EpiKV {
  CParams* p; int pm, pn;
  DEV void operator()(const AccT& acc, int wr, int wc, int fr, int fq) const {
    CParams& P = *launder(p); const int row0 = pm * BM + wr * 64 + fr;
#pragma unroll
    for (int ai = 0; ai < 2; ++ai)
#pragma unroll
      for (int m = 0; m < 4; ++m) {
        const int row = row0 + ai * HALF + m * 16; int b, key; row_to_bkey(row, b, key);
        const long bh = (long)(b * NH + pn) * KEYS + key; const int c = wc * 32 + 8 * fq;
        st_bf16x8(P.kf + bh * QK + c, acc[ai][0][m][0], acc[ai][0][m][1]);
        st_bf16x8(P.vf + bh * DV + c, acc[ai][1][m][0], acc[ai][1][m][1]);
        if (wc == 0) { const u32x4* kp_ = (const u32x4*)(P.kr2 + (long)row * ROPE + 16 * fq); u32x4* dp_ = (u32x4*)(P.kf + bh * QK + 128 + 16 * fq); dp_[0] = kp_[0]; dp_[1] = kp_[1]; }
      }
  }
};
struct EpiQ {
  CParams* p; int pm, pn;
  DEV void operator()(const AccT& acc, int wr, int wc, int fr, int fq) const {
    CParams& P = *launder(p); const int row0 = pm * BM + wr * 64 + fr;
#pragma unroll
    for (int ai = 0; ai < 2; ++ai)
#pragma unroll
      for (int m = 0; m < 4; ++m) {
        const int row = row0 + ai * HALF + m * 16, b = row >> 12, t = row & 4095;
#pragma unroll
        for (int bj = 0; bj < 2; ++bj) {
          const int col = pn * 256 + bj * HALF + wc * 32 + 8 * fq, hh = col / QK, e = col - hh * QK;
          st_bf16x8(P.qf + ((long)(b * NH + hh) * SEQ + t) * QK + e, acc[ai][bj][m][0], acc[ai][bj][m][1]);
        }
      }
  }
};
struct EpiOut {
  CParams* p; int pm, pn;
  DEV void operator()(const AccT& acc, int wr, int wc, int fr, int fq) const;
};
constexpr int STG_OFF = ((MOE_TAB_OFF_ + (2 * MAXTILES + 2) * 4 + 15) / 16) * 16, STG_HALF = 9216;
template <int LB> DEV void stage_store_block(const unsigned (&v)[4][LB / 4], unsigned char* dst, long row_stride) {
  extern __shared__ __attribute__((aligned(16))) char shm[];
  constexpr int MP = LB == 8 ? 4 : (LB == 16 ? 2 : 1), PITCH = 16 * LB + 16, ROWS = 16 * MP;
  static_assert(ROWS * PITCH <= STG_HALF, "staging region");
  const int tid = ltid(), wr = tid >> 8, wc = (tid >> 6) & 3, fr = tid & 15, fq = (tid >> 4) & 3;
  char* stg = shm + STG_OFF + wr * STG_HALF;
  const int t4 = tid & 255;
#pragma unroll
  for (int ps = 0; ps < 4 / MP; ++ps) {
#pragma unroll
    for (int mm = 0; mm < MP; ++mm) {
      char* wp = stg + (16 * mm + fr) * PITCH + (4 * wc + fq) * LB; const int m = ps * MP + mm;
      if (LB == 8) *(u32x2*)wp = (u32x2){v[m][0], v[m][1]};
      else { *(u32x4*)wp = (u32x4){v[m][0], v[m][1], v[m][2], v[m][3]}; if (LB == 32) *(u32x4*)(wp + 16) = (u32x4){v[m][LB / 4 - 4], v[m][LB / 4 - 3], v[m][LB / 4 - 2], v[m][LB / 4 - 1]}; }
    }
    asm volatile("s_waitcnt lgkmcnt(0)" ::: "memory"); __builtin_amdgcn_s_barrier(); asm volatile("" ::: "memory");
#pragma unroll
    for (int k = 0; k < 2; ++k) { const int idx = k * 256 + t4, row = idx / LB, ch = idx % LB;
      *(u32x4*)(dst + (long)(ps * ROWS + row) * row_stride + ch * 16) = *(const u32x4*)(stg + row * PITCH + ch * 16); }
    asm volatile("s_waitcnt lgkmcnt(0)" ::: "memory"); __builtin_amdgcn_s_barrier(); asm volatile("" ::: "memory");
  }
}
DEV void pk_bf16x8(unsigned (&o)[4], f32x4 a, f32x4 b) { o[0] = cvt_pk_bf16(a[0], a[1]); o[1] = cvt_pk_bf16(a[2], a[3]); o[2] = cvt_pk_bf16(b[0], b[1]); o[3] = cvt_pk_bf16(b[2], b[3]); }
DEV void pk_f32x8(unsigned (&o)[8], f32x4 a, f32x4 b) {
#pragma unroll
  for (int j = 0; j < 4; ++j) { o[j] = __float_as_uint(a[j]); o[4 + j] = __float_as_uint(b[j]); } }
template <int KIND> DEV void EpiIn::run(const AccT& acc, int wr, int wc, int fr, int fq) const {
  CParams& P = *launder(p);
  const int rowh = pm * BM + wr * 64;
  if (KIND == 2) {
#pragma unroll
    for (int ai = 0; ai < 2; ++ai)
#pragma unroll
      for (int m = 0; m < 4; ++m) { const int row = rowh + fr + ai * HALF + m * 16, c = wc * 32 + 8 * fq;
        if (c < 64) { *(f32x4*)(P.kr + (long)row * ROPE + c) = acc[ai][0][m][0]; *(f32x4*)(P.kr + (long)row * ROPE + c + 4) = acc[ai][0][m][1]; } }
    return;
  }
  if (KIND == 0 && pm < 4) return;
  f32x4 lbv[2][2], oml[2][2];
  if (KIND == 4) {
    const int dir = (pn - 8) >> 2;
#pragma unroll
    for (int bj = 0; bj < 2; ++bj)
#pragma unroll
      for (int n = 0; n < 2; ++n) {
        const int col = ((pn - 8) & 3) * 256 + bj * HALF + wc * 32 + 8 * fq + 4 * n;
        const f32x4 a0 = *(const f32x4*)(P.hgrn_lb + dir * 2048 + col), a1 = *(const f32x4*)(P.hgrn_lb + dir * 2048 + 1024 + col);
#pragma unroll
        for (int j = 0; j < 4; ++j) lbv[bj][n][j] = sigmoidf_(a0[j] - a1[j]);
        oml[bj][n] = 1.0f - lbv[bj][n];
      }
  }
#pragma unroll
  for (int ai = 0; ai < 2; ++ai)
#pragma unroll
    for (int bj = 0; bj < 2; ++bj) {
      const long row = rowh + ai * HALF; const int cb = bj * HALF;
      if (KIND == 4) {
        unsigned vals[4][8];
#pragma unroll
        for (int m = 0; m < 4; ++m) pk_f32x8(vals[m], lbv[bj][0] + oml[bj][0] * sig4(acc[ai][bj][m][0]), lbv[bj][1] + oml[bj][1] * sig4(acc[ai][bj][m][1]));
        stage_store_block<32>(vals, (unsigned char*)(((pn - 8) >> 2 ? P.gb : P.gf) + row * 1024 + ((pn - 8) & 3) * 256 + cb), 1024 * 4);
      } else {
        unsigned vals[4][4];
#pragma unroll
        for (int m = 0; m < 4; ++m) {
          if (KIND == 3) pk_bf16x8(vals[m], acc[ai][bj][m][0] * sig4(acc[ai][bj][m][0]), acc[ai][bj][m][1] * sig4(acc[ai][bj][m][1]));
          else pk_bf16x8(vals[m], acc[ai][bj][m][0], acc[ai][bj][m][1]);
        }
        bf16_t* dst;
        if (KIND == 0) dst = P.cq + (row - NCTX) * QRANK + pn * 256 + cb;
        else if (KIND == 1) dst = P.ckv + row * KVRANK + cb;
        else if (KIND == 3) dst = (pn < 8 ? P.qh + (pn - 4) * 256 : P.gate + (pn - 20) * 256) + row * 1024 + cb;
        else dst = P.vh + row * 1024 + (pn - 16) * 256 + cb;
        stage_store_block<16>(vals, (unsigned char*)dst, (KIND == 0 ? QRANK : (KIND == 1 ? KVRANK : 1024)) * 2);
      }
    }
}
DEV void EpiOut::operator()(const AccT& acc, int wr, int wc, int fr, int fq) const {
  CParams& P = *launder(p);
#pragma unroll
  for (int ai = 0; ai < 2; ++ai)
#pragma unroll
    for (int bj = 0; bj < 2; ++bj) {
      unsigned vals[4][4];
#pragma unroll
      for (int m = 0; m < 4; ++m) pk_bf16x8(vals[m], acc[ai][bj][m][0], acc[ai][bj][m][1]);
      stage_store_block<16>(vals, (unsigned char*)(P.mix + (long)(pm * BM + ai * HALF + wr * 64) * DM + pn * 256 + bj * HALF), DM * 2);
    }
}
struct EpiGU {
  CParams* p; int e, srow0, pn;
  DEV static f32x4 act4(f32x4 g, f32x4 l) {
    constexpr float KS = -1.702f * 1.4426950408889634f;
    f32x4 a;
#pragma unroll
    for (int h2 = 0; h2 < 2; ++h2) {
      f32x2 gl, li1, sg;
      gl.x = fminf(g[2 * h2], 7.f); gl.y = fminf(g[2 * h2 + 1], 7.f);
      li1.x = fminf(fmaxf(l[2 * h2], -6.f), 8.f); li1.y = fminf(fmaxf(l[2 * h2 + 1], -6.f), 8.f);
      const f32x2 t = gl * KS;
      f32x2 d; d.x = __builtin_amdgcn_exp2f(t.x); d.y = __builtin_amdgcn_exp2f(t.y);
      d = d + 1.0f;
      sg.x = __builtin_amdgcn_rcpf(d.x); sg.y = __builtin_amdgcn_rcpf(d.y);
      const f32x2 r = (gl * sg) * li1;
      a[2 * h2] = r.x; a[2 * h2 + 1] = r.y;
    }
    return a;
  }
  DEV void operator()(const AccT& acc, int wr, int wc, int fr, int fq) const {
    CParams& P = *launder(p); const int row0 = srow0 + wr * 64 + fr;
    const int c = wc * 32 + 8 * fq;
#pragma unroll
    for (int ai = 0; ai < 2; ++ai) {
      unsigned vals[4][2];
#pragma unroll
      for (int m = 0; m < 4; ++m) { vals[m][0] = cvt_pk4_fp8(act4(acc[ai][0][m][0], acc[ai][1][m][0])); vals[m][1] = cvt_pk4_fp8(act4(acc[ai][0][m][1], acc[ai][1][m][1])); }
      stage_store_block<8>(vals, P.act8 + (long)(srow0 + ai * HALF + wr * 64) * DFF + pn * 128, DFF);
    }
  }
};
struct EpiDN {
  CParams* p; int e, srow0, pn;
  DEV void operator()(const AccT& acc, int wr, int wc, int fr, int fq) const {
    CParams& P = *launder(p); const int row0 = srow0 + wr * 64 + fr;
#pragma unroll
    for (int bj = 0; bj < 2; ++bj)
#pragma unroll
      for (int ai = 0; ai < 2; ++ai) {
        unsigned vals[4][2];
#pragma unroll
        for (int m = 0; m < 4; ++m) { vals[m][0] = cvt_pk4_fp8(acc[ai][bj][m][0]); vals[m][1] = cvt_pk4_fp8(acc[ai][bj][m][1]); }
        stage_store_block<8>(vals, P.ys8 + (long)(srow0 + ai * HALF + wr * 64) * DM + pn * 256 + bj * HALF, DM);
      }
  }
};

struct PolIn {
  static constexpr bool GATHER = false;
  static constexpr bool FP8 = false, HASBIAS = false; static constexpr int SCALE_A = 0, SCALE_B = 0;
  CParams* p; const char* A; const char* B; int wg, nwg, KB, part;
  DEV bool get(int i, Unit& u) const {
    const int id = wg + i * nwg;
    if (part) { if (id >= 64) return false; u.pn = 23; u.pm = 4 + id; u.e = 0; u.r0 = 0; return true; }
    if (id >= 1528) return false;
    if (id < 1472) { u.pn = id >> 6; u.pm = 4 + (id & 63); } else { const int v = id - 1472, j = v >> 2; u.pm = v & 3; u.pn = j < 2 ? 2 + j : 6 + j; }
    u.e = 0; u.r0 = 0; return true; }
  DEV const char* abase(const Unit& u, int half) const { return A + (size_t)(u.pm * BM + half * HALF) * KB; }
  DEV const char* bbase(const Unit& u) const { return B + (size_t)(u.pn * BM) * KB; }
  DEV void arow_fill(const Unit&, int*) const {}
  DEV void bias_load(const Unit&, f32x4 (&)[2][2], int, int) const {}
  DEV void epi(const Unit& u, const AccT& acc, int wr, int wc, int fr, int fq) const { EpiIn e{p, u.pm, u.pn}; e(acc, wr, wc, fr, fq); }
};
DEV void phase2_inproj(CParams& p, int wg, int nwg) { PolIn pol{&p, (const char*)p.h, (const char*)p.wt_in, wg, nwg, DM * 2, 0}; gemm_stream(pol); }

struct PolKV {
  static constexpr bool GATHER = false;
  static constexpr bool FP8 = false, HASBIAS = false; static constexpr int SCALE_A = 0, SCALE_B = 0;
  CParams* p; const char* A; const char* B; int wg, nwg, KB;
  DEV bool get(int i, Unit& u) const { const int id = wg + i * nwg; if (id >= 68 * 8) return false; u.pn = id / 68; u.pm = id % 68; u.e = 0; u.r0 = 0; return true; }
  DEV const char* abase(const Unit& u, int half) const { return A + (size_t)(u.pm * BM + half * HALF) * KB; }
  DEV const char* bbase(const Unit& u) const { return B + (size_t)(u.pn * BM) * KB; }
  DEV void arow_fill(const Unit&, int*) const {}
  DEV void bias_load(const Unit&, f32x4 (&)[2][2], int, int) const {}
  DEV void epi(const Unit& u, const AccT& acc, int wr, int wc, int fr, int fq) const { EpiKV e{p, u.pm, u.pn}; e(acc, wr, wc, fr, fq); }
};
struct PolQ {
  static constexpr bool GATHER = false;
  static constexpr bool FP8 = false, HASBIAS = false; static constexpr int SCALE_A = 0, SCALE_B = 0;
  CParams* p; const char* A; const char* B; int wg, nwg, KB;
  DEV bool get(int i, Unit& u) const { const int id = wg + i * nwg; if (id >= 64 * 6) return false; u.pn = id >> 6; u.pm = id & 63; u.e = 0; u.r0 = 0; return true; }
  DEV const char* abase(const Unit& u, int half) const { return A + (size_t)(u.pm * BM + half * HALF) * KB; }
  DEV const char* bbase(const Unit& u) const { return B + (size_t)(u.pn * BM) * KB; }
  DEV void arow_fill(const Unit&, int*) const {}
  DEV void bias_load(const Unit&, f32x4 (&)[2][2], int, int) const {}
  DEV void epi(const Unit& u, const AccT& acc, int wr, int wc, int fr, int fq) const { EpiQ e{p, u.pm, u.pn}; e(acc, wr, wc, fr, fq); }
};
DEV void phase4_up(CParams& p, int wg, int nwg) {
  if (nwg >= 128) {
    if (wg < 64) { PolIn pol{&p, (const char*)p.h, (const char*)p.wt_in, wg, nwg, DM * 2, 1}; gemm_stream(pol); }
    else {
      { PolKV pol{&p, (const char*)p.ckvn, (const char*)p.wt_ukv, wg - 64, nwg - 64, KVRANK * 2}; gemm_stream(pol); }
      { PolQ pol{&p, (const char*)p.cqn, (const char*)p.wt_uq, (wg - 64 + 32) % (nwg - 64), nwg - 64, QRANK * 2}; gemm_stream(pol); }
    }
  } else {
    { PolIn pol{&p, (const char*)p.h, (const char*)p.wt_in, wg, nwg, DM * 2, 1}; gemm_stream(pol); }
    { PolKV pol{&p, (const char*)p.ckvn, (const char*)p.wt_ukv, wg, nwg, KVRANK * 2}; gemm_stream(pol); }
    { PolQ pol{&p, (const char*)p.cqn, (const char*)p.wt_uq, wg, nwg, QRANK * 2}; gemm_stream(pol); }
  }
}
struct PolOut {
  static constexpr bool GATHER = false;
  static constexpr bool FP8 = false, HASBIAS = false; static constexpr int SCALE_A = 0, SCALE_B = 0;
  CParams* p; const char* A; const char* B; int wg, nwg, KB;
  DEV bool get(int i, Unit& u) const { const int id = wg + i * nwg; if (id >= 64 * 8) return false; u.pn = id >> 6; u.pm = id & 63; u.e = 0; u.r0 = 0; return true; }
  DEV const char* abase(const Unit& u, int half) const { return A + (size_t)(u.pm * BM + half * HALF) * KB; }
  DEV const char* bbase(const Unit& u) const { return B + (size_t)(u.pn * BM) * KB; }
  DEV void arow_fill(const Unit&, int*) const {}
  DEV void bias_load(const Unit&, f32x4 (&)[2][2], int, int) const {}
  DEV void epi(const Unit& u, const AccT& acc, int wr, int wc, int fr, int fq) const { EpiOut e{p, u.pm, u.pn}; e(acc, wr, wc, fr, fq); }
};
DEV void phase6_outproj(CParams& p, int wg, int nwg) { PolOut pol{&p, (const char*)p.aout, (const char*)p.wt_out, wg, nwg, DM * 2}; gemm_stream(pol); }

constexpr int MOE_TAB_OFF = MOE_TAB_OFF_;
DEV int moe_prefix(CParams& p, int* tile_e, int* tile_r0) {
  const int t = ltid();
  if (t < 64) {
    const int c = t < NE ? p.cnt[t] : 0, n = (c + 255) >> 8; int inc = n;
#pragma unroll
    for (int st = 1; st < 32; st <<= 1) { const int v = __shfl_up(inc, st); if ((t & 63) >= st) inc += v; }
    const int first = inc - n;
    if (t < NE) for (int i = 0; i < n; ++i) { tile_e[first + i] = t; tile_r0[first + i] = i * 256; }
    if (t == NE - 1) tile_e[MAXTILES] = inc;
  }
  __syncthreads();
  return tile_e[MAXTILES];
}
struct PolGU {
  static constexpr bool GATHER = true, FP8 = true, HASBIAS = true; static constexpr int SCALE_A = FP8_SCALE_1, SCALE_B = FP8_SCALE_W;
  CParams* p; const char* A; const char* B; const int* tile_e; const int* tile_r0; int ntot, rbase, rstep, pncol, KB, noepi;
  DEV bool get(int i, Unit& u) const {
    u.pm = rstep * i + rbase; u.pn = pncol; if (u.pm >= ntot) return false;
    u.e = __builtin_amdgcn_readfirstlane(tile_e[u.pm]); u.r0 = __builtin_amdgcn_readfirstlane(tile_r0[u.pm]); return true; }
  DEV const char* abase(const Unit&, int) const { return A; }
  DEV const char* bbase(const Unit& u) const { return B + ((size_t)u.e * 4096 + u.pn * BM) * KB; }
  DEV void arow_fill(const Unit& u, int* tab) const { const int t = ltid(); if (t < 256) { const int r = u.r0 + t; tab[t] = r < p->cnt[u.e] ? p->idx[u.e * NLAT + r] : 0; } }
  DEV void bias_load(const Unit& u, f32x4 (&bv)[2][2], int wc, int fq) const {
    const float* bg = p->b_gu + (long)u.e * 4096 + u.pn * 128 + wc * 32 + 8 * fq;
    bv[0][0] = *(const f32x4*)bg; bv[0][1] = *(const f32x4*)(bg + 4); bv[1][0] = *(const f32x4*)(bg + 2048) + 1.0f; bv[1][1] = *(const f32x4*)(bg + 2052) + 1.0f; }
  DEV void epi(const Unit& u, const AccT& acc, int wr, int wc, int fr, int fq) const { if (noepi) return; EpiGU e{p, u.e, u.pm * 256, u.pn}; e(acc, wr, wc, fr, fq); }
};
struct PolDN {
  static constexpr bool GATHER = false, FP8 = true, HASBIAS = true; static constexpr int SCALE_A = FP8_SCALE_1, SCALE_B = FP8_SCALE_W;
  CParams* p; const char* A; const char* B; const int* tile_e; int ntot, rbase, rstep, pncol, KB, noepi;
  DEV bool get(int i, Unit& u) const {
    u.pm = rstep * i + rbase; u.pn = pncol; if (u.pm >= ntot) return false;
    u.e = __builtin_amdgcn_readfirstlane(tile_e[u.pm]); u.r0 = 0; return true; }
  DEV const char* abase(const Unit& u, int half) const { return A + (size_t)(u.pm * BM + half * HALF) * KB; }
  DEV const char* bbase(const Unit& u) const { return B + ((size_t)u.e * 2048 + u.pn * BM) * KB; }
  DEV void arow_fill(const Unit&, int*) const {}
  DEV void bias_load(const Unit& u, f32x4 (&bv)[2][2], int wc, int fq) const {
    const float* bd = p->b_dn + (long)u.e * 2048 + u.pn * 256 + wc * 32 + 8 * fq;
    bv[0][0] = *(const f32x4*)bd; bv[0][1] = *(const f32x4*)(bd + 4); bv[1][0] = *(const f32x4*)(bd + HALF); bv[1][1] = *(const f32x4*)(bd + HALF + 4); }
  DEV void epi(const Unit& u, const AccT& acc, int wr, int wc, int fr, int fq) const { if (noepi) return; EpiDN e{p, u.e, u.pm * 256, u.pn}; e(acc, wr, wc, fr, fq); }
};
template <int WHICH> DEV void phase_moe(CParams& p, int wg, int nwg, int noepi = 0) {
  extern __shared__ __attribute__((aligned(16))) char shm[];
  int* tile_e = (int*)(shm + MOE_TAB_OFF); int* tile_r0 = tile_e + MAXTILES + 1;
  const int ntiles = moe_prefix(p, tile_e, tile_r0);
  constexpr int NC = WHICH == 0 ? 16 : 8;
  int rbase, rstep, pncol;
  if (nwg == 256) { const int x = wg & 7, y = wg >> 3; rstep = 256 / NC; if (WHICH == 0) { rbase = 4 * (x >> 1) + (y >> 3); pncol = 8 * (x & 1) + (y & 7); } else { rbase = 4 * x + (y >> 3); pncol = y & 7; } }
  else { rbase = wg / NC; rstep = nwg / NC; pncol = wg % NC; }
  if (WHICH == 0) { PolGU pol{&p, (const char*)p.h2_8, (const char*)p.wt_gu8, tile_e, tile_r0, ntiles, rbase, rstep, pncol, DM, noepi}; gemm_stream(pol); }
  else { PolDN pol{&p, (const char*)p.act8, (const char*)p.wt_dn8, tile_e, ntiles, rbase, rstep, pncol, DFF, noepi}; gemm_stream(pol); }
}
DEV void phase3_rows(CParams& p, int wg, int nwg) {
  const int wid = ltid() >> 6, lane = ltid() & 63;
  for (int row = wg * 8 + wid; row < NROW; row += nwg * 8) {
    if (row >= NCTX) {
      const int lr = row - NCTX;
      const u32x4 raw = *(const u32x4*)(p.cq + (long)lr * QRANK + lane * 8);
      float v[8]; v[0] = bflo(raw.x); v[1] = bfhi(raw.x); v[2] = bflo(raw.y); v[3] = bfhi(raw.y); v[4] = bflo(raw.z); v[5] = bfhi(raw.z); v[6] = bflo(raw.w); v[7] = bfhi(raw.w);
      float ss = 0.f;
#pragma unroll
      for (int j = 0; j < 8; ++j) ss += v[j] * v[j];
      ss = wave_sum(ss); const float rstd = rsqrtf(ss * (1.f / QRANK) + EPS);
      const f32x4 w0 = *(const f32x4*)(p.q_norm + lane * 8), w1 = *(const f32x4*)(p.q_norm + lane * 8 + 4);
      u32x4 o; o.x = cvt_pk_bf16(v[0] * rstd * w0[0], v[1] * rstd * w0[1]); o.y = cvt_pk_bf16(v[2] * rstd * w0[2], v[3] * rstd * w0[3]);
      o.z = cvt_pk_bf16(v[4] * rstd * w1[0], v[5] * rstd * w1[1]); o.w = cvt_pk_bf16(v[6] * rstd * w1[2], v[7] * rstd * w1[3]);
      *(u32x4*)(p.cqn + (long)lr * QRANK + lane * 8) = o;
    }
    {
      const u32x2 raw = *(const u32x2*)(p.ckv + (long)row * KVRANK + lane * 4);
      float v[4]; v[0] = bflo(raw.x); v[1] = bfhi(raw.x); v[2] = bflo(raw.y); v[3] = bfhi(raw.y);
      float ss = v[0] * v[0] + v[1] * v[1] + v[2] * v[2] + v[3] * v[3];
      ss = wave_sum(ss); const float rstd = rsqrtf(ss * (1.f / KVRANK) + EPS);
      const f32x4 w0 = *(const f32x4*)(p.kv_norm + lane * 4);
      u32x2 o; o.x = cvt_pk_bf16(v[0] * rstd * w0[0], v[1] * rstd * w0[1]); o.y = cvt_pk_bf16(v[2] * rstd * w0[2], v[3] * rstd * w0[3]);
      *(u32x2*)(p.ckvn + (long)row * KVRANK + lane * 4) = o;
    }
    {
      const float kv = p.kr[(long)row * ROPE + lane];
      const float other = __shfl_xor(kv, 32);
      float o = kv;
      int b, key; row_to_bkey(row, b, key);
      if (row >= NCTX) {
        const int t = (row - NCTX) & 4095, a = lane & 31;
        const float cs = p.rope[t * 64 + a], sn = p.rope[t * 64 + 32 + a];
        o = lane < 32 ? kv * cs - other * sn : other * sn + kv * cs;
      }
      p.kr2[(long)row * ROPE + lane] = f2bf(o);
    }
  }
}

DEV void phase5c_rec(CParams& p, int wg, int nwg) {
  const int wid = ltid() >> 6, lane = ltid() & 63;
  for (int row = wg * 8 + wid; row < NLAT; row += nwg * 8) {
    const bf16_t* a = p.of + (long)row * 1024 + lane * 16; const bf16_t* b = p.ob + (long)row * 1024 + lane * 16;
    const u32x4 a0 = *(const u32x4*)a, a1 = *(const u32x4*)(a + 8), b0 = *(const u32x4*)b, b1 = *(const u32x4*)(b + 8);
    const unsigned aw[8] = {a0.x, a0.y, a0.z, a0.w, a1.x, a1.y, a1.z, a1.w}, bw[8] = {b0.x, b0.y, b0.z, b0.w, b1.x, b1.y, b1.z, b1.w};
    float v[16]; float ss = 0.f;
#pragma unroll
    for (int i = 0; i < 8; ++i) { v[2 * i] = bflo(aw[i]) + bflo(bw[i]); v[2 * i + 1] = bfhi(aw[i]) + bfhi(bw[i]); ss += v[2 * i] * v[2 * i] + v[2 * i + 1] * v[2 * i + 1]; }
    ss += __shfl_xor(ss, 1); ss += __shfl_xor(ss, 2); ss += __shfl_xor(ss, 4);
    const float rstd = rsqrtf(ss * (1.f / DV) + EPS);
    const bf16_t* gp = p.gate + (long)(NCTX + row) * 1024 + lane * 16;
    const u32x4 g0 = *(const u32x4*)gp, g1 = *(const u32x4*)(gp + 8);
    float gt[16]; gt[0] = bflo(g0.x); gt[1] = bfhi(g0.x); gt[2] = bflo(g0.y); gt[3] = bfhi(g0.y); gt[4] = bflo(g0.z); gt[5] = bfhi(g0.z); gt[6] = bflo(g0.w); gt[7] = bfhi(g0.w);
    gt[8] = bflo(g1.x); gt[9] = bfhi(g1.x); gt[10] = bflo(g1.y); gt[11] = bfhi(g1.y); gt[12] = bflo(g1.z); gt[13] = bfhi(g1.z); gt[14] = bflo(g1.w); gt[15] = bfhi(g1.w);
    const float* gn = p.g_norm + (lane & 7) * 16;
    unsigned o[8];
#pragma unroll
    for (int j = 0; j < 8; ++j) o[j] = cvt_pk_bf16(v[2 * j] * rstd * gn[2 * j] * gt[2 * j], v[2 * j + 1] * rstd * gn[2 * j + 1] * gt[2 * j + 1]);
    bf16_t* op = p.aout + (long)row * DM + 1024 + lane * 16;
    *(u32x4*)op = (u32x4){o[0], o[1], o[2], o[3]}; *(u32x4*)(op + 8) = (u32x4){o[4], o[5], o[6], o[7]};
  }
}

constexpr int H2S_LD = 2052;
template <bool ROUTE> DEV void phase7_post(CParams& p, int wg, int nwg) {
  extern __shared__ __attribute__((aligned(16))) char shm[];
  float* h2s = (float*)shm;
  float* red = (float*)(shm + 16 * H2S_LD * 4);
  const int tid = ltid(), wid = tid >> 6, lane = tid & 63;
  for (int g = wg; g < NLAT / 16; g += nwg) {
#pragma unroll 1
    for (int rr = 0; rr < 2; ++rr) {
      const int lr = wid * 2 + rr, row = g * 16 + lr, b = row >> 12;
      const float* mod = p.mod + b * 12288;
      const bf16_t* mr = p.mix + (long)row * DM; const float* xr = p.x + (long)row * DM;
      f32x4 v[8], xv[8]; u32x2 m2[8]; float ss = 0.f;
#pragma unroll
      for (int i = 0; i < 8; ++i) m2[i] = *(const u32x2*)(mr + i * 256 + lane * 4);
#pragma unroll
      for (int i = 0; i < 8; ++i) xv[i] = *(const f32x4*)(xr + i * 256 + lane * 4);
#pragma unroll
      for (int i = 0; i < 8; ++i) { v[i] = (f32x4){bflo(m2[i].x), bfhi(m2[i].x), bflo(m2[i].y), bfhi(m2[i].y)};
        ss += v[i][0] * v[i][0] + v[i][1] * v[i][1] + v[i][2] * v[i][2] + v[i][3] * v[i][3]; }
      ss = wave_sum(ss); const float rstd = rsqrtf(ss * (1.f / DM) + EPS);
      float s2 = 0.f;
#pragma unroll
      for (int i = 0; i < 8; ++i) {
        const int c0 = i * 256 + lane * 4;
        const f32x4 w = *(const f32x4*)(p.ln_mix_post + c0), gm = *(const f32x4*)(mod + 4096 + c0), xx = xv[i];
#pragma unroll
        for (int j = 0; j < 4; ++j) { v[i][j] = xx[j] + gm[j] * (v[i][j] * rstd * w[j]); s2 += v[i][j] * v[i][j]; }
        st_bf16x4(p.x1 + (long)row * DM + c0, v[i]);
      }
      s2 = wave_sum(s2); const float rstd2 = rsqrtf(s2 * (1.f / DM) + EPS);
#pragma unroll
      for (int i = 0; i < 8; ++i) {
        const int c0 = i * 256 + lane * 4;
        const f32x4 w = *(const f32x4*)(p.ln_ffn_pre + c0), s1 = *(const f32x4*)(mod + 8192 + c0), s0 = *(const f32x4*)(mod + 6144 + c0);
        f32x4 y;
#pragma unroll
        for (int j = 0; j < 4; ++j) y[j] = v[i][j] * rstd2 * w[j] * (1.f + s1[j]) + s0[j];
        *(unsigned*)(p.h2_8 + (long)row * DM + c0) = cvt_pk4_fp8(y);
        *(f32x4*)(h2s + lr * H2S_LD + c0) = y;
      }
    }
    {
      f32x4 a0 = {0.f, 0.f, 0.f, 0.f}, a1 = {0.f, 0.f, 0.f, 0.f};
      const int r16 = lane & 15, kq = lane >> 4;
      const float* ap = h2s + r16 * H2S_LD + wid * 256 + kq;
      const float* bp = p.router_w + (long)(wid * 256 + kq) * NE + r16;
      float bw0[16], bw1[16];
#pragma unroll
      for (int s = 0; s < 16; ++s) { bw0[s] = bp[(long)(4 * s) * NE]; bw1[s] = bp[(long)(4 * s) * NE + 16]; }
      __syncthreads();
#pragma unroll
      for (int s = 0; s < 16; ++s) {
        const float av = ap[4 * s];
        a0 = __builtin_amdgcn_mfma_f32_16x16x4f32(av, bw0[s], a0, 0, 0, 0);
        a1 = __builtin_amdgcn_mfma_f32_16x16x4f32(av, bw1[s], a1, 0, 0, 0);
      }
#pragma unroll 16
      for (int s = 16; s < 64; ++s) {
        const float av = ap[4 * s], b0 = bp[(long)(4 * s) * NE], b1 = bp[(long)(4 * s) * NE + 16];
        a0 = __builtin_amdgcn_mfma_f32_16x16x4f32(av, b0, a0, 0, 0, 0);
        a1 = __builtin_amdgcn_mfma_f32_16x16x4f32(av, b1, a1, 0, 0, 0);
      }
#pragma unroll
      for (int j = 0; j < 4; ++j) { red[(wid * 16 + 4 * kq + j) * 32 + r16] = a0[j]; red[(wid * 16 + 4 * kq + j) * 32 + 16 + r16] = a1[j]; }
    }
    __syncthreads();
    {
      const int r = tid >> 5, e = tid & 31; float sl = p.router_b[e];
#pragma unroll
      for (int w = 0; w < 8; ++w) sl += red[(w * 16 + r) * 32 + e];
      if (ROUTE) {
        const int row = g * 16 + r;
        float sv[4]; int sel[4];
#pragma unroll
        for (int k = 0; k < 4; ++k) {
          float bv = sl; int bi = e;
#pragma unroll
          for (int st = 1; st < 32; st <<= 1) { const float ov = __shfl_xor(bv, st); const int oi = __shfl_xor(bi, st); const bool take = ov > bv || (ov == bv && oi < bi); bv = take ? ov : bv; bi = take ? oi : bi; }
          sv[k] = bv; sel[k] = bi; if (e == bi) sl = -3.0e38f;
        }
        const float e1 = __expf(sv[1] - sv[0]), e2 = __expf(sv[2] - sv[0]), e3 = __expf(sv[3] - sv[0]), inv = 1.f / (1.f + e1 + e2 + e3);
        if (e < 4) {
          const int se = e == 0 ? sel[0] : (e == 1 ? sel[1] : (e == 2 ? sel[2] : sel[3]));
          const float gk = (e == 0 ? 1.f : (e == 1 ? e1 : (e == 2 ? e2 : e3))) * inv;
          const int pos = atomicAdd(p.cnt + se, 1);
          p.idx[se * NLAT + pos] = row;
          p.tok_e[row * 4 + e] = se; p.tok_pos[row * 4 + e] = pos; p.tok_gate[row * 4 + e] = gk;
        }
      }
    }
  }
}

DEV void phase11_final(CParams& p, int wg, int nwg) {
  extern __shared__ __attribute__((aligned(16))) char shm[];
  int* rowbase = (int*)shm;
  if (ltid() == 0) { int nt = 0; for (int e = 0; e < NE; ++e) { rowbase[e] = nt * 256; nt += (p.cnt[e] + 255) >> 8; } }
  __syncthreads();
  const int wid = ltid() >> 6, lane = ltid() & 63;
  i32x4 te_n, tp_n; f32x4 tg_n;
  { const int r0 = wg * 8 + wid; if (r0 < NLAT) { te_n = *(const i32x4*)(p.tok_e + r0 * 4); tp_n = *(const i32x4*)(p.tok_pos + r0 * 4); tg_n = *(const f32x4*)(p.tok_gate + r0 * 4); } }
  for (int row = wg * 8 + wid; row < NLAT; row += nwg * 8) {
    const int b = row >> 12; const float* mod = p.mod + b * 12288;
    const i32x4 te = te_n, tp = tp_n; const f32x4 tg = tg_n;
    { const int rn = row + nwg * 8; if (rn < NLAT) { te_n = *(const i32x4*)(p.tok_e + rn * 4); tp_n = *(const i32x4*)(p.tok_pos + rn * 4); tg_n = *(const f32x4*)(p.tok_gate + rn * 4); } }
    f32x4 y[2][4]; u32x4 xr[2][2];
#pragma unroll
    for (int i = 0; i < 2; ++i) { const bf16_t* xp = p.x1 + (long)row * DM + 1024 * i + lane * 16; xr[i][0] = *(const u32x4*)xp; xr[i][1] = *(const u32x4*)(xp + 8); }
#pragma unroll
    for (int i = 0; i < 2; ++i)
#pragma unroll
      for (int j = 0; j < 4; ++j) y[i][j] = (f32x4){0.f, 0.f, 0.f, 0.f};
#pragma unroll
    for (int k = 0; k < 4; ++k) {
      const int e = te[k], pos = tp[k]; const float gt = tg[k];
      const unsigned char* yr = p.ys8 + (long)(rowbase[e] + pos) * DM + lane * 16;
#pragma unroll
      for (int i = 0; i < 2; ++i) {
        const u32x4 r = *(const u32x4*)(yr + 1024 * i); const unsigned rw[4] = {r.x, r.y, r.z, r.w};
#pragma unroll
        for (int j = 0; j < 4; ++j) { const f32x2 lo = __builtin_amdgcn_cvt_pk_f32_fp8(rw[j], false), hi = __builtin_amdgcn_cvt_pk_f32_fp8(rw[j], true);
          y[i][j][0] += gt * lo.x; y[i][j][1] += gt * lo.y; y[i][j][2] += gt * hi.x; y[i][j][3] += gt * hi.y; }
      }
    }
    float ss = 0.f;
#pragma unroll
    for (int i = 0; i < 2; ++i)
#pragma unroll
      for (int j = 0; j < 4; ++j) ss += y[i][j][0] * y[i][j][0] + y[i][j][1] * y[i][j][1] + y[i][j][2] * y[i][j][2] + y[i][j][3] * y[i][j][3];
    ss = wave_sum(ss); const float rstd = rsqrtf(ss * (1.f / DM) + EPS);
#pragma unroll
    for (int i = 0; i < 2; ++i)
#pragma unroll
      for (int j = 0; j < 4; ++j) {
        const int c0 = 1024 * i + lane * 16 + 4 * j;
        const f32x4 w = *(const f32x4*)(p.ln_ffn_post + c0), gf = *(const f32x4*)(mod + 10240 + c0);
        const unsigned x01 = xr[i][j >> 1][(j & 1) * 2], x23 = xr[i][j >> 1][(j & 1) * 2 + 1]; const f32x4 xx = {bflo(x01), bfhi(x01), bflo(x23), bfhi(x23)};
        f32x4 o;
#pragma unroll
        for (int jj = 0; jj < 4; ++jj) o[jj] = xx[jj] + gf[jj] * (y[i][j][jj] * rstd * w[jj]);
        *(f32x4*)(p.out + (long)row * DM + c0) = o;
      }
  }
}
namespace att {
constexpr int NW = 8, QBLK = 32, KVBLK = 64;
constexpr float SCALE = 0.07216878364870322f;
constexpr float THR = 8.f;
constexpr int SHM_V = KVBLK * DV * 2, SHM_K = KVBLK * 512;
constexpr int LDS_BYTES = 2 * SHM_V + 2 * SHM_K + NW * 64 * 4;
#define KSWZ2(row, colB) ((row) * 512 + ((colB) ^ (((row) & 15) << 4)))
#define SBAR() __builtin_amdgcn_sched_barrier(0)
DEV int crow(int r, int hi) { return (r & 3) + 8 * (r >> 2) + 4 * hi; }

DEV void partialSM(f32x16& p0, f32x16& p1, float& m_reg, float& mn, float& alpha) {
  constexpr float C = SCALE * 1.4426950408889634f;
  float pmax = p0[0];
#pragma unroll
  for (int r = 1; r < 16; ++r) pmax = fmaxf(pmax, p0[r]);
#pragma unroll
  for (int r = 0; r < 16; ++r) pmax = fmaxf(pmax, p1[r]);
  { auto rr = __builtin_amdgcn_permlane32_swap(__float_as_uint(pmax), __float_as_uint(pmax), false, false);
    pmax = fmaxf(__uint_as_float(rr[0]), __uint_as_float(rr[1])); }
  if (__builtin_expect(__all(pmax - m_reg <= THR / SCALE), 1)) { mn = m_reg; alpha = 1.f; }
  else { mn = fmaxf(m_reg, pmax); alpha = __builtin_amdgcn_exp2f((m_reg - mn) * C); m_reg = mn; }
  const float mnC = -mn * C;
#pragma unroll
  for (int r = 0; r < 16; ++r) p0[r] = fmaf(p0[r], C, mnC);
#pragma unroll
  for (int r = 0; r < 16; ++r) p1[r] = fmaf(p1[r], C, mnC);
#pragma unroll
  for (int r = 0; r < 16; ++r) p0[r] = __builtin_amdgcn_exp2f(p0[r]);
}
DEV void finishSM(f32x16& p0, f32x16& p1, float alpha, float& l_reg, bf16x8& pa0, bf16x8& pa1, bf16x8& pa2, bf16x8& pa3) {
#pragma unroll
  for (int r = 0; r < 16; ++r) p1[r] = __builtin_amdgcn_exp2f(p1[r]);
  float ps = 0;
#pragma unroll
  for (int r = 0; r < 16; ++r) ps += p0[r];
#pragma unroll
  for (int r = 0; r < 16; ++r) ps += p1[r];
  { auto rr = __builtin_amdgcn_permlane32_swap(__float_as_uint(ps), __float_as_uint(ps), false, false);
    ps = __uint_as_float(rr[0]) + __uint_as_float(rr[1]); }
  l_reg = l_reg * alpha + ps;
#define PK4(P, BASE, OUT) do { unsigned a0 = cvt_pk_bf16(P[BASE + 0], P[BASE + 1]), a1 = cvt_pk_bf16(P[BASE + 2], P[BASE + 3]);   \
    unsigned b0 = cvt_pk_bf16(P[BASE + 4], P[BASE + 5]), b1 = cvt_pk_bf16(P[BASE + 6], P[BASE + 7]);                              \
    auto r0 = __builtin_amdgcn_permlane32_swap(a0, b0, false, false); auto r1 = __builtin_amdgcn_permlane32_swap(a1, b1, false, false); \
    u32x4 w = {r0[0], r1[0], r0[1], r1[1]}; OUT = *reinterpret_cast<bf16x8*>(&w); } while (0)
  PK4(p0, 0, pa0); PK4(p0, 8, pa1); PK4(p1, 0, pa2); PK4(p1, 8, pa3);
#undef PK4
}
DEV void qkt(f32x16& p0, f32x16& p1, const char* Ks, const bf16x8* qr, int r32, int hi) {
  p0 = f32x16{}; p1 = f32x16{};
#pragma unroll
  for (int d0 = 0; d0 < 12; ++d0) { const int cb = (d0 * 16 + hi * 8) * 2;
    const bf16x8 b0 = *reinterpret_cast<const bf16x8*>(Ks + KSWZ2(r32, cb));
    const bf16x8 b1 = *reinterpret_cast<const bf16x8*>(Ks + KSWZ2(32 + r32, cb));
    p0 = __builtin_amdgcn_mfma_f32_32x32x16_bf16(b0, qr[d0], p0, 0, 0, 0);
    p1 = __builtin_amdgcn_mfma_f32_32x32x16_bf16(b1, qr[d0], p1, 0, 0, 0); }
}
DEV int v_st(int k, int c) { const int kk = (k & ~0xC) | ((k & 4) << 1) | ((k & 8) >> 1); return ((kk >> 3) * 4 + (c >> 5)) * 512 + ((kk & 7) * 32 + (c & 31)) * 2; }
DEV int v_rd_base(int lane) { return ((lane & 3) << 3) | (((lane >> 2) & 3) << 6) | (((lane >> 4) & 1) << 5) | (((lane >> 5) & 1) << 8); }
constexpr int v_rd_off(int d0, int ks, int half) { return d0 * 512 + ks * 4096 + half * 2048; }
template <int OFF> DEV s16x4 tr_read(int vb) { s16x4 r; asm volatile("ds_read_b64_tr_b16 %0, %1 offset:%2" : "=&v"(r) : "v"(vb), "i"(OFF) : "memory"); return r; }
struct VFrag { s16x4 l0, h0, l1, h1, l2, h2, l3, h3; };
template <int D0> DEV void pv_read(VFrag& f, int vb) {
  f.l0 = tr_read<v_rd_off(D0, 0, 0)>(vb); f.h0 = tr_read<v_rd_off(D0, 0, 1)>(vb); f.l1 = tr_read<v_rd_off(D0, 1, 0)>(vb); f.h1 = tr_read<v_rd_off(D0, 1, 1)>(vb);
  f.l2 = tr_read<v_rd_off(D0, 2, 0)>(vb); f.h2 = tr_read<v_rd_off(D0, 2, 1)>(vb); f.l3 = tr_read<v_rd_off(D0, 3, 0)>(vb); f.h3 = tr_read<v_rd_off(D0, 3, 1)>(vb);
}
DEV void pv_mma(f32x16& od, const VFrag& f, bf16x8 pa0, bf16x8 pa1, bf16x8 pa2, bf16x8 pa3) {
#define PK(L, H) (bf16x8){L[0], L[1], L[2], L[3], H[0], H[1], H[2], H[3]}
  od = __builtin_amdgcn_mfma_f32_32x32x16_bf16(pa0, PK(f.l0, f.h0), od, 0, 0, 0);
  od = __builtin_amdgcn_mfma_f32_32x32x16_bf16(pa1, PK(f.l1, f.h1), od, 0, 0, 0);
  od = __builtin_amdgcn_mfma_f32_32x32x16_bf16(pa2, PK(f.l2, f.h2), od, 0, 0, 0);
  od = __builtin_amdgcn_mfma_f32_32x32x16_bf16(pa3, PK(f.l3, f.h3), od, 0, 0, 0);
#undef PK
}
#define PV_WAIT(n) do { asm volatile("s_waitcnt lgkmcnt(" #n ")" ::: "memory"); SBAR(); } while (0)
DEV void pv_d0(f32x16* o, int vb, bf16x8 pa0, bf16x8 pa1, bf16x8 pa2, bf16x8 pa3) {
  VFrag fa, fb;
  pv_read<0>(fa, vb);
  pv_read<1>(fb, vb); PV_WAIT(8); pv_mma(o[0], fa, pa0, pa1, pa2, pa3); SBAR();
  pv_read<2>(fa, vb); PV_WAIT(8); pv_mma(o[1], fb, pa0, pa1, pa2, pa3); SBAR();
  pv_read<3>(fb, vb); PV_WAIT(8); pv_mma(o[2], fa, pa0, pa1, pa2, pa3); SBAR();
  PV_WAIT(0); pv_mma(o[3], fb, pa0, pa1, pa2, pa3);
}

DEV void attn_unit(const bf16_t* __restrict__ Qb, const bf16_t* __restrict__ Kh, const bf16_t* __restrict__ Vh, const float* __restrict__ rp, bf16_t* __restrict__ Ob, CParams& fp, int fwg, int fbase, int fn) {
  extern __shared__ __attribute__((aligned(16))) char shm[];
  const int tid = ltid(), wid = tid >> 6, lane = tid & 63, r32 = lane & 31, hi = lane >> 5;
  char* V_lds = shm; char* K_lds = shm + 2 * SHM_V;
  float* ws = (float*)(shm + 2 * SHM_V + 2 * SHM_K) + wid * 64; float* li_l = ws; float* al_l = ws + 32;
  float m_reg = -1e30f, l_reg = 0; f32x16 o[4] = {}; bf16x8 qr[12];
  {
    const bf16_t* Qw = Qb + (long)(wid * QBLK + r32) * QK + hi * 8;
#pragma unroll
    for (int d0 = 0; d0 < 12; ++d0) qr[d0] = *reinterpret_cast<const bf16x8*>(Qw + d0 * 16);
    const float* rr = rp + (long)(wid * QBLK + r32) * 64;
#pragma unroll
    for (int dd = 0; dd < 2; ++dd) {
      const int a0 = 16 * dd + 8 * hi;
      const f32x4 c0 = *(const f32x4*)(rr + a0), c1 = *(const f32x4*)(rr + a0 + 4), s0 = *(const f32x4*)(rr + 32 + a0), s1 = *(const f32x4*)(rr + 32 + a0 + 4);
      float cs[8] = {c0[0], c0[1], c0[2], c0[3], c1[0], c1[1], c1[2], c1[3]}, sn[8] = {s0[0], s0[1], s0[2], s0[3], s1[0], s1[1], s1[2], s1[3]};
      const bf16x8 x1 = qr[8 + dd], x2 = qr[10 + dd]; bf16x8 y1, y2;
#pragma unroll
      for (int j = 0; j < 8; j += 2) {
        const float a1 = bf2f((bf16_t)x1[j]), a2 = bf2f((bf16_t)x2[j]), b1 = bf2f((bf16_t)x1[j + 1]), b2 = bf2f((bf16_t)x2[j + 1]);
        const unsigned u1 = cvt_pk_bf16(a1 * cs[j] - a2 * sn[j], b1 * cs[j + 1] - b2 * sn[j + 1]);
        const unsigned u2 = cvt_pk_bf16(a1 * sn[j] + a2 * cs[j], b1 * sn[j + 1] + b2 * cs[j + 1]);
        y1[j] = (short)(u1 & 0xffff); y1[j + 1] = (short)(u1 >> 16); y2[j] = (short)(u2 & 0xffff); y2[j + 1] = (short)(u2 >> 16);
      }
      qr[8 + dd] = y1; qr[10 + dd] = y2;
    }
  }
  const int sr = tid >> 4, sc = (tid & 15) * 8, vst0 = v_st(sr, sc), vst1 = v_st(32 + sr, sc);
  int kst[3];
#pragma unroll
  for (int i = 0; i < 3; ++i) { const int id = tid + 512 * i, row = id / 24, ch = id % 24; kst[i] = KSWZ2(row, ch * 16); }
  const int vb0 = (int)(uintptr_t)V_lds + v_rd_base(lane);
  bf16x8 vs0, vs1, ks0, ks1, ks2;
#define SLOAD(k0) do { vs0 = *reinterpret_cast<const bf16x8*>(Vh + (long)((k0) + sr) * DV + sc); vs1 = *reinterpret_cast<const bf16x8*>(Vh + (long)((k0) + 32 + sr) * DV + sc); \
    const bf16_t* kp_ = Kh + (long)(k0) * QK + tid * 8; ks0 = *reinterpret_cast<const bf16x8*>(kp_); ks1 = *reinterpret_cast<const bf16x8*>(kp_ + 4096); ks2 = *reinterpret_cast<const bf16x8*>(kp_ + 8192); } while (0)
#define SWRITE(b) do { *(bf16x8*)(V_lds + (b) * SHM_V + vst0) = vs0; *(bf16x8*)(V_lds + (b) * SHM_V + vst1) = vs1; \
    *(bf16x8*)(K_lds + (b) * SHM_K + kst[0]) = ks0; *(bf16x8*)(K_lds + (b) * SHM_K + kst[1]) = ks1; *(bf16x8*)(K_lds + (b) * SHM_K + kst[2]) = ks2; } while (0)
#define SWAIT() asm volatile("s_waitcnt vmcnt(0)" ::: "memory")
#define RESC(a) do { if (__any((a) < 1.f)) { if (hi == 0) al_l[r32] = (a); asm volatile("s_waitcnt lgkmcnt(0)" ::: "memory"); \
    _Pragma("unroll") for (int d = 0; d < 4; ++d) _Pragma("unroll") for (int r = 0; r < 16; ++r) o[d][r] *= al_l[crow(r, hi)]; } } while (0)
  f32x16 p0, p1; float mn, al; bf16x8 pa0, pa1, pa2, pa3; constexpr int NTL = KEYS / KVBLK;
  f32x4 fld[4];
  if (fn > 0) fill_load(fp, fwg, fbase, fld);
  SLOAD(0); SWAIT(); SWRITE(0); SLOAD(KVBLK); __syncthreads();
#pragma unroll 1
  for (int j = 0; j < NTL; ++j) {
    const int cb = j & 1;
    if (j + 1 < NTL) { if (j >= 2 && j < fn) asm volatile("s_waitcnt vmcnt(5)" ::: "memory"); else SWAIT(); SWRITE(cb ^ 1); }
    if (j + 2 < NTL) SLOAD((j + 2) * KVBLK);
    if (j > 0 && j <= fn) fill_store(fp, fwg, fbase + j - 1, (j - 1) & 1);
    SBAR(); qkt(p0, p1, K_lds + cb * SHM_K, qr, r32, hi);
    partialSM(p0, p1, m_reg, mn, al);
    RESC(al);
    finishSM(p0, p1, al, l_reg, pa0, pa1, pa2, pa3); SBAR();
    pv_d0(o, vb0 + cb * SHM_V, pa0, pa1, pa2, pa3);
    if (j < fn) { fill_write(fld, j & 1); if (j + 1 < fn) fill_load(fp, fwg, fbase + j + 1, fld); }
    __syncthreads();
  }
  if (fn == NTL) fill_store(fp, fwg, fbase + NTL - 1, (NTL - 1) & 1);
  if (hi == 0) li_l[r32] = l_reg;
  asm volatile("s_waitcnt lgkmcnt(0)" ::: "memory");
  float rli[16];
#pragma unroll
  for (int r = 0; r < 16; ++r) rli[r] = __builtin_amdgcn_rcpf(li_l[crow(r, hi)]);
  bf16_t* Ow = Ob + (long)(wid * QBLK) * DM;
  constexpr int OPITCH = DV * 2 + 16;
  char* ost = shm + wid * (QBLK * OPITCH);
#pragma unroll
  for (int r = 0; r < 16; ++r) { const int orow = crow(r, hi);
#pragma unroll
    for (int d0 = 0; d0 < 4; ++d0) *(bf16_t*)(ost + orow * OPITCH + (d0 * 32 + r32) * 2) = f2bf(o[d0][r] * rli[r]); }
  asm volatile("s_waitcnt lgkmcnt(0)" ::: "memory");
#pragma unroll
  for (int k = 0; k < 8; ++k) { const int idx = k * 64 + lane, row = idx >> 4, ch = idx & 15;
    *(u32x4*)(Ow + (long)row * DM + ch * 8) = *(const u32x4*)(ost + row * OPITCH + ch * 16); }
  __syncthreads();
#undef SLOAD
#undef SWRITE
#undef SWAIT
#undef RESC
}
}

DEV void phase5a_attn(CParams& p, int u, int fwg = 0, int fbase = 0, int fn = 0) {
  const int qb = u & 15, h = (u >> 4) & 7, b = u >> 7;
  const long bh = b * NH + h;
  att::attn_unit(p.qf + (bh * SEQ + qb * 256) * QK, p.kf + bh * KEYS * QK, p.vf + bh * KEYS * DV, p.rope + (long)(qb * 256) * 64,
                 p.aout + (long)(b * SEQ + qb * 256) * DM + h * DV, p, fwg, fbase, fn);
}
namespace hg {
constexpr int LQ = 136, LS = 72;
constexpr int O_QT = 0, O_KT = O_QT + 64 * LQ * 2, O_KHT = O_KT + 64 * LQ * 2, O_VT = O_KHT + 128 * LS * 2, O_ST = O_VT + 32 * LS * 2, BUF = O_ST + 32 * LQ * 2;
constexpr int LDS_BYTES = 2 * BUF;
DEV bf16x8 ld8(const char* p) { return *reinterpret_cast<const bf16x8*>(p); }
DEV bf16x8 ld44(const char* p0, const char* p1) { const s16x4 a = *reinterpret_cast<const s16x4*>(p0), b = *reinterpret_cast<const s16x4*>(p1); return (bf16x8){a[0], a[1], a[2], a[3], b[0], b[1], b[2], b[3]}; }

DEV void hgrn_unit(CParams& p, int u, int wg, bool fill) {
  extern __shared__ __attribute__((aligned(16))) char shm[];
  const int sl = u & 3, dir = (u >> 2) & 1, h = (u >> 3) & 7, b = u >> 6;
  const int tid = ltid(), wid = tid >> 6, lane = tid & 63, fr = lane & 15, fq = lane >> 4;
  const int dp = lane & 7, seg = lane >> 3, d0 = 16 * wid + 2 * dp;
  const float* G = dir ? p.gb : p.gf;
  bf16_t* O = dir ? p.ob : p.of;
  const int sgn = dir ? -1 : 1;
#define HG_ROW0(c_, r0_) do { if ((c_) < 4) r0_ = dir ? b * 256 + 255 - 64 * (c_) : b * 256 + 64 * (c_); \
    else r0_ = dir ? NCTX + b * 4096 + 4095 - 64 * ((c_) - 4) : NCTX + b * 4096 + 64 * ((c_) - 4); } while (0)
#define HG_LOAD(c_, G_, Q_, V_) do { int r0n_; HG_ROW0(c_, r0n_); \
    _Pragma("unroll") for (int ii = 0; ii < 8; ++ii) { const long row_ = r0n_ + sgn * (8 * seg + ii); G_[ii] = *(const f32x2*)(G + row_ * 1024 + h * 128 + d0); Q_[ii] = *(const unsigned*)(p.qh + row_ * 1024 + h * 128 + d0); } \
    { const long row_ = r0n_ + sgn * (tid >> 3); V_ = *(const u32x2*)(p.vh + row_ * 1024 + h * 128 + sl * 32 + (tid & 7) * 4); } } while (0)
  f32x4 S[2] = {{0.f, 0.f, 0.f, 0.f}, {0.f, 0.f, 0.f, 0.f}};
  float dec = 0.f;
  f32x2 g[8]; unsigned q[8]; u32x2 v;
  f32x2 gN[8]; unsigned qN[8]; u32x2 vN;
#define HG_ELEM(cn_, LATN_) do { char* bufn = shm + ((cn_) & 1) * BUF; \
    { bf16_t* VT = (bf16_t*)(bufn + O_VT); const int i = tid >> 3, e4 = (tid & 7) * 4; \
      VT[(e4 + 0) * LS + i] = (bf16_t)(v.x & 0xffff); VT[(e4 + 1) * LS + i] = (bf16_t)(v.x >> 16); VT[(e4 + 2) * LS + i] = (bf16_t)(v.y & 0xffff); VT[(e4 + 3) * LS + i] = (bf16_t)(v.y >> 16); } \
    f32x2 cp[8]; cp[0] = g[0]; \
    _Pragma("unroll") for (int ii = 1; ii < 8; ++ii) cp[ii] = cp[ii - 1] * g[ii]; \
    f32x2 inc = cp[7]; \
    _Pragma("unroll") for (int st = 8; st < 64; st <<= 1) { const float t0 = __shfl_up(inc[0], st), t1 = __shfl_up(inc[1], st); if (lane >= st) { inc[0] *= t0; inc[1] *= t1; } } \
    f32x2 off; { const float t0 = __shfl_up(inc[0], 8), t1 = __shfl_up(inc[1], 8); off[0] = lane >= 8 ? t0 : 1.f; off[1] = lane >= 8 ? t1 : 1.f; } \
    f32x2 BL, R; BL[0] = __shfl(inc[0], dp + 56); BL[1] = __shfl(inc[1], dp + 56); R[0] = __shfl(inc[0], dp + 24); R[1] = __shfl(inc[1], dp + 24); \
    const float Ri0 = __builtin_amdgcn_rcpf(fmaxf(R[0], 1e-35f)), Ri1 = __builtin_amdgcn_rcpf(fmaxf(R[1], 1e-35f)); \
    const float ebl0 = BL[0] * Ri0, ebl1 = BL[1] * Ri1; \
    const float b0s = __shfl(BL[0], fr >> 1), b1s = __shfl(BL[1], fr >> 1), r0s = __shfl(R[0], fr >> 1), r1s = __shfl(R[1], fr >> 1); \
    dec = (fr & 1) ? b1s : b0s; \
    if (LATN_) { const float er = (fr & 1) ? r1s : r0s; bf16_t* ST = (bf16_t*)(bufn + O_ST); \
      _Pragma("unroll") for (int eb = 0; eb < 2; ++eb) _Pragma("unroll") for (int j = 0; j < 4; ++j) ST[(eb * 16 + 4 * fq + j) * LQ + wid * 16 + fr] = f2bf(S[eb][j] * er); } \
    unsigned kh0[4], kh1[4]; \
    _Pragma("unroll") for (int ii = 0; ii < 8; ii += 2) { float k0v[2], k1v[2]; \
      _Pragma("unroll") for (int z = 0; z < 2; ++z) { const int i = 8 * seg + ii + z; \
        const float E0 = fminf(fmaxf(off[0] * cp[ii + z][0] * Ri0, 1e-30f), 1e30f), E1 = fminf(fmaxf(off[1] * cp[ii + z][1] * Ri1, 1e-30f), 1e30f); \
        const float Ei0 = __builtin_amdgcn_rcpf(E0), Ei1 = __builtin_amdgcn_rcpf(E1); \
        const float kt0 = (1.f - g[ii + z][0]) * Ei0, kt1 = (1.f - g[ii + z][1]) * Ei1; \
        *(unsigned*)(bufn + O_KT + (i * LQ + d0) * 2) = cvt_pk_bf16(kt0, kt1); \
        if (LATN_) *(unsigned*)(bufn + O_QT + (i * LQ + d0) * 2) = cvt_pk_bf16(bflo(q[ii + z]) * E0, bfhi(q[ii + z]) * E1); \
        k0v[z] = kt0 * ebl0; k1v[z] = kt1 * ebl1; } \
      kh0[ii >> 1] = cvt_pk_bf16(k0v[0], k0v[1]); kh1[ii >> 1] = cvt_pk_bf16(k1v[0], k1v[1]); } \
    *(u32x4*)(bufn + O_KHT + (d0 * LS + 8 * seg) * 2) = (u32x4){kh0[0], kh0[1], kh0[2], kh0[3]}; \
    *(u32x4*)(bufn + O_KHT + ((d0 + 1) * LS + 8 * seg) * 2) = (u32x4){kh1[0], kh1[1], kh1[2], kh1[3]}; } while (0)
#define HG_MMA(c_, LATC_) do { const char* bufc = shm + ((c_) & 1) * BUF; \
    if (LATC_) { const int tb = wid >> 1, eb = wid & 1; f32x4 P[4]; \
      _Pragma("unroll") for (int sb = 0; sb < 4; ++sb) { P[sb] = (f32x4){0.f, 0.f, 0.f, 0.f}; \
        if (sb <= tb) { \
          _Pragma("unroll") for (int ks = 0; ks < 4; ++ks) { \
            const bf16x8 a = ld8(bufc + O_KT + ((sb * 16 + fr) * LQ + 32 * ks + 8 * fq) * 2), bq = ld8(bufc + O_QT + ((tb * 16 + fr) * LQ + 32 * ks + 8 * fq) * 2); \
            P[sb] = __builtin_amdgcn_mfma_f32_16x16x32_bf16(a, bq, P[sb], 0, 0, 0); }        \
          if (sb == tb) { _Pragma("unroll") for (int j = 0; j < 4; ++j) P[sb][j] = (4 * fq + j <= fr) ? P[sb][j] : 0.f; } } } \
      f32x4 acc = {0.f, 0.f, 0.f, 0.f}; \
      _Pragma("unroll") for (int pr = 0; pr < 2; ++pr) {        \
        if (2 * pr <= tb) { \
          const u32x4 pw = {cvt_pk_bf16(P[2 * pr][0], P[2 * pr][1]), cvt_pk_bf16(P[2 * pr][2], P[2 * pr][3]), cvt_pk_bf16(P[2 * pr + 1][0], P[2 * pr + 1][1]), cvt_pk_bf16(P[2 * pr + 1][2], P[2 * pr + 1][3])}; \
          const char* vrow = bufc + O_VT + ((eb * 16 + fr) * LS + 32 * pr + 4 * fq) * 2; \
          acc = __builtin_amdgcn_mfma_f32_16x16x32_bf16(ld44(vrow, vrow + 32), __builtin_bit_cast(bf16x8, pw), acc, 0, 0, 0); } } \
      _Pragma("unroll") for (int ks = 0; ks < 4; ++ks) { \
        const bf16x8 a = ld8(bufc + O_ST + ((eb * 16 + fr) * LQ + 32 * ks + 8 * fq) * 2), bq = ld8(bufc + O_QT + ((tb * 16 + fr) * LQ + 32 * ks + 8 * fq) * 2); \
        acc = __builtin_amdgcn_mfma_f32_16x16x32_bf16(a, bq, acc, 0, 0, 0); } \
      int r0; HG_ROW0(c_, r0); const long row = r0 + sgn * (tb * 16 + fr) - NCTX; \
      st_bf16x4(O + row * 1024 + h * 128 + sl * 32 + eb * 16 + 4 * fq, acc); }        \
    _Pragma("unroll") for (int eb = 0; eb < 2; ++eb) { f32x4 acc = S[eb] * dec; \
      _Pragma("unroll") for (int ks = 0; ks < 2; ++ks) { \
        const bf16x8 a = ld8(bufc + O_VT + ((eb * 16 + fr) * LS + 32 * ks + 8 * fq) * 2), bk = ld8(bufc + O_KHT + ((wid * 16 + fr) * LS + 32 * ks + 8 * fq) * 2); \
        acc = __builtin_amdgcn_mfma_f32_16x16x32_bf16(a, bk, acc, 0, 0, 0); } \
      S[eb] = acc; } } while (0)
#define HG_STEP(c_, LATC_, LATN_, FLD_) do { HG_LOAD((c_) + 2 < 68 ? (c_) + 2 : 67, gN, qN, vN); if (fill && (c_) > 0 && (c_) <= FILL_HG) fill_store(p, wg, (c_) - 1, ((c_) - 1) & 1); \
    HG_MMA(c_, LATC_); HG_ELEM((c_) + 1, LATN_); if (fill && (c_) < FILL_HG) { fill_write(FLD_, (c_) & 1); if ((c_) + 2 < FILL_HG) fill_load(p, wg, (c_) + 2, FLD_); } __syncthreads(); \
    _Pragma("unroll") for (int ii = 0; ii < 8; ++ii) { g[ii] = gN[ii]; q[ii] = qN[ii]; } v = vN; } while (0)
  f32x4 fldA[4], fldB[4];
  if (fill && FILL_HG > 0) { fill_load(p, wg, 0, fldA); if (FILL_HG > 1) fill_load(p, wg, 1, fldB); }
  HG_LOAD(0, g, q, v);
  HG_ELEM(0, false);
  HG_LOAD(1, g, q, v);
  __syncthreads();
  HG_STEP(0, false, false, fldA); HG_STEP(1, false, false, fldB); HG_STEP(2, false, false, fldA);
  HG_STEP(3, false, true, fldB);
#pragma unroll 1
  for (int c = 4; c < 66; c += 2) { HG_STEP(c, true, true, fldA); HG_STEP(c + 1, true, true, fldB); }
  HG_STEP(66, true, true, fldA);
  HG_MMA(67, true);
  __syncthreads();
  if (fill && FILL_HG == 67) fill_store(p, wg, 66, 0);
#undef HG_ELEM
#undef HG_MMA
#undef HG_STEP
#undef HG_ROW0
#undef HG_LOAD
}
}

#define XB_TMO      128
#define XB_XCNT(j)  (256  + 64 * (j))
#define XB_XSUB(j)  (1280 + 64 * (j))
#define XB_XGEN(j)  (2304 + 64 * (j))
#define XB_TOP      3328
#define XB_TOPGEN   3392
#define XCD_BAR_WORDS 3456
#define XB_SPIN_CAP (1u << 21)

__device__ __forceinline__ unsigned xb_ld(unsigned* p)              { return __hip_atomic_load(p, __ATOMIC_RELAXED, __HIP_MEMORY_SCOPE_AGENT); }
__device__ __forceinline__ unsigned xb_add(unsigned* p, unsigned v) { return __hip_atomic_fetch_add(p, v, __ATOMIC_RELAXED, __HIP_MEMORY_SCOPE_AGENT); }
__device__ __forceinline__ unsigned xb_xcc_id() { return (unsigned)__builtin_amdgcn_s_getreg((3 << 11) | 20) & 0xFu; }
#define XB_SPIN(cond, bar) do { unsigned _sp = 0; while (cond) { __builtin_amdgcn_s_sleep(1); \
    if ((++_sp & 255u) == 0u) { if (xb_ld(&(bar)[XB_TMO])) break; if (_sp > XB_SPIN_CAP) { atomicAdd(&(bar)[XB_TMO], 1u); break; } } } } while (0)

struct XcdBarrier {
    unsigned* bar; unsigned x;
    volatile LAS unsigned* st;
};

__device__ __forceinline__ XcdBarrier xcd_barrier_post(unsigned* bar, volatile LAS unsigned* st) {
    XcdBarrier b; b.bar = bar; b.x = xb_xcc_id(); b.st = st;
    if (threadIdx.x == 0) (void)xb_add(&bar[XB_XCNT(b.x)], 1u);
    return b;
}
__device__ __forceinline__ void xcd_barrier_complete(unsigned* bar, unsigned x, unsigned& nloc, unsigned& nx) {
    const unsigned G = gridDim.x * gridDim.y * gridDim.z;
    unsigned sum, cnt, mine, sp = 0u;
    for (;;) {
        sum = 0u; cnt = 0u; mine = 0u;
#pragma unroll
        for (unsigned j = 0; j < 16; ++j) { const unsigned c = xb_ld(&bar[XB_XCNT(j)]); sum += c; cnt += (c > 0u) ? 1u : 0u; mine = (j == x) ? c : mine; }
        if (sum == G) break;
        __builtin_amdgcn_s_sleep(1);
        if ((++sp & 255u) == 0u) { if (xb_ld(&bar[XB_TMO])) break; if (sp > XB_SPIN_CAP) { atomicAdd(&bar[XB_TMO], 1u); break; } }
    }
    nloc = mine > 0u ? mine : 1u; nx = cnt > 0u ? cnt : 1u;
}

__device__ __forceinline__ void xcd_barrier(const XcdBarrier& b) {
    asm volatile("s_waitcnt vmcnt(0)" ::: "memory");
    __syncthreads();
    if (threadIdx.x == 0) {
        unsigned* bar = b.bar;
        __builtin_amdgcn_s_waitcnt(0);
        unsigned nloc = b.st[0], nx = b.st[1];
        if (nloc == 0u) { xcd_barrier_complete(bar, b.x, nloc, nx); b.st[0] = nloc; b.st[1] = nx; }
        const unsigned old = xb_add(&bar[XB_XSUB(b.x)], 1u);
        const unsigned gen = old / nloc;
        if (old + 1u == (gen + 1u) * nloc) {
            __builtin_amdgcn_fence(__ATOMIC_RELEASE, "agent");
            asm volatile("s_waitcnt vmcnt(0)" ::: "memory");
            const unsigned og = xb_add(&bar[XB_TOP], 1u);
            const unsigned tg = og / nx;
            if (og + 1u == (tg + 1u) * nx) xb_add(&bar[XB_TOPGEN], 1u);
            else XB_SPIN(xb_ld(&bar[XB_TOPGEN]) == tg, bar);
            __builtin_amdgcn_fence(__ATOMIC_ACQUIRE, "agent");
            xb_add(&bar[XB_XGEN(b.x)], 1u);
            asm volatile("s_waitcnt vmcnt(0)" ::: "memory");
        } else {
            XB_SPIN(xb_ld(&bar[XB_XGEN(b.x)]) == gen, bar);
            __builtin_amdgcn_fence(__ATOMIC_ACQUIRE, "agent");
            asm volatile("s_waitcnt vmcnt(0)" ::: "memory");
        }
    }
    __syncthreads();
}


constexpr int LDS_MAX = 160 * 1024;
constexpr int XB_LDS_OFF = LDS_MAX - 16;

__global__ void __launch_bounds__(NT, 2) k_mega(Params p) {
  extern __shared__ __attribute__((aligned(16))) char shm[];
  const int wg = blockIdx.x, nwg = gridDim.x;
  CParams* kp = KARGS;
  if (threadIdx.x == 0) *(uint4*)(shm + XB_LDS_OFF) = make_uint4(0u, 0u, 0u, 0u);
  __syncthreads();
  XcdBarrier bar = xcd_barrier_post(kp->bar, (volatile LAS unsigned*)(shm + XB_LDS_OFF));
  phase0(*launder(kp), wg, nwg);
  xcd_barrier(bar);
  phase1_rows(*launder(kp), wg, nwg);
  xcd_barrier(bar);
  phase2_inproj(*launder(kp), wg, nwg);
  xcd_barrier(bar);
  phase3_rows(*launder(kp), wg, nwg);
  xcd_barrier(bar);
  phase4_up(*launder(kp), wg, nwg);
  xcd_barrier(bar);
  if (nwg == 256) {
    const int x = wg & 7, y = wg >> 3; const bool late = (y >> 2) & 1;
    if (!late) hg::hgrn_unit(*launder(kp), 4 * (x + 8 * (y >> 2)) + (y & 3), wg, true);
    phase5a_attn(*launder(kp), 16 * (2 * x + (y >> 4)) + (y & 15), wg, FILL_HG, FILL_A0);
    if (late) hg::hgrn_unit(*launder(kp), 4 * (x + 8 * (y >> 2)) + (y & 3), wg, true);
    phase5a_attn(*launder(kp), 16 * (16 + 2 * x + (y >> 4)) + (y & 15), wg, FILL_HG + FILL_A0, FILL_A1);
  } else {
    for (int u = wg; u < 256; u += nwg) hg::hgrn_unit(*launder(kp), u, wg, false);
    for (int u = wg; u < 512; u += nwg) phase5a_attn(*launder(kp), u);
  }
  xcd_barrier(bar);
  phase5c_rec(*launder(kp), wg, nwg);
  xcd_barrier(bar);
  phase6_outproj(*launder(kp), wg, nwg);
  xcd_barrier(bar);
  phase7_post<true>(*launder(kp), wg, nwg);
  xcd_barrier(bar);
  phase_moe<0>(*launder(kp), wg, nwg);
  xcd_barrier(bar);
  phase_moe<1>(*launder(kp), wg, nwg);
  xcd_barrier(bar);
  phase11_final(*launder(kp), wg, nwg);
}

static size_t carve(size_t& off, size_t bytes) { const size_t o = off; off += (bytes + 255) & ~(size_t)255; return o; }

extern "C" void kernel_launch(void* const* d_in, const int* in_sizes, int n_in, void* d_out, int out_size, void* d_ws, size_t ws_size, hipStream_t stream) {
  Params p{};
  p.x = (const float*)d_in[0]; p.c = (const float*)d_in[1]; p.ctx = (const float*)d_in[2]; p.c_ctx = (const float*)d_in[3]; p.w_mod = (const float*)d_in[4]; p.b_mod = (const float*)d_in[5];
  p.ln_mix_pre = (const float*)d_in[6]; p.ln_mix_post = (const float*)d_in[7]; p.ln_ffn_pre = (const float*)d_in[8]; p.ln_ffn_post = (const float*)d_in[9]; p.w_in = (const float*)d_in[10];
  p.q_norm = (const float*)d_in[11]; p.kv_norm = (const float*)d_in[12]; p.w_uq = (const float*)d_in[13]; p.w_ukv = (const float*)d_in[14]; p.hgrn_lb = (const float*)d_in[15];
  p.g_norm = (const float*)d_in[16]; p.w_out = (const float*)d_in[17]; p.router_w = (const float*)d_in[18]; p.router_b = (const float*)d_in[19]; p.w_gu = (const float*)d_in[20];
  p.b_gu = (const float*)d_in[21]; p.w_dn = (const float*)d_in[22]; p.b_dn = (const float*)d_in[23];
  p.out = (float*)d_out;
  char* ws = (char*)d_ws; size_t off = 0;
  p.bar = (unsigned*)(ws + carve(off, 16384));
  p.cnt = (int*)(ws + carve(off, 256));
  const size_t zero_bytes = off;
  p.wt_in = (bf16_t*)(ws + carve(off, (size_t)INCP * 2048 * 2)); p.wt_uq = (bf16_t*)(ws + carve(off, (size_t)1536 * 512 * 2)); p.wt_ukv = (bf16_t*)(ws + carve(off, (size_t)2048 * 256 * 2));
  p.wt_out = (bf16_t*)(ws + carve(off, (size_t)2048 * 2048 * 2)); p.wt_gu8 = (unsigned char*)(ws + carve(off, (size_t)NE * 4096 * 2048)); p.wt_dn8 = (unsigned char*)(ws + carve(off, (size_t)NE * 2048 * 2048));
  p.mod = (float*)(ws + carve(off, 5 * 12288 * 4)); p.rope = (float*)(ws + carve(off, 4096 * 64 * 4));
  p.h = (bf16_t*)(ws + carve(off, (size_t)NROW * DM * 2));
  p.cq = (bf16_t*)(ws + carve(off, (size_t)NLAT * QRANK * 2)); p.cqn = (bf16_t*)(ws + carve(off, (size_t)NLAT * QRANK * 2));
  p.ckv = (bf16_t*)(ws + carve(off, (size_t)NROW * KVRANK * 2)); p.ckvn = (bf16_t*)(ws + carve(off, (size_t)NROW * KVRANK * 2));
  p.kr = (float*)(ws + carve(off, (size_t)NROW * ROPE * 4)); p.kr2 = (bf16_t*)(ws + carve(off, (size_t)NROW * ROPE * 2));
  p.qh = (bf16_t*)(ws + carve(off, (size_t)NROW * 1024 * 2)); p.gf = (float*)(ws + carve(off, (size_t)NROW * 1024 * 4)); p.gb = (float*)(ws + carve(off, (size_t)NROW * 1024 * 4));
  p.vh = (bf16_t*)(ws + carve(off, (size_t)NROW * 1024 * 2)); p.gate = (bf16_t*)(ws + carve(off, (size_t)NROW * 1024 * 2));
  p.qf = (bf16_t*)(ws + carve(off, (size_t)NBATCH * NH * SEQ * QK * 2)); p.kf = (bf16_t*)(ws + carve(off, (size_t)NBATCH * NH * KEYS * QK * 2)); p.vf = (bf16_t*)(ws + carve(off, (size_t)NBATCH * NH * KEYS * DV * 2));
  p.aout = (bf16_t*)(ws + carve(off, (size_t)NLAT * DM * 2)); p.of = (bf16_t*)(ws + carve(off, (size_t)NLAT * 1024 * 2)); p.ob = (bf16_t*)(ws + carve(off, (size_t)NLAT * 1024 * 2));
  p.mix = (bf16_t*)(ws + carve(off, (size_t)NLAT * DM * 2)); p.x1 = (bf16_t*)(ws + carve(off, (size_t)NLAT * DM * 2)); p.h2_8 = (unsigned char*)(ws + carve(off, (size_t)NLAT * DM));
  p.tok_e = (int*)(ws + carve(off, (size_t)NLAT * 4 * 4)); p.tok_pos = (int*)(ws + carve(off, (size_t)NLAT * 4 * 4)); p.tok_gate = (float*)(ws + carve(off, (size_t)NLAT * 4 * 4));
  p.idx = (int*)(ws + carve(off, (size_t)NE * NLAT * 4));
  p.act8 = (unsigned char*)(ws + carve(off, (size_t)MAXSLOT * DFF)); p.ys8 = (unsigned char*)(ws + carve(off, (size_t)MAXSLOT * DM));
  if (off > ws_size) { fprintf(stderr, "kernel_launch: workspace too small: need %zu have %zu\n", off, ws_size); return; }
  static int grid = 0;
  if (!grid) {
    if (hipFuncSetAttribute((const void*)k_mega, hipFuncAttributeMaxDynamicSharedMemorySize, LDS_MAX) != hipSuccess) { fprintf(stderr, "kernel_launch: hipFuncSetAttribute failed\n"); return; }
    int dev = 0, cus = 0, per_cu = 0;
    (void)hipGetDevice(&dev);
    (void)hipDeviceGetAttribute(&cus, hipDeviceAttributeMultiprocessorCount, dev);
    (void)hipOccupancyMaxActiveBlocksPerMultiprocessor(&per_cu, k_mega, NT, LDS_MAX);
    if (per_cu < 1 || cus < 1) { fprintf(stderr, "kernel_launch: occupancy query says %d blocks per CU on %d CUs\n", per_cu, cus); return; }
    grid = cus & ~15;
  }
  (void)hipMemsetAsync(ws, 0, zero_bytes, stream);
  hipLaunchKernelGGL(k_mega, dim3(grid), dim3(NT), LDS_MAX, stream, p);
  const hipError_t le = hipPeekAtLastError();
  if (le != hipSuccess) fprintf(stderr, "kernel_launch: launch failed: %s\n", hipGetErrorName(le));
}
```

```cpp
#include <hip/hip_runtime.h>
#include <stdint.h>
#include <stdio.h>

#define DEV __device__ __forceinline__
typedef unsigned short bf16_t;
typedef short bf16x8 __attribute__((ext_vector_type(8)));
typedef short s16x4 __attribute__((ext_vector_type(4)));
typedef float f32x4 __attribute__((ext_vector_type(4)));
typedef float f32x2 __attribute__((ext_vector_type(2)));
typedef float f32x16 __attribute__((ext_vector_type(16)));
typedef unsigned u32x4 __attribute__((ext_vector_type(4)));
typedef unsigned u32x2 __attribute__((ext_vector_type(2)));

constexpr int DM = 2048, NBATCH = 4, SEQ = 4096, CTX = 256, KEYS = CTX + SEQ;
constexpr int NLAT = NBATCH * SEQ, NCTX = NBATCH * CTX, NROW = NLAT + NCTX;
constexpr int NH = 8, QRANK = 512, KVRANK = 256, ROPE = 64, QK = 192, DV = 128, DK = 128;
constexpr int INC = 5952, INCP = 6144;
constexpr int NE = 32, TOPK = 4, DFF = 2048;
constexpr int MAXSLOT = 65536 + NE * 256;
constexpr int MAXTILES = MAXSLOT / 256;
constexpr int CNT_LD = 64;
constexpr int NT = 512;
constexpr float EPS = 1e-6f;
constexpr int FP8_WSCALE_LOG2_ = 6;

struct Params {
  const float *x, *c, *ctx, *c_ctx, *w_mod, *b_mod, *ln_mix_pre, *ln_mix_post, *ln_ffn_pre, *ln_ffn_post, *w_in, *q_norm, *kv_norm, *w_uq, *w_ukv, *hgrn_lb, *g_norm, *w_out,
      *router_w, *router_b, *w_gu, *b_gu, *w_dn, *b_dn;
  float* out;
  bf16_t *wt_in, *wt_uq, *wt_ukv, *wt_out;
  unsigned char *wt_gu8, *wt_dn8;
  unsigned char *h2_8, *act8;
  float* mod;
  float* rope;
  bf16_t* h;
  bf16_t *cq, *cqn;
  bf16_t *ckv, *ckvn;
  float* kr;
  bf16_t* qh;
  float *gf, *gb;
  bf16_t* vh;
  bf16_t* gate;
  bf16_t *qf, *kf, *vf;
  bf16_t* aout;
  bf16_t *of, *ob;
  bf16_t* mix;
  bf16_t* x1;
  int *tok_e, *tok_pos;
  float* tok_gate;
  int* cnt;
  int* idx;
  unsigned char* ys8;
  unsigned* bar;
};

DEV int ltid() { int t = threadIdx.x; asm volatile("" : "+v"(t)); return t; }
typedef const __attribute__((address_space(4))) Params CParams;
DEV CParams* launder(CParams* p) { asm volatile("" : "+s"(p)); return p; }
#define KARGS ((CParams*)__builtin_amdgcn_kernarg_segment_ptr())
typedef __bf16 bf16n2 __attribute__((ext_vector_type(2)));
DEV unsigned cvt_pk_bf16(float lo, float hi) { const f32x2 v = {lo, hi}; const bf16n2 r = __builtin_convertvector(v, bf16n2); return __builtin_bit_cast(unsigned, r); }
DEV unsigned cvt_pk4_fp8(f32x4 v) { unsigned r = 0; r = __builtin_amdgcn_cvt_pk_fp8_f32(v[0], v[1], r, false); r = __builtin_amdgcn_cvt_pk_fp8_f32(v[2], v[3], r, true); return r; }
DEV float bf2f(bf16_t v) { return __uint_as_float(((unsigned)v) << 16); }
DEV float bflo(unsigned v) { return __uint_as_float(v << 16); }
DEV float bfhi(unsigned v) { return __uint_as_float(v & 0xffff0000u); }
DEV bf16_t f2bf(float f) { const __bf16 r = (__bf16)f; return __builtin_bit_cast(bf16_t, r); }
DEV float wave_sum(float v) {
#pragma unroll
  for (int o = 32; o > 0; o >>= 1) v += __shfl_xor(v, o);
  return v;
}
DEV float sigmoidf_(float v) { return __builtin_amdgcn_rcpf(1.f + __builtin_amdgcn_exp2f(-1.4426950408889634f * v)); }
DEV float siluf_(float v) { return v * __builtin_amdgcn_rcpf(1.f + __builtin_amdgcn_exp2f(-1.4426950408889634f * v)); }

DEV void mod_unit(CParams& p, int u) {
  extern __shared__ __attribute__((aligned(16))) char shm[];
  float* sc = (float*)shm;
  float* red = (float*)(shm + 5 * 2048 * 4);
  const int tid = ltid(), wid = tid >> 6, lane = tid & 63, cl = lane & 15, kr = lane >> 4;
  for (int i = tid; i < 5 * 2048; i += NT) { const int v = i >> 11, k = i & 2047; const float cv = v < 4 ? p.c[v * 2048 + k] : p.c_ctx[k]; sc[i] = siluf_(cv); }
  __syncthreads();
  f32x4 acc[5];
#pragma unroll
  for (int v = 0; v < 5; ++v) acc[v] = (f32x4){0.f, 0.f, 0.f, 0.f};
  const float* wp = p.w_mod + (long)(wid * 256 + kr) * 12288 + u * 64 + cl * 4;
  const float* sp = sc + wid * 256 + kr;
#pragma unroll 1
  for (int k = 0; k < 256; k += 32) {
    f32x4 w[8];
#pragma unroll
    for (int j = 0; j < 8; ++j) w[j] = *(const f32x4*)(wp + (long)(k + 4 * j) * 12288);
#pragma unroll
    for (int j = 0; j < 8; ++j)
#pragma unroll
      for (int v = 0; v < 5; ++v) { const float s = sp[v * 2048 + k + 4 * j]; acc[v] += w[j] * s; }
  }
#pragma unroll
  for (int v = 0; v < 5; ++v)
#pragma unroll
    for (int j = 0; j < 4; ++j) { float a = acc[v][j]; a += __shfl_xor(a, 16); a += __shfl_xor(a, 32); acc[v][j] = a; }
  if (kr == 0) {
#pragma unroll
    for (int v = 0; v < 5; ++v) *(f32x4*)(red + (wid * 5 + v) * 64 + cl * 4) = acc[v];
  }
  __syncthreads();
  if (tid < 5 * 64) {
    const int v = tid >> 6, cc = tid & 63; float s = p.b_mod[u * 64 + cc];
#pragma unroll
    for (int w = 0; w < 8; ++w) s += red[(w * 5 + v) * 64 + cc];
    p.mod[v * 12288 + u * 64 + cc] = s;
  }
  __syncthreads();
}

DEV int perm_row(int perm, int n) {
  if (perm == 1) return n < 832 ? n : n + 192;
  if (perm == 2) { const int lin = n >= 2048 ? 1 : 0, j = n - lin * 2048; return (j >> 7) * 256 + lin * 128 + (j & 127); }
  return n;
}
struct CvtDesc { const float* src; void* dst; int ldsrc, N, lddst, k0, n0, perm, fp8; };
constexpr int U_MOD = 192, U_ROPE = 16;
constexpr int U_GU = NE * 16 * 32, U_DN = NE * 16 * 16, U_IN = 16 * 47, U_OUT = 16 * 16, U_UQ = 4 * 12, U_UKV = 2 * 16;
constexpr int U_CVT = U_GU + U_DN + U_IN + U_OUT + U_UQ + U_UKV;
DEV CvtDesc cvt_decode(CParams& p, int u) {
  CvtDesc d;
  if (u < U_GU) { const int e = u >> 9, r = u & 511, kt = r >> 5, nt = r & 31;
    d.src = p.w_gu + (long)e * 2048 * 4096; d.ldsrc = 4096; d.N = 4096; d.dst = p.wt_gu8 + (long)e * 4096 * 2048; d.lddst = 2048; d.k0 = kt * 128; d.n0 = nt * 128; d.perm = 2; d.fp8 = 1; return d; }
  u -= U_GU;
  if (u < U_DN) { const int e = u >> 8, r = u & 255, kt = r >> 4, nt = r & 15;
    d.src = p.w_dn + (long)e * 2048 * 2048; d.ldsrc = 2048; d.N = 2048; d.dst = p.wt_dn8 + (long)e * 2048 * 2048; d.lddst = 2048; d.k0 = kt * 128; d.n0 = nt * 128; d.perm = 0; d.fp8 = 1; return d; }
  u -= U_DN;
  if (u < U_IN) { const int kt = u / 47, nt = u % 47; d.src = p.w_in; d.ldsrc = INC; d.N = INC; d.dst = p.wt_in; d.lddst = 2048; d.k0 = kt * 128; d.n0 = nt * 128; d.perm = 1; d.fp8 = 0; return d; }
  u -= U_IN;
  if (u < U_OUT) { const int kt = u >> 4, nt = u & 15; d.src = p.w_out; d.ldsrc = 2048; d.N = 2048; d.dst = p.wt_out; d.lddst = 2048; d.k0 = kt * 128; d.n0 = nt * 128; d.perm = 0; d.fp8 = 0; return d; }
  u -= U_OUT;
  if (u < U_UQ) { const int kt = u / 12, nt = u % 12; d.src = p.w_uq; d.ldsrc = 1536; d.N = 1536; d.dst = p.wt_uq; d.lddst = 512; d.k0 = kt * 128; d.n0 = nt * 128; d.perm = 0; d.fp8 = 0; return d; }
  u -= U_UQ;
  { const int kt = u >> 4, nt = u & 15; d.src = p.w_ukv; d.ldsrc = 2048; d.N = 2048; d.dst = p.wt_ukv; d.lddst = 256; d.k0 = kt * 128; d.n0 = nt * 128; d.perm = 0; d.fp8 = 0; }
  return d;
}
DEV void cvt_load(const CvtDesc& d, f32x4 (&ld)[8]) {
  const int tid = ltid(), tx = tid & 31, ty = tid >> 5;
  const bool ok = (d.n0 + 4 * tx) < d.N;
#pragma unroll
  for (int x = 0; x < 8; ++x) {
    const int row = d.fp8 ? 4 * (ty + 16 * (x >> 2)) + (x & 3) : 2 * (ty + 16 * (x >> 1)) + (x & 1);
    const float* sp = d.src + (long)(d.k0 + row) * d.ldsrc + d.n0 + 4 * tx;
    ld[x] = ok ? __builtin_nontemporal_load((const f32x4*)sp) : (f32x4){0.f, 0.f, 0.f, 0.f};
  }
}
DEV void cvt_store(const CvtDesc& d, const f32x4 (&ld)[8]) {
  extern __shared__ __attribute__((aligned(16))) char shm[];
  unsigned* T = (unsigned*)shm;
  const int tid = ltid(), tx = tid & 31, ty = tid >> 5;
  if (d.fp8) {
    constexpr float WS = (float)(1 << FP8_WSCALE_LOG2_);
#pragma unroll
    for (int i = 0; i < 2; ++i) {
      const int q = ty + 16 * i;
#pragma unroll
      for (int j = 0; j < 4; ++j) T[(4 * tx + j) * 33 + q] = cvt_pk4_fp8((f32x4){ld[4 * i][j] * WS, ld[4 * i + 1][j] * WS, ld[4 * i + 2][j] * WS, ld[4 * i + 3][j] * WS});
    }
    __syncthreads();
#pragma unroll
    for (int j = 0; j < 2; ++j) {
      const int id = tid + NT * j, nl = id >> 3, cc = id & 7, n = d.n0 + nl;
      u32x4 v; v.x = T[nl * 33 + 4 * cc]; v.y = T[nl * 33 + 4 * cc + 1]; v.z = T[nl * 33 + 4 * cc + 2]; v.w = T[nl * 33 + 4 * cc + 3];
      if (n < d.N) *(u32x4*)((unsigned char*)d.dst + (long)perm_row(d.perm, n) * d.lddst + d.k0 + 16 * cc) = v;
    }
  } else {
#pragma unroll
    for (int i = 0; i < 4; ++i) {
      const int q = ty + 16 * i;
#pragma unroll
      for (int j = 0; j < 4; ++j) T[(4 * tx + j) * 65 + q] = cvt_pk_bf16(ld[2 * i][j], ld[2 * i + 1][j]);
    }
    __syncthreads();
#pragma unroll
    for (int j = 0; j < 4; ++j) {
      const int id = tid + NT * j, nl = id >> 4, cc = id & 15, n = d.n0 + nl;
      u32x4 v; v.x = T[nl * 65 + 4 * cc]; v.y = T[nl * 65 + 4 * cc + 1]; v.z = T[nl * 65 + 4 * cc + 2]; v.w = T[nl * 65 + 4 * cc + 3];
      if (n < d.N) *(u32x4*)((bf16_t*)d.dst + (long)perm_row(d.perm, n) * d.lddst + d.k0 + 8 * cc) = v;
    }
  }
  __syncthreads();
}
constexpr int FILL_LDS_OFF = 133120, FILL_TB = 128 * 17 * 4;
constexpr int FILL_HALVES = 2 * (NE * 16 * 32 + NE * 16 * 16);
#ifndef FILL_HG
#define FILL_HG 67
#endif
#ifndef FILL_A0
#define FILL_A0 63
#endif
#ifndef FILL_A1
#define FILL_A1 62
#endif
constexpr int FILL_SLOTS = FILL_HG + FILL_A0 + FILL_A1;
static_assert(FILL_HG <= 67 && FILL_A0 <= 68 && FILL_A1 <= 68 && FILL_SLOTS * 256 <= FILL_HALVES, "filler split");
struct FillDesc { const float* src; unsigned char* dst; int ldsrc, perm, n0, kh; };
DEV FillDesc fill_decode(CParams& p, int wg, int slot) {
  const int h = slot * 256 + wg, t = h >> 1, half = h & 1; FillDesc d;
  if (t < NE * 512) { const int e = t >> 9, r = t & 511; d.src = p.w_gu + (long)e * 2048 * 4096; d.ldsrc = 4096; d.dst = p.wt_gu8 + (long)e * 4096 * 2048; d.perm = 2; d.n0 = (r & 31) * 128 + 64 * half; d.kh = (r >> 5) * 128; }
  else { const int v = t - NE * 512, e = v >> 8, r = v & 255; d.src = p.w_dn + (long)e * 2048 * 2048; d.ldsrc = 2048; d.dst = p.wt_dn8 + (long)e * 2048 * 2048; d.perm = 0; d.n0 = (r & 15) * 128 + 64 * half; d.kh = (r >> 4) * 128; }
  return d;
}
DEV void fill_load(CParams& p, int wg, int slot, f32x4 (&ld)[4]) {
  const FillDesc d = fill_decode(p, wg, slot); const int tid = ltid(), tx = tid & 15, ty = tid >> 4;
  const float* sp = d.src + (long)(d.kh + 4 * ty) * d.ldsrc + d.n0 + 4 * tx;
#pragma unroll
  for (int r = 0; r < 4; ++r) ld[r] = *(const f32x4*)(sp + (long)r * d.ldsrc);
}
DEV void fill_write(const f32x4 (&ld)[4], int bufsel) {
  extern __shared__ __attribute__((aligned(16))) char shm[];
  unsigned* T = (unsigned*)(shm + FILL_LDS_OFF + bufsel * FILL_TB); const int tid = ltid(), tx = tid & 15, ty = tid >> 4;
  constexpr float WS = (float)(1 << FP8_WSCALE_LOG2_);
#pragma unroll
  for (int j = 0; j < 4; ++j) T[(4 * tx + j) * 33 + ty] = cvt_pk4_fp8((f32x4){ld[0][j] * WS, ld[1][j] * WS, ld[2][j] * WS, ld[3][j] * WS});
}
DEV void fill_store(CParams& p, int wg, int slot, int bufsel) {
  extern __shared__ __attribute__((aligned(16))) char shm[];
  const unsigned* T = (const unsigned*)(shm + FILL_LDS_OFF + bufsel * FILL_TB); const int tid = ltid(), nl = tid >> 3, cc = tid & 7;
  const FillDesc d = fill_decode(p, wg, slot);
  u32x4 v; v.x = T[nl * 33 + 4 * cc]; v.y = T[nl * 33 + 4 * cc + 1]; v.z = T[nl * 33 + 4 * cc + 2]; v.w = T[nl * 33 + 4 * cc + 3];
  *(u32x4*)(d.dst + (long)perm_row(d.perm, d.n0 + nl) * 2048 + d.kh + 16 * cc) = v;
}
DEV void rope_unit(CParams& p, int u) {
  for (int i = ltid(); i < 256 * 32; i += NT) {
    const int t = u * 256 + (i >> 5), a = i & 31; const int fi = a & 15;
    const float inv = powf(10000.0f, -(float)fi / 16.0f);
    const float pos = a < 16 ? (float)(t >> 6) : (float)(t & 63);
    const float ang = pos * inv; float s, c; sincosf(ang, &s, &c);
    p.rope[t * 64 + a] = c; p.rope[t * 64 + 32 + a] = s;
  }
}
DEV void phase0_units(CParams& p, int wg, int nwg) {
  if (wg < U_MOD) mod_unit(p, wg); else if (wg < U_MOD + U_ROPE) rope_unit(p, wg - U_MOD);
  if (nwg < U_MOD + U_ROPE) { for (int u = wg + nwg; u < U_MOD + U_ROPE; u += nwg) { if (u < U_MOD) mod_unit(p, u); else rope_unit(p, u - U_MOD); } }
}
DEV void phase0_cvt(CParams& p, int wg, int nwg) {
  f32x4 ld[8], ld2[8];
  int u = (nwg == 256 ? FILL_SLOTS * 128 : 0) + wg;
  if (u < U_CVT) { const CvtDesc d = cvt_decode(p, u); cvt_load(d, ld); }
  for (; u < U_CVT; u += nwg) {
    const CvtDesc d = cvt_decode(p, u);
    const int un = u + nwg;
    if (un < U_CVT) { const CvtDesc dn = cvt_decode(p, un); cvt_load(dn, ld2); }
    cvt_store(d, ld);
#pragma unroll
    for (int i = 0; i < 8; ++i) ld[i] = ld2[i];
  }
}

DEV void phase1_rows(CParams& p, int wg, int nwg) {
  const int wid = ltid() >> 6, lane = ltid() & 63;
  for (int row = wg * 8 + wid; row < NROW; row += nwg * 8) {
    const float* xr; int v;
    if (row < NCTX) { xr = p.ctx + (long)row * DM; v = 4; } else { xr = p.x + (long)(row - NCTX) * DM; v = (row - NCTX) >> 12; }
    const float* sh = p.mod + v * 12288; const float* sc = sh + 2048;
    f32x4 xv[8]; float ss = 0.f;
#pragma unroll
    for (int i = 0; i < 8; ++i) { xv[i] = *(const f32x4*)(xr + i * 256 + lane * 4); ss += xv[i][0] * xv[i][0] + xv[i][1] * xv[i][1] + xv[i][2] * xv[i][2] + xv[i][3] * xv[i][3]; }
    ss = wave_sum(ss);
    const float rstd = rsqrtf(ss * (1.f / DM) + EPS);
#pragma unroll
    for (int i = 0; i < 8; ++i) {
      const int c0 = i * 256 + lane * 4;
      const f32x4 w = *(const f32x4*)(p.ln_mix_pre + c0), s1 = *(const f32x4*)(sc + c0), s0 = *(const f32x4*)(sh + c0);
      f32x4 y;
#pragma unroll
      for (int j = 0; j < 4; ++j) y[j] = xv[i][j] * rstd * w[j] * (1.f + s1[j]) + s0[j];
      u32x2 o; o.x = cvt_pk_bf16(y[0], y[1]); o.y = cvt_pk_bf16(y[2], y[3]);
      *(u32x2*)(p.h + (long)row * DM + c0) = o;
    }
  }
}
#define LAS __attribute__((address_space(3)))
constexpr int BM = 256, BK = 64, HALF = 128, HTB = HALF * BK * 2, GEMM_LDS = 8 * HTB;
constexpr int GEMM_AROW_OFF = GEMM_LDS;
constexpr int GEMM_BIAS_OFF = ((GEMM_AROW_OFF + 2 * 256 * 4 + (3 * MAXTILES + 2) * 4 + 15) / 16) * 16 + 2 * 9216;
DEV int lds_byte(int r, int c) { const int st = (r >> 4) * 2 + (c >> 5), rr = r & 15, cc = c & 31, ob = rr * 64 + cc * 2; return st * 1024 + (ob ^ (((ob >> 9) & 1) << 5)); }
DEV void stage_rc(int b, int& R, int& C) { const int st = b / 1024, sb = b % 1024, swz = sb ^ (((sb >> 9) & 1) << 5); R = (st >> 1) * 16 + swz / 64; C = (st & 1) * 32 + (swz % 64) / 2; }
typedef f32x4 AccT[2][2][4][2];
struct Unit { int pm, pn, e, r0, rv; };
typedef int i32x8 __attribute__((ext_vector_type(8)));
typedef int i32x4 __attribute__((ext_vector_type(4)));
DEV int g8(int r) { const int q = ((r & 15) >> 1) + 2; return 2 * (q & 3) + 1 - ((q >> 2) & 1); }
constexpr int FP8_WSCALE_LOG2 = FP8_WSCALE_LOG2_;
constexpr int FP8_SCALE_W = 0x01010101 * (127 - FP8_WSCALE_LOG2), FP8_SCALE_1 = 0x7f7f7f7f;

DEV void mfma_fp8(f32x4& acc, const i32x8& w, const i32x8& a, int sw, int sa) {
  asm volatile("v_mfma_scale_f32_16x16x128_f8f6f4 %0, %1, %2, %0, %3, %4 op_sel_hi:[0,0,0]" : "+v"(acc) : "v"(w), "v"(a), "v"(sw), "v"(sa));
}
template <class P>
DEV void gemm_stream(const P& pol) {
  extern __shared__ __attribute__((aligned(16))) char shm[];
  LAS unsigned char* lds = (LAS unsigned char*)shm;
  LAS int* arow = (LAS int*)(shm + GEMM_AROW_OFF);
  const int tid = ltid(), wid = __builtin_amdgcn_readfirstlane(tid >> 6), lane = tid & 63, wr = wid >> 2, wc = wid & 3, fr = lane & 15, fq = lane >> 4;
  const int KB = pol.KB, nt = KB / 128;
  Unit cur, nxt; int ui = 0;
  if (!pol.get(0, cur)) return;
  unsigned voffB[2], vAc[2][2];
#define G_SRC(i_, R_, C_) do { const int b_ = ltid() * 16 + (i_) * 8192; if (P::FP8) { R_ = b_ >> 7; C_ = (((b_ >> 4) & 7) ^ g8(R_)) << 4; } else { stage_rc(b_, R_, C_); C_ *= 2; } } while (0)
#define G_GATHER_OFFS(tab_, rv_) do { _Pragma("unroll") for (int i = 0; i < 2; ++i) { int R_, C_; G_SRC(i, R_, C_); const int ra_ = (tab_)[R_], rb_ = (tab_)[HALF + R_];        \
    vAc[0][i] = (unsigned)((R_ < (rv_) ? ra_ : 0) * KB + C_); vAc[1][i] = (unsigned)((HALF + R_ < (rv_) ? rb_ : 0) * KB + C_); } } while (0)
#pragma unroll
  for (int i = 0; i < 2; ++i) { int R_, C_; G_SRC(i, R_, C_); const int rho = R_ & 31, Rb = (R_ & ~31) + 8 * ((rho & 15) >> 2) + 4 * (rho >> 4) + (rho & 3); voffB[i] = (unsigned)(Rb * KB + C_); }
  if (P::GATHER) {
    pol.arow_fill(cur, (int*)(shm + GEMM_AROW_OFF));
    __syncthreads();
    G_GATHER_OFFS(arow, cur.rv);
  } else {
#pragma unroll
    for (int i = 0; i < 2; ++i) { int R_, C_; G_SRC(i, R_, C_); vAc[0][i] = (unsigned)(R_ * KB + C_); vAc[1][i] = vAc[0][i]; }
  }
  const size_t kstep = 128, hstep = (size_t)HALF * KB;
  const unsigned ldsw = (unsigned)wid * 1024u;
  const int aoff = P::FP8 ? (wr * 64 + fr) * 128 + (((2 * fq) ^ g8(fr)) << 4) : lds_byte(wr * 64 + fr, fq * 8);
  const int boff = P::FP8 ? (wc * 32 + fr) * 128 + (((2 * fq) ^ g8(fr)) << 4) : lds_byte(wc * 32 + fr, fq * 8);
  const int aoff1 = (wr * 64 + fr) * 128 + (((2 * fq + 1) ^ g8(fr)) << 4), boff1 = (wc * 32 + fr) * 128 + (((2 * fq + 1) ^ g8(fr)) << 4);
#define G_SA(b, h) (((b) * 2 + (h)) * HTB)
#define G_SB(b, h) ((4 + (b) * 2 + (h)) * HTB)
#define G_STAGE(bufoff, gbase, voff) do { _Pragma("unroll") for (int _i = 0; _i < 2; ++_i) \
    __builtin_amdgcn_global_load_lds((const unsigned*)((const char*)(gbase) + (voff)[_i]), (LAS unsigned*)(lds + (bufoff) + ldsw + _i * 8192), 16, 0, 0); } while (0)
#define G_LD2(o0, o1) __builtin_shufflevector(*(const LAS i32x4*)(lds + (o0)), *(const LAS i32x4*)(lds + (o1)), 0, 1, 2, 3, 4, 5, 6, 7)
#define G_LDA(dst, b, h) do { _Pragma("unroll") for (int m = 0; m < 4; ++m) dst[m] = G_LD2(G_SA(b, h) + aoff + m * 2048, G_SA(b, h) + (P::FP8 ? aoff1 : aoff + 1024) + m * 2048); } while (0)
#define G_LDB(dst, b, h) do { _Pragma("unroll") for (int n = 0; n < 2; ++n) dst[n] = G_LD2(G_SB(b, h) + boff + n * 2048, G_SB(b, h) + (P::FP8 ? boff1 : boff + 1024) + n * 2048); } while (0)
#define G_LO(x_) __builtin_bit_cast(bf16x8, __builtin_shufflevector(x_, x_, 0, 1, 2, 3))
#define G_HI(x_) __builtin_bit_cast(bf16x8, __builtin_shufflevector(x_, x_, 4, 5, 6, 7))
#define G_MMA(ai, bj, At_, Bt_) do { if (P::ROWSKIP && rvw <= 128 * (ai)) break;        \
    __builtin_amdgcn_s_setprio(1); _Pragma("unroll") for (int m = 0; m < 4; ++m) _Pragma("unroll") for (int n = 0; n < 2; ++n) { \
    if (P::FP8) mfma_fp8(acc[ai][bj][m][n], Bt_[n], At_[m], sclw, scla); \
    else { acc[ai][bj][m][n] = __builtin_amdgcn_mfma_f32_16x16x32_bf16(G_LO(Bt_[n]), G_LO(At_[m]), acc[ai][bj][m][n], 0, 0, 0); \
           acc[ai][bj][m][n] = __builtin_amdgcn_mfma_f32_16x16x32_bf16(G_HI(Bt_[n]), G_HI(At_[m]), acc[ai][bj][m][n], 0, 0, 0); } } \
    __builtin_amdgcn_s_setprio(0); } while (0)
#define G_ZERO() do { _Pragma("unroll") for (int a_ = 0; a_ < 2; ++a_) _Pragma("unroll") for (int b_ = 0; b_ < 2; ++b_) _Pragma("unroll") for (int m_ = 0; m_ < 4; ++m_) _Pragma("unroll") for (int n_ = 0; n_ < 2; ++n_) \
    acc[a_][b_][m_][n_] = (f32x4){0.f, 0.f, 0.f, 0.f}; } while (0)
#define WAIT_V(n) asm volatile("s_waitcnt vmcnt(" #n ")" ::: "memory")
#define WAIT_L(n) asm volatile("s_waitcnt lgkmcnt(" #n ")" ::: "memory")
#define BAR __builtin_amdgcn_s_barrier()
#define SCHED __builtin_amdgcn_sched_barrier(0)
  int sclw = P::SCALE_B, scla = P::SCALE_A;
  f32x4 acc[2][2][4][2];
  f32x4 bv[2][2];
  LAS float* btab = (LAS float*)(shm + GEMM_BIAS_OFF);
#define G_BIAS(tab_) do { _Pragma("unroll") for (int b_ = 0; b_ < 2; ++b_) _Pragma("unroll") for (int n_ = 0; n_ < 2; ++n_) { bv[b_][n_] = *(const LAS f32x4*)((tab_) + 128 * b_ + 32 * wc + 8 * fq + 4 * n_); \
    if (b_ == 1 && P::BIAS_LIN1) bv[b_][n_] = bv[b_][n_] + 1.0f; } } while (0)
#define G_INIT() do { _Pragma("unroll") for (int a_ = 0; a_ < 2; ++a_) _Pragma("unroll") for (int b_ = 0; b_ < 2; ++b_) _Pragma("unroll") for (int m_ = 0; m_ < 4; ++m_) _Pragma("unroll") for (int n_ = 0; n_ < 2; ++n_) \
    acc[a_][b_][m_][n_] = bv[b_][n_]; } while (0)
  if (P::HASBIAS) { pol.bias_fill(cur, (float*)(shm + GEMM_BIAS_OFF)); __syncthreads(); G_BIAS(btab); G_INIT(); } else G_ZERO();
  i32x8 At[4], B0[2], B1[2];
  int rvw = P::ROWSKIP ? cur.rv - 64 * wr : 256;
  const char* cA0 = pol.abase(cur, 0); const char* cA1 = pol.abase(cur, 1); const char* cB = pol.bbase(cur);
  G_STAGE(G_SB(0, 0), cB, voffB); G_STAGE(G_SA(0, 0), cA0, vAc[0]); G_STAGE(G_SB(0, 1), cB + hstep, voffB); G_STAGE(G_SA(0, 1), cA1, vAc[1]);
  if (wr == 1) BAR;
  WAIT_V(4); BAR;
  G_STAGE(G_SB(1, 0), cB + kstep, voffB); G_STAGE(G_SA(1, 0), cA0 + kstep, vAc[0]); G_STAGE(G_SB(1, 1), cB + hstep + kstep, voffB);
  WAIT_V(6); BAR;
  for (;;) {
    const bool has_next = pol.get(ui + 1, nxt);
    const char* nA0 = has_next ? pol.abase(nxt, 0) : cA0; const char* nA1 = has_next ? pol.abase(nxt, 1) : cA1; const char* nB = has_next ? pol.bbase(nxt) : cB;
    for (int t = 0; t < nt; t += 2) {
      const bool last = (t == nt - 2);
      const size_t k1 = (size_t)(t + 1) * kstep, k2 = (size_t)(t + 2) * kstep;
      const char* a20 = last ? nA0 : cA0 + k2; const char* a21 = last ? nA1 : cA1 + k2; const char* b2 = last ? nB : cB + k2;
      G_LDB(B0, 0, 0); SCHED; G_LDA(At, 0, 0); G_STAGE(G_SA(1, 1), cA1 + k1, vAc[1]);
      WAIT_L(8); BAR; WAIT_L(0); G_MMA(0, 0, At, B0); BAR; SCHED;
      if (P::GATHER && last && has_next) { LAS int* tab = arow + ((ui + 1) & 1) * 256; G_GATHER_OFFS(tab, nxt.rv); }
      G_LDB(B1, 0, 1); G_STAGE(G_SB(0, 0), b2, voffB);
      BAR; WAIT_L(0); G_MMA(0, 1, At, B1); BAR;
      G_LDA(At, 0, 1); G_STAGE(G_SA(0, 0), a20, vAc[0]);
      BAR; WAIT_L(0); G_MMA(1, 0, At, B0); BAR; SCHED;
      G_STAGE(G_SB(0, 1), b2 + hstep, voffB);
      WAIT_V(6); BAR; G_MMA(1, 1, At, B1); BAR;
      G_LDB(B0, 1, 0); SCHED; G_LDA(At, 1, 0); G_STAGE(G_SA(0, 1), a21, vAc[1]);
      WAIT_L(8); BAR; WAIT_L(0); G_MMA(0, 0, At, B0); BAR; SCHED;
      G_LDB(B1, 1, 1); G_STAGE(G_SB(1, 0), b2 + kstep, voffB);
      BAR; WAIT_L(0); G_MMA(0, 1, At, B1); BAR;
      G_LDA(At, 1, 1); G_STAGE(G_SA(1, 0), a20 + kstep, vAc[0]);
      BAR; WAIT_L(0); G_MMA(1, 0, At, B0); BAR; SCHED;
      G_STAGE(G_SB(1, 1), b2 + hstep + kstep, voffB);
      WAIT_V(6); BAR; G_MMA(1, 1, At, B1); BAR;
      if (P::HASBIAS && has_next && t == 0) pol.bias_dma(nxt, btab + ((ui + 1) & 1) * 256 + ((wid & 3) << 6));
      if (P::GATHER && has_next && t == 0) pol.arow_dma(nxt, arow + ((ui + 1) & 1) * 256 + ((wid & 3) << 6));
    }
    if (P::FP8) asm volatile("s_nop 7\n\ts_nop 7" ::: "memory");
    pol.epi(cur, acc, wr, wc, fr, fq);
    if (!has_next) break;
    if (P::HASBIAS) { G_BIAS(btab + ((ui + 1) & 1) * 256); G_INIT(); } else G_ZERO();
    cur = nxt; cA0 = nA0; cA1 = nA1; cB = nB; ++ui;
    if (P::ROWSKIP) rvw = cur.rv - 64 * wr;
  }
  WAIT_V(0);
  if (wr == 0) BAR;
  __syncthreads();
#undef G_SA
#undef G_SB
#undef G_STAGE
#undef G_LDA
#undef G_LDB
#undef G_MMA
#undef G_LD2
#undef G_SRC
#undef G_GATHER_OFFS
#undef G_LO
#undef G_HI
#undef G_ZERO
#undef G_INIT
#undef G_BIAS
}

constexpr int MOE_TAB_OFF_ = GEMM_AROW_OFF + 2 * 256 * 4;
DEV void st_bf16x4(bf16_t* p, f32x4 v) { u32x2 o; o.x = cvt_pk_bf16(v[0], v[1]); o.y = cvt_pk_bf16(v[2], v[3]); *(u32x2*)p = o; }
DEV void st_bf16x8(bf16_t* p, f32x4 a, f32x4 b) { u32x4 o; o.x = cvt_pk_bf16(a[0], a[1]); o.y = cvt_pk_bf16(a[2], a[3]); o.z = cvt_pk_bf16(b[0], b[1]); o.w = cvt_pk_bf16(b[2], b[3]); *(u32x4*)p = o; }
DEV void st_fp8x8(unsigned char* p, f32x4 a, f32x4 b) { u32x2 o; o.x = cvt_pk4_fp8(a); o.y = cvt_pk4_fp8(b); *(u32x2*)p = o; }

DEV f32x4 sig4(f32x4 v) {
  const f32x4 t = v * -1.4426950408889634f; f32x4 e;
#pragma unroll
  for (int j = 0; j < 4; ++j) e[j] = __builtin_amdgcn_exp2f(t[j]);
  e = e + 1.0f; f32x4 r;
#pragma unroll
  for (int j = 0; j < 4; ++j) r[j] = __builtin_amdgcn_rcpf(e[j]);
  return r;
}
struct EpiIn {
  CParams* p; int pm, pn;
  template <int KIND> DEV void run(const AccT& acc, int wr, int wc, int fr, int fq) const;
  DEV void operator()(const AccT& acc, int wr, int wc, int fr, int fq) const {
    if (pn < 2) run<0>(acc, wr, wc, fr, fq); else if (pn == 2) run<1>(acc, wr, wc, fr, fq); else if (pn == 3) run<2>(acc, wr, wc, fr, fq);
    else if (pn < 8 || pn >= 20) run<3>(acc, wr, wc, fr, fq); else if (pn < 16) run<4>(acc, wr, wc, fr, fq); else run<5>(acc, wr, wc, fr, fq);
  }
};
DEV void row_to_bkey(int row, int& b, int& key) { if (row < NCTX) { b = row >> 8; key = row & 255; } else { const int r = row - NCTX; b = r >> 12; key = CTX + (r & 4095); } }

struct EpiKV {
  CParams* p; int pm, pn;
  DEV void operator()(const AccT& acc, int wr, int wc, int fr, int fq) const {
    CParams& P = *launder(p); const int row0 = pm * BM + wr * 64 + fr;
#pragma unroll
    for (int ai = 0; ai < 2; ++ai)
#pragma unroll
      for (int m = 0; m < 4; ++m) {
        const int row = row0 + ai * HALF + m * 16; int b, key; row_to_bkey(row, b, key);
        const long bh = (long)(b * NH + pn) * KEYS + key; const int c = wc * 32 + 8 * fq;
        st_bf16x8(P.kf + bh * QK + c, acc[ai][0][m][0], acc[ai][0][m][1]);
        st_bf16x8(P.vf + bh * DV + c, acc[ai][1][m][0], acc[ai][1][m][1]);
      }
  }
};
struct EpiQ {
  CParams* p; int pm, pn;
  DEV void operator()(const AccT& acc, int wr, int wc, int fr, int fq) const {
    CParams& P = *launder(p); const int row0 = pm * BM + wr * 64 + fr;
#pragma unroll
    for (int ai = 0; ai < 2; ++ai)
#pragma unroll
      for (int m = 0; m < 4; ++m) {
        const int row = row0 + ai * HALF + m * 16, b = row >> 12, t = row & 4095;
#pragma unroll
        for (int bj = 0; bj < 2; ++bj) {
          const int col = pn * 256 + bj * HALF + wc * 32 + 8 * fq, hh = col / QK, e = col - hh * QK;
          st_bf16x8(P.qf + ((long)(b * NH + hh) * SEQ + t) * QK + e, acc[ai][bj][m][0], acc[ai][bj][m][1]);
        }
      }
  }
};
struct EpiOut {
  CParams* p; int pm, pn;
  DEV void operator()(const AccT& acc, int wr, int wc, int fr, int fq) const;
};
constexpr int STG_OFF = ((MOE_TAB_OFF_ + (3 * MAXTILES + 2) * 4 + 15) / 16) * 16, STG_HALF = 9216;
static_assert(GEMM_BIAS_OFF == STG_OFF + 2 * STG_HALF, "bias tables sit right behind the staging region");
template <int LB> DEV void stage_store_block(const unsigned (&v)[4][LB / 4], unsigned char* dst, long row_stride) {
  extern __shared__ __attribute__((aligned(16))) char shm[];
  constexpr int MP = LB == 8 ? 4 : (LB == 16 ? 2 : 1), PITCH = 16 * LB + 16, ROWS = 16 * MP;
  static_assert(ROWS * PITCH <= STG_HALF, "staging region");
  const int tid = ltid(), wr = tid >> 8, wc = (tid >> 6) & 3, fr = tid & 15, fq = (tid >> 4) & 3;
  char* stg = shm + STG_OFF + wr * STG_HALF;
  const int t4 = tid & 255;
#pragma unroll
  for (int ps = 0; ps < 4 / MP; ++ps) {
#pragma unroll
    for (int mm = 0; mm < MP; ++mm) {
      char* wp = stg + (16 * mm + fr) * PITCH + (4 * wc + fq) * LB; const int m = ps * MP + mm;
      if (LB == 8) *(u32x2*)wp = (u32x2){v[m][0], v[m][1]};
      else { *(u32x4*)wp = (u32x4){v[m][0], v[m][1], v[m][2], v[m][3]}; if (LB == 32) *(u32x4*)(wp + 16) = (u32x4){v[m][LB / 4 - 4], v[m][LB / 4 - 3], v[m][LB / 4 - 2], v[m][LB / 4 - 1]}; }
    }
    asm volatile("s_waitcnt lgkmcnt(0)" ::: "memory"); __builtin_amdgcn_s_barrier(); asm volatile("" ::: "memory");
#pragma unroll
    for (int k = 0; k < 2; ++k) { const int idx = k * 256 + t4, row = idx / LB, ch = idx % LB;
      *(u32x4*)(dst + (long)(ps * ROWS + row) * row_stride + ch * 16) = *(const u32x4*)(stg + row * PITCH + ch * 16); }
    asm volatile("s_waitcnt lgkmcnt(0)" ::: "memory"); __builtin_amdgcn_s_barrier(); asm volatile("" ::: "memory");
  }
}
DEV void pk_bf16x8(unsigned (&o)[4], f32x4 a, f32x4 b) { o[0] = cvt_pk_bf16(a[0], a[1]); o[1] = cvt_pk_bf16(a[2], a[3]); o[2] = cvt_pk_bf16(b[0], b[1]); o[3] = cvt_pk_bf16(b[2], b[3]); }
DEV void pk_f32x8(unsigned (&o)[8], f32x4 a, f32x4 b) {
#pragma unroll
  for (int j = 0; j < 4; ++j) { o[j] = __float_as_uint(a[j]); o[4 + j] = __float_as_uint(b[j]); } }
template <int KIND> DEV void EpiIn::run(const AccT& acc, int wr, int wc, int fr, int fq) const {
  CParams& P = *launder(p);
  const int rowh = pm * BM + wr * 64;
  if (KIND == 2) {
#pragma unroll
    for (int ai = 0; ai < 2; ++ai)
#pragma unroll
      for (int m = 0; m < 4; ++m) { const int row = rowh + fr + ai * HALF + m * 16, c = wc * 32 + 8 * fq;
        if (c < 64) { *(f32x4*)(P.kr + (long)row * ROPE + c) = acc[ai][0][m][0]; *(f32x4*)(P.kr + (long)row * ROPE + c + 4) = acc[ai][0][m][1]; } }
    return;
  }
  if (KIND == 0 && pm < 4) return;
  f32x4 lbv[2][2], oml[2][2];
  if (KIND == 4) {
    const int dir = (pn - 8) >> 2;
#pragma unroll
    for (int bj = 0; bj < 2; ++bj)
#pragma unroll
      for (int n = 0; n < 2; ++n) {
        const int col = ((pn - 8) & 3) * 256 + bj * HALF + wc * 32 + 8 * fq + 4 * n;
        const f32x4 a0 = *(const f32x4*)(P.hgrn_lb + dir * 2048 + col), a1 = *(const f32x4*)(P.hgrn_lb + dir * 2048 + 1024 + col);
#pragma unroll
        for (int j = 0; j < 4; ++j) lbv[bj][n][j] = sigmoidf_(a0[j] - a1[j]);
        oml[bj][n] = 1.0f - lbv[bj][n];
      }
  }
#pragma unroll
  for (int ai = 0; ai < 2; ++ai)
#pragma unroll
    for (int bj = 0; bj < 2; ++bj) {
      const long row = rowh + ai * HALF; const int cb = bj * HALF;
      if (KIND == 4) {
        unsigned vals[4][8];
#pragma unroll
        for (int m = 0; m < 4; ++m) pk_f32x8(vals[m], lbv[bj][0] + oml[bj][0] * sig4(acc[ai][bj][m][0]), lbv[bj][1] + oml[bj][1] * sig4(acc[ai][bj][m][1]));
        stage_store_block<32>(vals, (unsigned char*)(((pn - 8) >> 2 ? P.gb : P.gf) + row * 1024 + ((pn - 8) & 3) * 256 + cb), 1024 * 4);
      } else {
        unsigned vals[4][4];
#pragma unroll
        for (int m = 0; m < 4; ++m) {
          if (KIND == 3) pk_bf16x8(vals[m], acc[ai][bj][m][0] * sig4(acc[ai][bj][m][0]), acc[ai][bj][m][1] * sig4(acc[ai][bj][m][1]));
          else pk_bf16x8(vals[m], acc[ai][bj][m][0], acc[ai][bj][m][1]);
        }
        bf16_t* dst;
        if (KIND == 0) dst = P.cq + (row - NCTX) * QRANK + pn * 256 + cb;
        else if (KIND == 1) dst = P.ckv + row * KVRANK + cb;
        else if (KIND == 3) dst = (pn < 8 ? P.qh + (pn - 4) * 256 : P.gate + (pn - 20) * 256) + row * 1024 + cb;
        else dst = P.vh + row * 1024 + (pn - 16) * 256 + cb;
        stage_store_block<16>(vals, (unsigned char*)dst, (KIND == 0 ? QRANK : (KIND == 1 ? KVRANK : 1024)) * 2);
      }
    }
}
DEV void EpiOut::operator()(const AccT& acc, int wr, int wc, int fr, int fq) const {
  CParams& P = *launder(p);
#pragma unroll
  for (int ai = 0; ai < 2; ++ai)
#pragma unroll
    for (int bj = 0; bj < 2; ++bj) {
      unsigned vals[4][4];
#pragma unroll
      for (int m = 0; m < 4; ++m) pk_bf16x8(vals[m], acc[ai][bj][m][0], acc[ai][bj][m][1]);
      stage_store_block<16>(vals, (unsigned char*)(P.mix + (long)(pm * BM + ai * HALF + wr * 64) * DM + pn * 256 + bj * HALF), DM * 2);
    }
}
struct EpiGU {
  CParams* p; int e, srow0, pn;
  DEV static f32x4 act4(f32x4 g, f32x4 l) {
    constexpr float KS = -1.702f * 1.4426950408889634f;
    f32x4 a;
#pragma unroll
    for (int h2 = 0; h2 < 2; ++h2) {
      f32x2 gl, li1, sg;
      gl.x = fminf(g[2 * h2], 7.f); gl.y = fminf(g[2 * h2 + 1], 7.f);
      li1.x = fminf(fmaxf(l[2 * h2], -6.f), 8.f); li1.y = fminf(fmaxf(l[2 * h2 + 1], -6.f), 8.f);
      const f32x2 t = gl * KS;
      f32x2 d; d.x = __builtin_amdgcn_exp2f(t.x); d.y = __builtin_amdgcn_exp2f(t.y);
      d = d + 1.0f;
      sg.x = __builtin_amdgcn_rcpf(d.x); sg.y = __builtin_amdgcn_rcpf(d.y);
      const f32x2 r = (gl * sg) * li1;
      a[2 * h2] = r.x; a[2 * h2 + 1] = r.y;
    }
    return a;
  }
  DEV void operator()(const AccT& acc, int wr, int wc, int fr, int fq) const {
    CParams& P = *launder(p); const int row0 = srow0 + wr * 64 + fr;
    const int c = wc * 32 + 8 * fq;
#pragma unroll
    for (int ai = 0; ai < 2; ++ai) {
      unsigned vals[4][2];
#pragma unroll
      for (int m = 0; m < 4; ++m) { vals[m][0] = cvt_pk4_fp8(act4(acc[ai][0][m][0], acc[ai][1][m][0])); vals[m][1] = cvt_pk4_fp8(act4(acc[ai][0][m][1], acc[ai][1][m][1])); }
      stage_store_block<8>(vals, P.act8 + (long)(srow0 + ai * HALF + wr * 64) * DFF + pn * 128, DFF);
    }
  }
};
struct EpiDN {
  CParams* p; int e, srow0, pn;
  DEV void operator()(const AccT& acc, int wr, int wc, int fr, int fq) const {
    CParams& P = *launder(p); const int row0 = srow0 + wr * 64 + fr;
#pragma unroll
    for (int bj = 0; bj < 2; ++bj)
#pragma unroll
      for (int ai = 0; ai < 2; ++ai) {
        unsigned vals[4][2];
#pragma unroll
        for (int m = 0; m < 4; ++m) { vals[m][0] = cvt_pk4_fp8(acc[ai][bj][m][0]); vals[m][1] = cvt_pk4_fp8(acc[ai][bj][m][1]); }
        stage_store_block<8>(vals, P.ys8 + (long)(srow0 + ai * HALF + wr * 64) * DM + pn * 256 + bj * HALF, DM);
      }
  }
};

struct PolIn {
  static constexpr bool GATHER = false;
  static constexpr bool FP8 = false, HASBIAS = false, ROWSKIP = false, BIAS_LIN1 = false; static constexpr int SCALE_A = 0, SCALE_B = 0;
  CParams* p; const char* A; const char* B; int wg, nwg, KB, part;
  DEV bool get(int i, Unit& u) const {
    const int id = wg + i * nwg;
    if (part) { if (id >= 64) return false; u.pn = 23; u.pm = 4 + id; u.e = 0; u.r0 = 0; u.rv = 256; return true; }
    if (id >= 1528) return false;
    if (id < 1472) { u.pn = id >> 6; u.pm = 4 + (id & 63); } else { const int v = id - 1472, j = v >> 2; u.pm = v & 3; u.pn = j < 2 ? 2 + j : 6 + j; }
    u.e = 0; u.r0 = 0; u.rv = 256; return true; }
  DEV const char* abase(const Unit& u, int half) const { return A + (size_t)(u.pm * BM + half * HALF) * KB; }
  DEV const char* bbase(const Unit& u) const { return B + (size_t)(u.pn * BM) * KB; }
  DEV void arow_fill(const Unit&, int*) const {}
  DEV void arow_dma(const Unit&, LAS int*) const {}
  DEV void bias_fill(const Unit&, float*) const {}
  DEV void bias_dma(const Unit&, LAS float*) const {}
  DEV void epi(const Unit& u, const AccT& acc, int wr, int wc, int fr, int fq) const { EpiIn e{p, u.pm, u.pn}; e(acc, wr, wc, fr, fq); }
};
DEV void phase2_inproj(CParams& p, int wg, int nwg) { PolIn pol{&p, (const char*)p.h, (const char*)p.wt_in, wg, nwg, DM * 2, 0}; gemm_stream(pol); }

struct PolKV {
  static constexpr bool GATHER = false;
  static constexpr bool FP8 = false, HASBIAS = false, ROWSKIP = false, BIAS_LIN1 = false; static constexpr int SCALE_A = 0, SCALE_B = 0;
  CParams* p; const char* A; const char* B; int wg, nwg, KB;
  DEV bool get(int i, Unit& u) const { const int id = wg + i * nwg; if (id >= 68 * 8) return false; u.pn = id / 68; u.pm = id % 68; u.e = 0; u.r0 = 0; u.rv = 256; return true; }
  DEV const char* abase(const Unit& u, int half) const { return A + (size_t)(u.pm * BM + half * HALF) * KB; }
  DEV const char* bbase(const Unit& u) const { return B + (size_t)(u.pn * BM) * KB; }
  DEV void arow_fill(const Unit&, int*) const {}
  DEV void arow_dma(const Unit&, LAS int*) const {}
  DEV void bias_fill(const Unit&, float*) const {}
  DEV void bias_dma(const Unit&, LAS float*) const {}
  DEV void epi(const Unit& u, const AccT& acc, int wr, int wc, int fr, int fq) const { EpiKV e{p, u.pm, u.pn}; e(acc, wr, wc, fr, fq); }
};
struct PolQ {
  static constexpr bool GATHER = false;
  static constexpr bool FP8 = false, HASBIAS = false, ROWSKIP = false, BIAS_LIN1 = false; static constexpr int SCALE_A = 0, SCALE_B = 0;
  CParams* p; const char* A; const char* B; int wg, nwg, KB;
  DEV bool get(int i, Unit& u) const { const int id = wg + i * nwg; if (id >= 64 * 6) return false; u.pn = id >> 6; u.pm = id & 63; u.e = 0; u.r0 = 0; u.rv = 256; return true; }
  DEV const char* abase(const Unit& u, int half) const { return A + (size_t)(u.pm * BM + half * HALF) * KB; }
  DEV const char* bbase(const Unit& u) const { return B + (size_t)(u.pn * BM) * KB; }
  DEV void arow_fill(const Unit&, int*) const {}
  DEV void arow_dma(const Unit&, LAS int*) const {}
  DEV void bias_fill(const Unit&, float*) const {}
  DEV void bias_dma(const Unit&, LAS float*) const {}
  DEV void epi(const Unit& u, const AccT& acc, int wr, int wc, int fr, int fq) const { EpiQ e{p, u.pm, u.pn}; e(acc, wr, wc, fr, fq); }
};
DEV void phase4_up(CParams& p, int wg, int nwg) {
  if (nwg >= 128) {
    if (wg < 64) { PolIn pol{&p, (const char*)p.h, (const char*)p.wt_in, wg, nwg, DM * 2, 1}; gemm_stream(pol); }
    else {
      { PolKV pol{&p, (const char*)p.ckvn, (const char*)p.wt_ukv, wg - 64, nwg - 64, KVRANK * 2}; gemm_stream(pol); }
      { PolQ pol{&p, (const char*)p.cqn, (const char*)p.wt_uq, (wg - 64 + 32) % (nwg - 64), nwg - 64, QRANK * 2}; gemm_stream(pol); }
    }
  } else {
    { PolIn pol{&p, (const char*)p.h, (const char*)p.wt_in, wg, nwg, DM * 2, 1}; gemm_stream(pol); }
    { PolKV pol{&p, (const char*)p.ckvn, (const char*)p.wt_ukv, wg, nwg, KVRANK * 2}; gemm_stream(pol); }
    { PolQ pol{&p, (const char*)p.cqn, (const char*)p.wt_uq, wg, nwg, QRANK * 2}; gemm_stream(pol); }
  }
}
struct PolOut {
  static constexpr bool GATHER = false;
  static constexpr bool FP8 = false, HASBIAS = false, ROWSKIP = false, BIAS_LIN1 = false; static constexpr int SCALE_A = 0, SCALE_B = 0;
  CParams* p; const char* A; const char* B; int wg, nwg, KB;
  DEV bool get(int i, Unit& u) const { const int id = wg + i * nwg; if (id >= 64 * 8) return false; u.pn = id >> 6; u.pm = id & 63; u.e = 0; u.r0 = 0; u.rv = 256; return true; }
  DEV const char* abase(const Unit& u, int half) const { return A + (size_t)(u.pm * BM + half * HALF) * KB; }
  DEV const char* bbase(const Unit& u) const { return B + (size_t)(u.pn * BM) * KB; }
  DEV void arow_fill(const Unit&, int*) const {}
  DEV void arow_dma(const Unit&, LAS int*) const {}
  DEV void bias_fill(const Unit&, float*) const {}
  DEV void bias_dma(const Unit&, LAS float*) const {}
  DEV void epi(const Unit& u, const AccT& acc, int wr, int wc, int fr, int fq) const { EpiOut e{p, u.pm, u.pn}; e(acc, wr, wc, fr, fq); }
};
DEV void phase6_outproj(CParams& p, int wg, int nwg) { PolOut pol{&p, (const char*)p.aout, (const char*)p.wt_out, wg, nwg, DM * 2}; gemm_stream(pol); }

constexpr int MOE_TAB_OFF = MOE_TAB_OFF_;
DEV int moe_prefix(CParams& p, int* tile_e, int* tile_r0, int* tile_rv) {
  const int t = ltid();
  if (t < 64) {
    const int c = t < NE ? p.cnt[t * CNT_LD] : 0, n = (c + 255) >> 8; int inc = n;
#pragma unroll
    for (int st = 1; st < 32; st <<= 1) { const int v = __shfl_up(inc, st); if ((t & 63) >= st) inc += v; }
    const int first = inc - n;
    if (t < NE) for (int i = 0; i < n; ++i) { tile_e[first + i] = t; tile_r0[first + i] = i * 256; tile_rv[first + i] = min(256, c - i * 256); }
    if (t == NE - 1) tile_e[MAXTILES] = inc;
  }
  __syncthreads();
  return tile_e[MAXTILES];
}
struct PolGU {
  static constexpr bool GATHER = true, FP8 = true, HASBIAS = true, ROWSKIP = false, BIAS_LIN1 = true; static constexpr int SCALE_A = FP8_SCALE_1, SCALE_B = FP8_SCALE_W;
  CParams* p; const char* A; const char* B; const int* tile_e; const int* tile_r0; const int* tile_rv; int ntot, rbase, rstep, pncol, KB, noepi;
  DEV bool get(int i, Unit& u) const {
    u.pm = rstep * i + rbase; u.pn = pncol; if (u.pm >= ntot) return false;
    u.e = __builtin_amdgcn_readfirstlane(tile_e[u.pm]); u.r0 = __builtin_amdgcn_readfirstlane(tile_r0[u.pm]); u.rv = __builtin_amdgcn_readfirstlane(tile_rv[u.pm]); return true; }
  DEV const char* abase(const Unit&, int) const { return A; }
  DEV const char* bbase(const Unit& u) const { return B + ((size_t)u.e * 4096 + u.pn * BM) * KB; }
  DEV void arow_fill(const Unit& u, int* tab) const { const int t = ltid(); if (t < 256) { const int v = p->idx[u.e * NLAT + u.r0 + t]; tab[t] = t < u.rv ? v : 0; } }
  DEV void arow_dma(const Unit& u, LAS int* tabw) const { const int t = ltid() & 255;
    __builtin_amdgcn_global_load_lds((const unsigned*)(p->idx + u.e * NLAT + u.r0 + t), (LAS unsigned*)tabw, 4, 0, 0); }
  DEV const float* bias_src(const Unit& u, int t) const { return p->b_gu + (long)u.e * 4096 + u.pn * 128 + (t < 128 ? t : 2048 + t - 128); }
  DEV void bias_fill(const Unit& u, float* tab) const { const int t = ltid(); if (t < 256) tab[t] = *bias_src(u, t); }
  DEV void bias_dma(const Unit& u, LAS float* tabw) const { __builtin_amdgcn_global_load_lds((const unsigned*)bias_src(u, ltid() & 255), (LAS unsigned*)tabw, 4, 0, 0); }
  DEV void epi(const Unit& u, const AccT& acc, int wr, int wc, int fr, int fq) const { if (noepi) return; EpiGU e{p, u.e, u.pm * 256, u.pn}; e(acc, wr, wc, fr, fq); }
};
struct PolDN {
  static constexpr bool GATHER = false, FP8 = true, HASBIAS = true, ROWSKIP = false, BIAS_LIN1 = false; static constexpr int SCALE_A = FP8_SCALE_1, SCALE_B = FP8_SCALE_W;
  CParams* p; const char* A; const char* B; const int* tile_e; const int* tile_rv; int ntot, rbase, rstep, pncol, KB, noepi;
  DEV bool get(int i, Unit& u) const {
    u.pm = rstep * i + rbase; u.pn = pncol; if (u.pm >= ntot) return false;
    u.e = __builtin_amdgcn_readfirstlane(tile_e[u.pm]); u.r0 = 0; u.rv = __builtin_amdgcn_readfirstlane(tile_rv[u.pm]); return true; }
  DEV const char* abase(const Unit& u, int half) const { return A + (size_t)(u.pm * BM + half * HALF) * KB; }
  DEV const char* bbase(const Unit& u) const { return B + ((size_t)u.e * 2048 + u.pn * BM) * KB; }
  DEV void arow_fill(const Unit&, int*) const {}
  DEV void arow_dma(const Unit&, LAS int*) const {}
  DEV const float* bias_src(const Unit& u, int t) const { return p->b_dn + (long)u.e * 2048 + u.pn * 256 + t; }
  DEV void bias_fill(const Unit& u, float* tab) const { const int t = ltid(); if (t < 256) tab[t] = *bias_src(u, t); }
  DEV void bias_dma(const Unit& u, LAS float* tabw) const { __builtin_amdgcn_global_load_lds((const unsigned*)bias_src(u, ltid() & 255), (LAS unsigned*)tabw, 4, 0, 0); }
  DEV void epi(const Unit& u, const AccT& acc, int wr, int wc, int fr, int fq) const { if (noepi) return; EpiDN e{p, u.e, u.pm * 256, u.pn}; e(acc, wr, wc, fr, fq); }
};
template <int WHICH> DEV void phase_moe(CParams& p, int wg, int nwg, int noepi = 0) {
  extern __shared__ __attribute__((aligned(16))) char shm[];
  int* tile_e = (int*)(shm + MOE_TAB_OFF); int* tile_r0 = tile_e + MAXTILES + 1; int* tile_rv = tile_r0 + MAXTILES;
  const int ntiles = moe_prefix(p, tile_e, tile_r0, tile_rv);
  constexpr int NC = WHICH == 0 ? 16 : 8;
  int rbase, rstep, pncol;
  if (nwg == 256) { const int x = wg & 7, y = wg >> 3; rstep = 256 / NC; if (WHICH == 0) { rbase = 4 * (x >> 1) + (y >> 3); pncol = 8 * (x & 1) + (y & 7); } else { rbase = 4 * x + (y >> 3); pncol = y & 7; } }
  else { rbase = wg / NC; rstep = nwg / NC; pncol = wg % NC; }
  if (WHICH == 0) { PolGU pol{&p, (const char*)p.h2_8, (const char*)p.wt_gu8, tile_e, tile_r0, tile_rv, ntiles, rbase, rstep, pncol, DM, noepi}; gemm_stream(pol); }
  else { PolDN pol{&p, (const char*)p.act8, (const char*)p.wt_dn8, tile_e, tile_rv, ntiles, rbase, rstep, pncol, DFF, noepi}; gemm_stream(pol); }
}
DEV void phase3_rows(CParams& p, int wg, int nwg) {
  const int wid = ltid() >> 6, lane = ltid() & 63;
  for (int row = wg * 8 + wid; row < NROW; row += nwg * 8) {
    if (row >= NCTX) {
      const int lr = row - NCTX;
      const u32x4 raw = *(const u32x4*)(p.cq + (long)lr * QRANK + lane * 8);
      float v[8]; v[0] = bflo(raw.x); v[1] = bfhi(raw.x); v[2] = bflo(raw.y); v[3] = bfhi(raw.y); v[4] = bflo(raw.z); v[5] = bfhi(raw.z); v[6] = bflo(raw.w); v[7] = bfhi(raw.w);
      float ss = 0.f;
#pragma unroll
      for (int j = 0; j < 8; ++j) ss += v[j] * v[j];
      ss = wave_sum(ss); const float rstd = rsqrtf(ss * (1.f / QRANK) + EPS);
      const f32x4 w0 = *(const f32x4*)(p.q_norm + lane * 8), w1 = *(const f32x4*)(p.q_norm + lane * 8 + 4);
      u32x4 o; o.x = cvt_pk_bf16(v[0] * rstd * w0[0], v[1] * rstd * w0[1]); o.y = cvt_pk_bf16(v[2] * rstd * w0[2], v[3] * rstd * w0[3]);
      o.z = cvt_pk_bf16(v[4] * rstd * w1[0], v[5] * rstd * w1[1]); o.w = cvt_pk_bf16(v[6] * rstd * w1[2], v[7] * rstd * w1[3]);
      *(u32x4*)(p.cqn + (long)lr * QRANK + lane * 8) = o;
    }
    {
      const u32x2 raw = *(const u32x2*)(p.ckv + (long)row * KVRANK + lane * 4);
      float v[4]; v[0] = bflo(raw.x); v[1] = bfhi(raw.x); v[2] = bflo(raw.y); v[3] = bfhi(raw.y);
      float ss = v[0] * v[0] + v[1] * v[1] + v[2] * v[2] + v[3] * v[3];
      ss = wave_sum(ss); const float rstd = rsqrtf(ss * (1.f / KVRANK) + EPS);
      const f32x4 w0 = *(const f32x4*)(p.kv_norm + lane * 4);
      u32x2 o; o.x = cvt_pk_bf16(v[0] * rstd * w0[0], v[1] * rstd * w0[1]); o.y = cvt_pk_bf16(v[2] * rstd * w0[2], v[3] * rstd * w0[3]);
      *(u32x2*)(p.ckvn + (long)row * KVRANK + lane * 4) = o;
    }
    {
      const float kv = p.kr[(long)row * ROPE + lane];
      const float other = __shfl_xor(kv, 32);
      float o = kv;
      int b, key; row_to_bkey(row, b, key);
      if (row >= NCTX) {
        const int t = (row - NCTX) & 4095, a = lane & 31;
        const float cs = p.rope[t * 64 + a], sn = p.rope[t * 64 + 32 + a];
        o = lane < 32 ? kv * cs - other * sn : other * sn + kv * cs;
      }
      bf16_t* kd = p.kf + ((long)(b * NH) * KEYS + key) * QK + 128 + lane; const bf16_t ob = f2bf(o);
#pragma unroll
      for (int hh = 0; hh < NH; ++hh) kd[(long)hh * KEYS * QK] = ob;
    }
  }
}

DEV void phase5c_rec(CParams& p, int row0, int rstep, int rend) {
  const int wid = ltid() >> 6, lane = ltid() & 63;
  for (int row = row0 + wid; row < rend; row += rstep) {
    const bf16_t* a = p.of + (long)row * 1024 + lane * 16; const bf16_t* b = p.ob + (long)row * 1024 + lane * 16;
    const u32x4 a0 = *(const u32x4*)a, a1 = *(const u32x4*)(a + 8), b0 = *(const u32x4*)b, b1 = *(const u32x4*)(b + 8);
    const unsigned aw[8] = {a0.x, a0.y, a0.z, a0.w, a1.x, a1.y, a1.z, a1.w}, bw[8] = {b0.x, b0.y, b0.z, b0.w, b1.x, b1.y, b1.z, b1.w};
    float v[16]; float ss = 0.f;
#pragma unroll
    for (int i = 0; i < 8; ++i) { v[2 * i] = bflo(aw[i]) + bflo(bw[i]); v[2 * i + 1] = bfhi(aw[i]) + bfhi(bw[i]); ss += v[2 * i] * v[2 * i] + v[2 * i + 1] * v[2 * i + 1]; }
    ss += __shfl_xor(ss, 1); ss += __shfl_xor(ss, 2); ss += __shfl_xor(ss, 4);
    const float rstd = rsqrtf(ss * (1.f / DV) + EPS);
    const bf16_t* gp = p.gate + (long)(NCTX + row) * 1024 + lane * 16;
    const u32x4 g0 = *(const u32x4*)gp, g1 = *(const u32x4*)(gp + 8);
    float gt[16]; gt[0] = bflo(g0.x); gt[1] = bfhi(g0.x); gt[2] = bflo(g0.y); gt[3] = bfhi(g0.y); gt[4] = bflo(g0.z); gt[5] = bfhi(g0.z); gt[6] = bflo(g0.w); gt[7] = bfhi(g0.w);
    gt[8] = bflo(g1.x); gt[9] = bfhi(g1.x); gt[10] = bflo(g1.y); gt[11] = bfhi(g1.y); gt[12] = bflo(g1.z); gt[13] = bfhi(g1.z); gt[14] = bflo(g1.w); gt[15] = bfhi(g1.w);
    const float* gn = p.g_norm + (lane & 7) * 16;
    unsigned o[8];
#pragma unroll
    for (int j = 0; j < 8; ++j) o[j] = cvt_pk_bf16(v[2 * j] * rstd * gn[2 * j] * gt[2 * j], v[2 * j + 1] * rstd * gn[2 * j + 1] * gt[2 * j + 1]);
    bf16_t* op = p.aout + (long)row * DM + 1024 + lane * 16;
    *(u32x4*)op = (u32x4){o[0], o[1], o[2], o[3]}; *(u32x4*)(op + 8) = (u32x4){o[4], o[5], o[6], o[7]};
  }
}

constexpr int H2S_LD = 2052;
template <bool ROUTE> DEV void phase7_post(CParams& p, int wg, int nwg) {
  extern __shared__ __attribute__((aligned(16))) char shm[];
  float* h2s = (float*)shm;
  float* red = (float*)(shm + 16 * H2S_LD * 4);
  int* lcnt = (int*)(shm + 16 * H2S_LD * 4 + 8 * 16 * 32 * 4); int* lbase = lcnt + NE; int* rt_e = lbase + NE; int* rt_lp = rt_e + 256;
  const int tid = ltid(), wid = tid >> 6, lane = tid & 63;
  if (tid < NE) lcnt[tid] = 0;
  int gi = 0;
  u32x2 m2[2][8]; f32x4 xv[2][8];
#define P7_LOAD_A(g_) do { const long row_ = (g_) * 16 + wid * 2; const bf16_t* mr = p.mix + row_ * DM + lane * 4; const float* xr = p.x + row_ * DM + lane * 4; \
    _Pragma("unroll") for (int i = 0; i < 8; ++i) m2[0][i] = *(const u32x2*)(mr + i * 256); \
    _Pragma("unroll") for (int i = 0; i < 8; ++i) xv[0][i] = *(const f32x4*)(xr + i * 256); } while (0)
#define P7_LOAD_B(g_) do { const long row_ = (g_) * 16 + wid * 2 + 1; const bf16_t* mr = p.mix + row_ * DM + lane * 4; const float* xr = p.x + row_ * DM + lane * 4; \
    _Pragma("unroll") for (int i = 0; i < 8; ++i) m2[1][i] = *(const u32x2*)(mr + i * 256); \
    _Pragma("unroll") for (int i = 0; i < 8; ++i) xv[1][i] = *(const f32x4*)(xr + i * 256); } while (0)
  if (wg < NLAT / 16) P7_LOAD_A(wg);
  for (int g = wg; g < NLAT / 16; g += nwg, ++gi) {
    {
      P7_LOAD_B(g);
      const int row0 = g * 16 + wid * 2, b = row0 >> 12;
      const float* mod = p.mod + b * 12288;
      float ss[2] = {0.f, 0.f};
#pragma unroll
      for (int rr = 0; rr < 2; ++rr)
#pragma unroll
        for (int i = 0; i < 8; ++i) { const float a0 = bflo(m2[rr][i].x), a1 = bfhi(m2[rr][i].x), a2 = bflo(m2[rr][i].y), a3 = bfhi(m2[rr][i].y); ss[rr] += a0 * a0 + a1 * a1 + a2 * a2 + a3 * a3; }
      ss[0] = wave_sum(ss[0]); ss[1] = wave_sum(ss[1]);
      const float rstd[2] = {rsqrtf(ss[0] * (1.f / DM) + EPS), rsqrtf(ss[1] * (1.f / DM) + EPS)};
      float s2[2] = {0.f, 0.f};
      __builtin_amdgcn_sched_barrier(0);
#pragma unroll
      for (int i = 0; i < 8; ++i) {
        const int c0 = i * 256 + lane * 4;
        const f32x4 w = *(const f32x4*)(p.ln_mix_post + c0), gm = *(const f32x4*)(mod + 4096 + c0);
#pragma unroll
        for (int rr = 0; rr < 2; ++rr) {
          const f32x4 mv = {bflo(m2[rr][i].x), bfhi(m2[rr][i].x), bflo(m2[rr][i].y), bfhi(m2[rr][i].y)};
#pragma unroll
          for (int j = 0; j < 4; ++j) { xv[rr][i][j] = xv[rr][i][j] + gm[j] * (mv[j] * rstd[rr] * w[j]); s2[rr] += xv[rr][i][j] * xv[rr][i][j]; }
          st_bf16x4(p.x1 + (long)(row0 + rr) * DM + c0, xv[rr][i]);
        }
      }
      s2[0] = wave_sum(s2[0]); s2[1] = wave_sum(s2[1]);
      const float rstd2[2] = {rsqrtf(s2[0] * (1.f / DM) + EPS), rsqrtf(s2[1] * (1.f / DM) + EPS)};
      __builtin_amdgcn_sched_barrier(0);
#pragma unroll
      for (int i = 0; i < 8; ++i) {
        const int c0 = i * 256 + lane * 4;
        const f32x4 w = *(const f32x4*)(p.ln_ffn_pre + c0), s1 = *(const f32x4*)(mod + 8192 + c0), s0 = *(const f32x4*)(mod + 6144 + c0);
#pragma unroll
        for (int rr = 0; rr < 2; ++rr) {
          f32x4 y;
#pragma unroll
          for (int j = 0; j < 4; ++j) y[j] = xv[rr][i][j] * rstd2[rr] * w[j] * (1.f + s1[j]) + s0[j];
          *(unsigned*)(p.h2_8 + (long)(row0 + rr) * DM + c0) = cvt_pk4_fp8(y);
          *(f32x4*)(h2s + (wid * 2 + rr) * H2S_LD + c0) = y;
        }
      }
    }
    {
      f32x4 a0 = {0.f, 0.f, 0.f, 0.f}, a1 = {0.f, 0.f, 0.f, 0.f};
      const int r16 = lane & 15, kq = lane >> 4;
      const float* ap = h2s + r16 * H2S_LD + wid * 256 + kq;
      const float* bp = p.router_w + (long)(wid * 256 + kq) * NE + r16; asm volatile("" : "+v"(bp));
      float bw0[64], bw1[64];
#pragma unroll
      for (int s = 0; s < 64; ++s) { bw0[s] = bp[(long)(4 * s) * NE]; bw1[s] = bp[(long)(4 * s) * NE + 16]; }
      asm volatile("" ::: "memory");
      if (g + nwg < NLAT / 16) P7_LOAD_A(g + nwg);
      __syncthreads();
#pragma unroll
      for (int s = 0; s < 64; ++s) {
        const float av = ap[4 * s];
        a0 = __builtin_amdgcn_mfma_f32_16x16x4f32(av, bw0[s], a0, 0, 0, 0);
        a1 = __builtin_amdgcn_mfma_f32_16x16x4f32(av, bw1[s], a1, 0, 0, 0);
      }
#pragma unroll
      for (int j = 0; j < 4; ++j) { red[(wid * 16 + 4 * kq + j) * 32 + r16] = a0[j]; red[(wid * 16 + 4 * kq + j) * 32 + 16 + r16] = a1[j]; }
    }
    __syncthreads();
    {
      const int r = tid >> 5, e = tid & 31; float sl = p.router_b[e];
#pragma unroll
      for (int w = 0; w < 8; ++w) sl += red[(w * 16 + r) * 32 + e];
      if (ROUTE) {
        const int row = g * 16 + r;
        float sv[4]; int sel[4];
#pragma unroll
        for (int k = 0; k < 4; ++k) {
          float bv = sl; int bi = e;
#pragma unroll
          for (int st = 1; st < 32; st <<= 1) { const float ov = __shfl_xor(bv, st); const int oi = __shfl_xor(bi, st); const bool take = ov > bv || (ov == bv && oi < bi); bv = take ? ov : bv; bi = take ? oi : bi; }
          sv[k] = bv; sel[k] = bi; if (e == bi) sl = -3.0e38f;
        }
        const float e1 = __expf(sv[1] - sv[0]), e2 = __expf(sv[2] - sv[0]), e3 = __expf(sv[3] - sv[0]), inv = 1.f / (1.f + e1 + e2 + e3);
        if (e < 4) {
          const int se = e == 0 ? sel[0] : (e == 1 ? sel[1] : (e == 2 ? sel[2] : sel[3]));
          const float gk = (e == 0 ? 1.f : (e == 1 ? e1 : (e == 2 ? e2 : e3))) * inv;
          const int li = (gi & 3) * 64 + r * 4 + e;
          rt_e[li] = se; rt_lp[li] = atomicAdd(&lcnt[se], 1);
          p.tok_e[row * 4 + e] = se; p.tok_gate[row * 4 + e] = gk;
        }
      }
    }
    if (ROUTE && ((gi & 3) == 3 || g + nwg >= NLAT / 16)) {
      __syncthreads();
      if (tid < NE) { const int c = lcnt[tid]; lbase[tid] = c ? atomicAdd(p.cnt + tid * CNT_LD, c) : 0; lcnt[tid] = 0; }
      __syncthreads();
      const int nent = ((gi & 3) + 1) * 64;
      if (tid < nent) {
        const int se = rt_e[tid], pos = lbase[se] + rt_lp[tid], row = (g - ((gi & 3) - (tid >> 6)) * nwg) * 16 + ((tid >> 2) & 15);
        p.idx[se * NLAT + pos] = row; p.tok_pos[row * 4 + (tid & 3)] = pos;
      }
    }
  }
#undef P7_LOAD_A
#undef P7_LOAD_B
}

DEV void phase11_final(CParams& p, int wg, int nwg) {
  extern __shared__ __attribute__((aligned(16))) char shm[];
  int* rowbase = (int*)shm;
  if (ltid() < 64) {
    const int t = ltid(), n = t < NE ? (p.cnt[t * CNT_LD] + 255) >> 8 : 0; int inc = n;
#pragma unroll
    for (int st = 1; st < 32; st <<= 1) { const int v = __shfl_up(inc, st); if (t >= st) inc += v; }
    if (t < NE) rowbase[t] = (inc - n) * 256;
  }
  __syncthreads();
  const int wid = ltid() >> 6, lane = ltid() & 63;
  i32x4 te_n, tp_n; f32x4 tg_n;
  { const int r0 = wg * 8 + wid; if (r0 < NLAT) { te_n = *(const i32x4*)(p.tok_e + r0 * 4); tp_n = *(const i32x4*)(p.tok_pos + r0 * 4); tg_n = *(const f32x4*)(p.tok_gate + r0 * 4); } }
  for (int row = wg * 8 + wid; row < NLAT; row += nwg * 8) {
    const int b = row >> 12; const float* mod = p.mod + b * 12288;
    const i32x4 te = te_n, tp = tp_n; const f32x4 tg = tg_n;
    { const int rn = row + nwg * 8; if (rn < NLAT) { te_n = *(const i32x4*)(p.tok_e + rn * 4); tp_n = *(const i32x4*)(p.tok_pos + rn * 4); tg_n = *(const f32x4*)(p.tok_gate + rn * 4); } }
    f32x4 y[2][4]; u32x4 xr[2][2];
#pragma unroll
    for (int i = 0; i < 2; ++i) { const bf16_t* xp = p.x1 + (long)row * DM + 1024 * i + lane * 16; xr[i][0] = *(const u32x4*)xp; xr[i][1] = *(const u32x4*)(xp + 8); }
#pragma unroll
    for (int i = 0; i < 2; ++i)
#pragma unroll
      for (int j = 0; j < 4; ++j) y[i][j] = (f32x4){0.f, 0.f, 0.f, 0.f};
#pragma unroll
    for (int k = 0; k < 4; ++k) {
      const int e = te[k], pos = tp[k]; const float gt = tg[k];
      const unsigned char* yr = p.ys8 + (long)(rowbase[e] + pos) * DM + lane * 16;
#pragma unroll
      for (int i = 0; i < 2; ++i) {
        const u32x4 r = *(const u32x4*)(yr + 1024 * i); const unsigned rw[4] = {r.x, r.y, r.z, r.w};
#pragma unroll
        for (int j = 0; j < 4; ++j) { const f32x2 lo = __builtin_amdgcn_cvt_pk_f32_fp8(rw[j], false), hi = __builtin_amdgcn_cvt_pk_f32_fp8(rw[j], true);
          y[i][j][0] += gt * lo.x; y[i][j][1] += gt * lo.y; y[i][j][2] += gt * hi.x; y[i][j][3] += gt * hi.y; }
      }
    }
    float ss = 0.f;
#pragma unroll
    for (int i = 0; i < 2; ++i)
#pragma unroll
      for (int j = 0; j < 4; ++j) ss += y[i][j][0] * y[i][j][0] + y[i][j][1] * y[i][j][1] + y[i][j][2] * y[i][j][2] + y[i][j][3] * y[i][j][3];
    ss = wave_sum(ss); const float rstd = rsqrtf(ss * (1.f / DM) + EPS);
#pragma unroll
    for (int i = 0; i < 2; ++i)
#pragma unroll
      for (int j = 0; j < 4; ++j) {
        const int c0 = 1024 * i + lane * 16 + 4 * j;
        const f32x4 w = *(const f32x4*)(p.ln_ffn_post + c0), gf = *(const f32x4*)(mod + 10240 + c0);
        const unsigned x01 = xr[i][j >> 1][(j & 1) * 2], x23 = xr[i][j >> 1][(j & 1) * 2 + 1]; const f32x4 xx = {bflo(x01), bfhi(x01), bflo(x23), bfhi(x23)};
        f32x4 o;
#pragma unroll
        for (int jj = 0; jj < 4; ++jj) o[jj] = xx[jj] + gf[jj] * (y[i][j][jj] * rstd * w[jj]);
        *(f32x4*)(p.out + (long)row * DM + c0) = o;
      }
  }
}
namespace att {
constexpr int NW = 8, QBLK = 32, KVBLK = 64;
constexpr float SCALE = 0.07216878364870322f;
constexpr float THR = 8.f;
constexpr int SHM_V = KVBLK * DV * 2, SHM_K = KVBLK * 512;
constexpr int LDS_BYTES = 2 * SHM_V + 2 * SHM_K + NW * 64 * 4;
#define KSWZ2(row, colB) ((row) * 512 + ((colB) ^ (((row) & 15) << 4)))
#define SBAR() __builtin_amdgcn_sched_barrier(0)
DEV int crow(int r, int hi) { return (r & 3) + 8 * (r >> 2) + 4 * hi; }

DEV void partialSM(f32x16& p0, f32x16& p1, float& m_reg, float& mn, float& alpha) {
  constexpr float C = SCALE * 1.4426950408889634f;
  float pmax = p0[0];
#pragma unroll
  for (int r = 1; r < 16; ++r) pmax = fmaxf(pmax, p0[r]);
#pragma unroll
  for (int r = 0; r < 16; ++r) pmax = fmaxf(pmax, p1[r]);
  { auto rr = __builtin_amdgcn_permlane32_swap(__float_as_uint(pmax), __float_as_uint(pmax), false, false);
    pmax = fmaxf(__uint_as_float(rr[0]), __uint_as_float(rr[1])); }
  if (__builtin_expect(__all(pmax - m_reg <= THR / SCALE), 1)) { mn = m_reg; alpha = 1.f; }
  else { mn = fmaxf(m_reg, pmax); alpha = __builtin_amdgcn_exp2f((m_reg - mn) * C); m_reg = mn; }
  const float mnC = -mn * C;
#pragma unroll
  for (int r = 0; r < 16; ++r) p0[r] = fmaf(p0[r], C, mnC);
#pragma unroll
  for (int r = 0; r < 16; ++r) p1[r] = fmaf(p1[r], C, mnC);
#pragma unroll
  for (int r = 0; r < 16; ++r) p0[r] = __builtin_amdgcn_exp2f(p0[r]);
}
DEV void finishSM(f32x16& p0, f32x16& p1, float alpha, float& l_reg, bf16x8& pa0, bf16x8& pa1, bf16x8& pa2, bf16x8& pa3) {
#pragma unroll
  for (int r = 0; r < 16; ++r) p1[r] = __builtin_amdgcn_exp2f(p1[r]);
  float ps = 0;
#pragma unroll
  for (int r = 0; r < 16; ++r) ps += p0[r];
#pragma unroll
  for (int r = 0; r < 16; ++r) ps += p1[r];
  { auto rr = __builtin_amdgcn_permlane32_swap(__float_as_uint(ps), __float_as_uint(ps), false, false);
    ps = __uint_as_float(rr[0]) + __uint_as_float(rr[1]); }
  l_reg = l_reg * alpha + ps;
#define PK4(P, BASE, OUT) do { unsigned a0 = cvt_pk_bf16(P[BASE + 0], P[BASE + 1]), a1 = cvt_pk_bf16(P[BASE + 2], P[BASE + 3]);   \
    unsigned b0 = cvt_pk_bf16(P[BASE + 4], P[BASE + 5]), b1 = cvt_pk_bf16(P[BASE + 6], P[BASE + 7]);                              \
    auto r0 = __builtin_amdgcn_permlane32_swap(a0, b0, false, false); auto r1 = __builtin_amdgcn_permlane32_swap(a1, b1, false, false); \
    u32x4 w = {r0[0], r1[0], r0[1], r1[1]}; OUT = *reinterpret_cast<bf16x8*>(&w); } while (0)
  PK4(p0, 0, pa0); PK4(p0, 8, pa1); PK4(p1, 0, pa2); PK4(p1, 8, pa3);
#undef PK4
}
DEV void qkt(f32x16& p0, f32x16& p1, const char* Ks, const bf16x8* qr, int r32, int hi) {
  p0 = f32x16{}; p1 = f32x16{};
#pragma unroll
  for (int d0 = 0; d0 < 12; ++d0) { const int cb = (d0 * 16 + hi * 8) * 2;
    const bf16x8 b0 = *reinterpret_cast<const bf16x8*>(Ks + KSWZ2(r32, cb));
    const bf16x8 b1 = *reinterpret_cast<const bf16x8*>(Ks + KSWZ2(32 + r32, cb));
    p0 = __builtin_amdgcn_mfma_f32_32x32x16_bf16(b0, qr[d0], p0, 0, 0, 0);
    p1 = __builtin_amdgcn_mfma_f32_32x32x16_bf16(b1, qr[d0], p1, 0, 0, 0); }
}
DEV int v_st(int k, int c) { const int kk = (k & ~0xC) | ((k & 4) << 1) | ((k & 8) >> 1); return ((kk >> 3) * 4 + (c >> 5)) * 512 + ((kk & 7) * 32 + (c & 31)) * 2; }
DEV int v_rd_base(int lane) { return ((lane & 3) << 3) | (((lane >> 2) & 3) << 6) | (((lane >> 4) & 1) << 5) | (((lane >> 5) & 1) << 8); }
constexpr int v_rd_off(int d0, int ks, int half) { return d0 * 512 + ks * 4096 + half * 2048; }
template <int OFF> DEV s16x4 tr_read(int vb) { s16x4 r; asm volatile("ds_read_b64_tr_b16 %0, %1 offset:%2" : "=&v"(r) : "v"(vb), "i"(OFF) : "memory"); return r; }
struct VFrag { s16x4 l0, h0, l1, h1, l2, h2, l3, h3; };
template <int D0> DEV void pv_read(VFrag& f, int vb) {
  f.l0 = tr_read<v_rd_off(D0, 0, 0)>(vb); f.h0 = tr_read<v_rd_off(D0, 0, 1)>(vb); f.l1 = tr_read<v_rd_off(D0, 1, 0)>(vb); f.h1 = tr_read<v_rd_off(D0, 1, 1)>(vb);
  f.l2 = tr_read<v_rd_off(D0, 2, 0)>(vb); f.h2 = tr_read<v_rd_off(D0, 2, 1)>(vb); f.l3 = tr_read<v_rd_off(D0, 3, 0)>(vb); f.h3 = tr_read<v_rd_off(D0, 3, 1)>(vb);
}
DEV void pv_mma(f32x16& od, const VFrag& f, bf16x8 pa0, bf16x8 pa1, bf16x8 pa2, bf16x8 pa3) {
#define PK(L, H) (bf16x8){L[0], L[1], L[2], L[3], H[0], H[1], H[2], H[3]}
  od = __builtin_amdgcn_mfma_f32_32x32x16_bf16(pa0, PK(f.l0, f.h0), od, 0, 0, 0);
  od = __builtin_amdgcn_mfma_f32_32x32x16_bf16(pa1, PK(f.l1, f.h1), od, 0, 0, 0);
  od = __builtin_amdgcn_mfma_f32_32x32x16_bf16(pa2, PK(f.l2, f.h2), od, 0, 0, 0);
  od = __builtin_amdgcn_mfma_f32_32x32x16_bf16(pa3, PK(f.l3, f.h3), od, 0, 0, 0);
#undef PK
}
#define PV_WAIT(n) do { asm volatile("s_waitcnt lgkmcnt(" #n ")" ::: "memory"); SBAR(); } while (0)
DEV void pv_d0(f32x16* o, int vb, bf16x8 pa0, bf16x8 pa1, bf16x8 pa2, bf16x8 pa3) {
  VFrag fa, fb;
  pv_read<0>(fa, vb);
  pv_read<1>(fb, vb); PV_WAIT(8); pv_mma(o[0], fa, pa0, pa1, pa2, pa3); SBAR();
  pv_read<2>(fa, vb); PV_WAIT(8); pv_mma(o[1], fb, pa0, pa1, pa2, pa3); SBAR();
  pv_read<3>(fb, vb); PV_WAIT(8); pv_mma(o[2], fa, pa0, pa1, pa2, pa3); SBAR();
  PV_WAIT(0); pv_mma(o[3], fb, pa0, pa1, pa2, pa3);
}

DEV void attn_unit(const bf16_t* __restrict__ Qb, const bf16_t* __restrict__ Kh, const bf16_t* __restrict__ Vh, const float* __restrict__ rp, bf16_t* __restrict__ Ob, CParams& fp, int fwg, int fbase, int fn) {
  extern __shared__ __attribute__((aligned(16))) char shm[];
  const int tid = ltid(), wid = tid >> 6, lane = tid & 63, r32 = lane & 31, hi = lane >> 5;
  char* V_lds = shm; char* K_lds = shm + 2 * SHM_V;
  float* ws = (float*)(shm + 2 * SHM_V + 2 * SHM_K) + wid * 64; float* li_l = ws; float* al_l = ws + 32;
  float m_reg = -1e30f, l_reg = 0; f32x16 o[4] = {}; bf16x8 qr[12];
  {
    const bf16_t* Qw = Qb + (long)(wid * QBLK + r32) * QK + hi * 8;
#pragma unroll
    for (int d0 = 0; d0 < 12; ++d0) qr[d0] = *reinterpret_cast<const bf16x8*>(Qw + d0 * 16);
    const float* rr = rp + (long)(wid * QBLK + r32) * 64;
#pragma unroll
    for (int dd = 0; dd < 2; ++dd) {
      const int a0 = 16 * dd + 8 * hi;
      const f32x4 c0 = *(const f32x4*)(rr + a0), c1 = *(const f32x4*)(rr + a0 + 4), s0 = *(const f32x4*)(rr + 32 + a0), s1 = *(const f32x4*)(rr + 32 + a0 + 4);
      float cs[8] = {c0[0], c0[1], c0[2], c0[3], c1[0], c1[1], c1[2], c1[3]}, sn[8] = {s0[0], s0[1], s0[2], s0[3], s1[0], s1[1], s1[2], s1[3]};
      const bf16x8 x1 = qr[8 + dd], x2 = qr[10 + dd]; bf16x8 y1, y2;
#pragma unroll
      for (int j = 0; j < 8; j += 2) {
        const float a1 = bf2f((bf16_t)x1[j]), a2 = bf2f((bf16_t)x2[j]), b1 = bf2f((bf16_t)x1[j + 1]), b2 = bf2f((bf16_t)x2[j + 1]);
        const unsigned u1 = cvt_pk_bf16(a1 * cs[j] - a2 * sn[j], b1 * cs[j + 1] - b2 * sn[j + 1]);
        const unsigned u2 = cvt_pk_bf16(a1 * sn[j] + a2 * cs[j], b1 * sn[j + 1] + b2 * cs[j + 1]);
        y1[j] = (short)(u1 & 0xffff); y1[j + 1] = (short)(u1 >> 16); y2[j] = (short)(u2 & 0xffff); y2[j + 1] = (short)(u2 >> 16);
      }
      qr[8 + dd] = y1; qr[10 + dd] = y2;
    }
  }
  const int sr = tid >> 4, sc = (tid & 15) * 8, vst0 = v_st(sr, sc), vst1 = v_st(32 + sr, sc);
  int kst[3];
#pragma unroll
  for (int i = 0; i < 3; ++i) { const int id = tid + 512 * i, row = id / 24, ch = id % 24; kst[i] = KSWZ2(row, ch * 16); }
  const int vb0 = (int)(uintptr_t)V_lds + v_rd_base(lane);
  bf16x8 vs0, vs1, ks0, ks1, ks2;
#define SLOAD(k0) do { vs0 = *reinterpret_cast<const bf16x8*>(Vh + (long)((k0) + sr) * DV + sc); vs1 = *reinterpret_cast<const bf16x8*>(Vh + (long)((k0) + 32 + sr) * DV + sc); \
    const bf16_t* kp_ = Kh + (long)(k0) * QK + tid * 8; ks0 = *reinterpret_cast<const bf16x8*>(kp_); ks1 = *reinterpret_cast<const bf16x8*>(kp_ + 4096); ks2 = *reinterpret_cast<const bf16x8*>(kp_ + 8192); } while (0)
#define SWRITE(b) do { *(bf16x8*)(V_lds + (b) * SHM_V + vst0) = vs0; *(bf16x8*)(V_lds + (b) * SHM_V + vst1) = vs1; \
    *(bf16x8*)(K_lds + (b) * SHM_K + kst[0]) = ks0; *(bf16x8*)(K_lds + (b) * SHM_K + kst[1]) = ks1; *(bf16x8*)(K_lds + (b) * SHM_K + kst[2]) = ks2; } while (0)
#define SWAIT() asm volatile("s_waitcnt vmcnt(0)" ::: "memory")
#define RESC(a) do { if (__any((a) < 1.f)) { if (hi == 0) al_l[r32] = (a); asm volatile("s_waitcnt lgkmcnt(0)" ::: "memory"); \
    _Pragma("unroll") for (int d = 0; d < 4; ++d) _Pragma("unroll") for (int r = 0; r < 16; ++r) o[d][r] *= al_l[crow(r, hi)]; } } while (0)
  f32x16 p0, p1; float mn, al; bf16x8 pa0, pa1, pa2, pa3; constexpr int NTL = KEYS / KVBLK;
  f32x4 fld[4];
  if (fn > 0) fill_load(fp, fwg, fbase, fld);
  SLOAD(0); SWAIT(); SWRITE(0); SLOAD(KVBLK); __syncthreads();
#pragma unroll 1
  for (int j = 0; j < NTL; ++j) {
    const int cb = j & 1;
    if (j + 1 < NTL) { if (j >= 2 && j < fn) asm volatile("s_waitcnt vmcnt(5)" ::: "memory"); else SWAIT(); SWRITE(cb ^ 1); }
    if (j + 2 < NTL) SLOAD((j + 2) * KVBLK);
    if (j > 0 && j <= fn) fill_store(fp, fwg, fbase + j - 1, (j - 1) & 1);
    SBAR(); qkt(p0, p1, K_lds + cb * SHM_K, qr, r32, hi);
    partialSM(p0, p1, m_reg, mn, al);
    RESC(al);
    finishSM(p0, p1, al, l_reg, pa0, pa1, pa2, pa3); SBAR();
    pv_d0(o, vb0 + cb * SHM_V, pa0, pa1, pa2, pa3);
    if (j < fn) { fill_write(fld, j & 1); if (j + 1 < fn) fill_load(fp, fwg, fbase + j + 1, fld); }
    __syncthreads();
  }
  if (fn == NTL) fill_store(fp, fwg, fbase + NTL - 1, (NTL - 1) & 1);
  if (hi == 0) li_l[r32] = l_reg;
  asm volatile("s_waitcnt lgkmcnt(0)" ::: "memory");
  float rli[16];
#pragma unroll
  for (int r = 0; r < 16; ++r) rli[r] = __builtin_amdgcn_rcpf(li_l[crow(r, hi)]);
  bf16_t* Ow = Ob + (long)(wid * QBLK) * DM;
  constexpr int OPITCH = DV * 2 + 16;
  char* ost = shm + wid * (QBLK * OPITCH);
#pragma unroll
  for (int r = 0; r < 16; ++r) { const int orow = crow(r, hi);
#pragma unroll
    for (int d0 = 0; d0 < 4; ++d0) *(bf16_t*)(ost + orow * OPITCH + (d0 * 32 + r32) * 2) = f2bf(o[d0][r] * rli[r]); }
  asm volatile("s_waitcnt lgkmcnt(0)" ::: "memory");
#pragma unroll
  for (int k = 0; k < 8; ++k) { const int idx = k * 64 + lane, row = idx >> 4, ch = idx & 15;
    *(u32x4*)(Ow + (long)row * DM + ch * 8) = *(const u32x4*)(ost + row * OPITCH + ch * 16); }
  __syncthreads();
#undef SLOAD
#undef SWRITE
#undef SWAIT
#undef RESC
}
}

DEV void phase5a_attn(CParams& p, int u, int fwg = 0, int fbase = 0, int fn = 0) {
  const int qb = u & 15, h = (u >> 4) & 7, b = u >> 7;
  const long bh = b * NH + h;
  att::attn_unit(p.qf + (bh * SEQ + qb * 256) * QK, p.kf + bh * KEYS * QK, p.vf + bh * KEYS * DV, p.rope + (long)(qb * 256) * 64,
                 p.aout + (long)(b * SEQ + qb * 256) * DM + h * DV, p, fwg, fbase, fn);
}
namespace hg {
constexpr int LQ = 136, LS = 72;
constexpr int O_QT = 0, O_KT = O_QT + 64 * LQ * 2, O_KHT = O_KT + 64 * LQ * 2, O_VT = O_KHT + 128 * LS * 2, O_ST = O_VT + 32 * LS * 2, BUF = O_ST + 32 * LQ * 2;
constexpr int LDS_BYTES = 2 * BUF;
DEV bf16x8 ld8(const char* p) { return *reinterpret_cast<const bf16x8*>(p); }
DEV int qk_off(int row, int colb) { return row * (LQ * 2) + ((((colb >> 4) ^ ((row >> 3) & 7)) << 4) | (colb & 15)); }
DEV bf16x8 ld44(const char* p0, const char* p1) { const s16x4 a = *reinterpret_cast<const s16x4*>(p0), b = *reinterpret_cast<const s16x4*>(p1); return (bf16x8){a[0], a[1], a[2], a[3], b[0], b[1], b[2], b[3]}; }

DEV void hgrn_unit(CParams& p, int u, int wg, bool fill) {
  extern __shared__ __attribute__((aligned(16))) char shm[];
  const int sl = u & 3, dir = (u >> 2) & 1, h = (u >> 3) & 7, b = u >> 6;
  const int tid = ltid(), wid = tid >> 6, lane = tid & 63, fr = lane & 15, fq = lane >> 4;
  const int dp = lane & 7, seg = lane >> 3, d0 = 16 * wid + 2 * dp;
  const float* G = dir ? p.gb : p.gf;
  bf16_t* O = dir ? p.ob : p.of;
  const int sgn = dir ? -1 : 1;
#define HG_ROW0(c_, r0_) do { if ((c_) < 4) r0_ = dir ? b * 256 + 255 - 64 * (c_) : b * 256 + 64 * (c_); \
    else r0_ = dir ? NCTX + b * 4096 + 4095 - 64 * ((c_) - 4) : NCTX + b * 4096 + 64 * ((c_) - 4); } while (0)
#define HG_LOAD(c_, G_, Q_, V_) do { int r0n_; HG_ROW0(c_, r0n_); \
    _Pragma("unroll") for (int ii = 0; ii < 8; ++ii) { const long row_ = r0n_ + sgn * (8 * seg + ii); G_[ii] = *(const f32x2*)(G + row_ * 1024 + h * 128 + d0); Q_[ii] = *(const unsigned*)(p.qh + row_ * 1024 + h * 128 + d0); } \
    { const long row_ = r0n_ + sgn * (tid >> 3); V_ = *(const u32x2*)(p.vh + row_ * 1024 + h * 128 + sl * 32 + (tid & 7) * 4); } } while (0)
  f32x4 S[2] = {{0.f, 0.f, 0.f, 0.f}, {0.f, 0.f, 0.f, 0.f}};
  float dec = 0.f;
  f32x2 g[8]; unsigned q[8]; u32x2 v;
  f32x2 gN[8]; unsigned qN[8]; u32x2 vN;
#define HG_ELEM(cn_, LATN_) do { char* bufn = shm + ((cn_) & 1) * BUF; \
    { bf16_t* VT = (bf16_t*)(bufn + O_VT); const int i = tid >> 3, e4 = (tid & 7) * 4; \
      VT[(e4 + 0) * LS + i] = (bf16_t)(v.x & 0xffff); VT[(e4 + 1) * LS + i] = (bf16_t)(v.x >> 16); VT[(e4 + 2) * LS + i] = (bf16_t)(v.y & 0xffff); VT[(e4 + 3) * LS + i] = (bf16_t)(v.y >> 16); } \
    f32x2 cp[8]; cp[0] = g[0]; \
    _Pragma("unroll") for (int ii = 1; ii < 8; ++ii) cp[ii] = cp[ii - 1] * g[ii]; \
    f32x2 inc = cp[7]; \
    _Pragma("unroll") for (int st = 8; st < 64; st <<= 1) { const float t0 = __shfl_up(inc[0], st), t1 = __shfl_up(inc[1], st); if (lane >= st) { inc[0] *= t0; inc[1] *= t1; } } \
    f32x2 off; { const float t0 = __shfl_up(inc[0], 8), t1 = __shfl_up(inc[1], 8); off[0] = lane >= 8 ? t0 : 1.f; off[1] = lane >= 8 ? t1 : 1.f; } \
    f32x2 BL, R; BL[0] = __shfl(inc[0], dp + 56); BL[1] = __shfl(inc[1], dp + 56); R[0] = __shfl(inc[0], dp + 24); R[1] = __shfl(inc[1], dp + 24); \
    const float Ri0 = __builtin_amdgcn_rcpf(fmaxf(R[0], 1e-35f)), Ri1 = __builtin_amdgcn_rcpf(fmaxf(R[1], 1e-35f)); \
    const float ebl0 = BL[0] * Ri0, ebl1 = BL[1] * Ri1; \
    const float b0s = __shfl(BL[0], fr >> 1), b1s = __shfl(BL[1], fr >> 1), r0s = __shfl(R[0], fr >> 1), r1s = __shfl(R[1], fr >> 1); \
    dec = (fr & 1) ? b1s : b0s; \
    if (LATN_) { const float er = (fr & 1) ? r1s : r0s; bf16_t* ST = (bf16_t*)(bufn + O_ST); \
      _Pragma("unroll") for (int eb = 0; eb < 2; ++eb) _Pragma("unroll") for (int j = 0; j < 4; ++j) ST[(eb * 16 + 4 * fq + j) * LQ + wid * 16 + fr] = f2bf(S[eb][j] * er); } \
    unsigned kh0[4], kh1[4]; \
    _Pragma("unroll") for (int ii = 0; ii < 8; ii += 2) { float k0v[2], k1v[2]; \
      _Pragma("unroll") for (int z = 0; z < 2; ++z) { const int i = 8 * seg + ii + z; \
        const float E0 = fminf(fmaxf(off[0] * cp[ii + z][0] * Ri0, 1e-30f), 1e30f), E1 = fminf(fmaxf(off[1] * cp[ii + z][1] * Ri1, 1e-30f), 1e30f); \
        const float Ei0 = __builtin_amdgcn_rcpf(E0), Ei1 = __builtin_amdgcn_rcpf(E1); \
        const float kt0 = (1.f - g[ii + z][0]) * Ei0, kt1 = (1.f - g[ii + z][1]) * Ei1; \
        *(unsigned*)(bufn + O_KT + qk_off(i, d0 * 2)) = cvt_pk_bf16(kt0, kt1); \
        if (LATN_) *(unsigned*)(bufn + O_QT + qk_off(i, d0 * 2)) = cvt_pk_bf16(bflo(q[ii + z]) * E0, bfhi(q[ii + z]) * E1); \
        k0v[z] = kt0 * ebl0; k1v[z] = kt1 * ebl1; } \
      kh0[ii >> 1] = cvt_pk_bf16(k0v[0], k0v[1]); kh1[ii >> 1] = cvt_pk_bf16(k1v[0], k1v[1]); } \
    *(u32x4*)(bufn + O_KHT + (d0 * LS + 8 * seg) * 2) = (u32x4){kh0[0], kh0[1], kh0[2], kh0[3]}; \
    *(u32x4*)(bufn + O_KHT + ((d0 + 1) * LS + 8 * seg) * 2) = (u32x4){kh1[0], kh1[1], kh1[2], kh1[3]}; } while (0)
#define HG_MMA(c_, LATC_) do { const char* bufc = shm + ((c_) & 1) * BUF; \
    if (LATC_) { const int tb = wid >> 1, eb = wid & 1; f32x4 P[4]; bf16x8 qt[4];        \
      _Pragma("unroll") for (int ks = 0; ks < 4; ++ks) qt[ks] = ld8(bufc + O_QT + qk_off(tb * 16 + fr, 64 * ks + 16 * fq)); \
      _Pragma("unroll") for (int sb = 0; sb < 4; ++sb) { P[sb] = (f32x4){0.f, 0.f, 0.f, 0.f}; \
        if (sb <= tb) { \
          _Pragma("unroll") for (int ks = 0; ks < 4; ++ks) { \
            const bf16x8 a = ld8(bufc + O_KT + qk_off(sb * 16 + fr, 64 * ks + 16 * fq)); \
            P[sb] = __builtin_amdgcn_mfma_f32_16x16x32_bf16(a, qt[ks], P[sb], 0, 0, 0); }        \
          if (sb == tb) { _Pragma("unroll") for (int j = 0; j < 4; ++j) P[sb][j] = (4 * fq + j <= fr) ? P[sb][j] : 0.f; } } } \
      f32x4 acc = {0.f, 0.f, 0.f, 0.f}; \
      _Pragma("unroll") for (int pr = 0; pr < 2; ++pr) {        \
        if (2 * pr <= tb) { \
          const u32x4 pw = {cvt_pk_bf16(P[2 * pr][0], P[2 * pr][1]), cvt_pk_bf16(P[2 * pr][2], P[2 * pr][3]), cvt_pk_bf16(P[2 * pr + 1][0], P[2 * pr + 1][1]), cvt_pk_bf16(P[2 * pr + 1][2], P[2 * pr + 1][3])}; \
          const char* vrow = bufc + O_VT + ((eb * 16 + fr) * LS + 32 * pr + 4 * fq) * 2; \
          acc = __builtin_amdgcn_mfma_f32_16x16x32_bf16(ld44(vrow, vrow + 32), __builtin_bit_cast(bf16x8, pw), acc, 0, 0, 0); } } \
      _Pragma("unroll") for (int ks = 0; ks < 4; ++ks) { \
        const bf16x8 a = ld8(bufc + O_ST + ((eb * 16 + fr) * LQ + 32 * ks + 8 * fq) * 2); \
        acc = __builtin_amdgcn_mfma_f32_16x16x32_bf16(a, qt[ks], acc, 0, 0, 0); } \
      int r0; HG_ROW0(c_, r0); const long row = r0 + sgn * (tb * 16 + fr) - NCTX; \
      st_bf16x4(O + row * 1024 + h * 128 + sl * 32 + eb * 16 + 4 * fq, acc); }        \
    { bf16x8 kh[2]; _Pragma("unroll") for (int ks = 0; ks < 2; ++ks) kh[ks] = ld8(bufc + O_KHT + ((wid * 16 + fr) * LS + 32 * ks + 8 * fq) * 2); \
    _Pragma("unroll") for (int eb = 0; eb < 2; ++eb) { f32x4 acc = S[eb] * dec; \
      _Pragma("unroll") for (int ks = 0; ks < 2; ++ks) { \
        const bf16x8 a = ld8(bufc + O_VT + ((eb * 16 + fr) * LS + 32 * ks + 8 * fq) * 2); \
        acc = __builtin_amdgcn_mfma_f32_16x16x32_bf16(a, kh[ks], acc, 0, 0, 0); } \
      S[eb] = acc; } } } while (0)
#define HG_STEP(c_, LATC_, LATN_, FLD_) do { HG_LOAD((c_) + 2 < 68 ? (c_) + 2 : 67, gN, qN, vN); if (fill && (c_) > 0 && (c_) <= FILL_HG) fill_store(p, wg, (c_) - 1, ((c_) - 1) & 1); \
    HG_MMA(c_, LATC_); HG_ELEM((c_) + 1, LATN_); if (fill && (c_) < FILL_HG) { fill_write(FLD_, (c_) & 1); if ((c_) + 2 < FILL_HG) fill_load(p, wg, (c_) + 2, FLD_); } __syncthreads(); \
    _Pragma("unroll") for (int ii = 0; ii < 8; ++ii) { g[ii] = gN[ii]; q[ii] = qN[ii]; } v = vN; } while (0)
  f32x4 fldA[4], fldB[4];
  if (fill && FILL_HG > 0) { fill_load(p, wg, 0, fldA); if (FILL_HG > 1) fill_load(p, wg, 1, fldB); }
  HG_LOAD(0, g, q, v);
  HG_ELEM(0, false);
  HG_LOAD(1, g, q, v);
  __syncthreads();
  HG_STEP(0, false, false, fldA); HG_STEP(1, false, false, fldB); HG_STEP(2, false, false, fldA);
  HG_STEP(3, false, true, fldB);
#pragma unroll 1
  for (int c = 4; c < 66; c += 2) { HG_STEP(c, true, true, fldA); HG_STEP(c + 1, true, true, fldB); }
  HG_STEP(66, true, true, fldA);
  HG_MMA(67, true);
  __syncthreads();
  if (fill && FILL_HG == 67) fill_store(p, wg, 66, 0);
#undef HG_ELEM
#undef HG_MMA
#undef HG_STEP
#undef HG_ROW0
#undef HG_LOAD
}
}

#define XB_TMO      128
#define XB_XCNT(j)  (256  + 64 * (j))
#define XB_XSUB(j)  (1280 + 64 * (j))
#define XB_XGEN(j)  (2304 + 64 * (j))
#define XB_TOP      3328
#define XB_TOPGEN   3392
#define XCD_BAR_WORDS 3456
#define XB_SPIN_CAP (1u << 21)

__device__ __forceinline__ unsigned xb_ld(unsigned* p)              { return __hip_atomic_load(p, __ATOMIC_RELAXED, __HIP_MEMORY_SCOPE_AGENT); }
__device__ __forceinline__ unsigned xb_add(unsigned* p, unsigned v) { return __hip_atomic_fetch_add(p, v, __ATOMIC_RELAXED, __HIP_MEMORY_SCOPE_AGENT); }
__device__ __forceinline__ unsigned xb_xcc_id() { return (unsigned)__builtin_amdgcn_s_getreg((3 << 11) | 20) & 0xFu; }
#define XB_SPIN(cond, bar) do { unsigned _sp = 0; while (cond) { __builtin_amdgcn_s_sleep(1); \
    if ((++_sp & 255u) == 0u) { if (xb_ld(&(bar)[XB_TMO])) break; if (_sp > XB_SPIN_CAP) { atomicAdd(&(bar)[XB_TMO], 1u); break; } } } } while (0)

struct XcdBarrier {
    unsigned* bar; unsigned x;
    volatile LAS unsigned* st;
};

__device__ __forceinline__ XcdBarrier xcd_barrier_post(unsigned* bar, volatile LAS unsigned* st) {
    XcdBarrier b; b.bar = bar; b.x = xb_xcc_id(); b.st = st;
    if (threadIdx.x == 0) (void)xb_add(&bar[XB_XCNT(b.x)], 1u);
    return b;
}
__device__ __forceinline__ void xcd_barrier_complete(unsigned* bar, unsigned x, unsigned& nloc, unsigned& nx) {
    const unsigned G = gridDim.x * gridDim.y * gridDim.z;
    unsigned sum, cnt, mine, sp = 0u;
    for (;;) {
        sum = 0u; cnt = 0u; mine = 0u;
#pragma unroll
        for (unsigned j = 0; j < 16; ++j) { const unsigned c = xb_ld(&bar[XB_XCNT(j)]); sum += c; cnt += (c > 0u) ? 1u : 0u; mine = (j == x) ? c : mine; }
        if (sum == G) break;
        __builtin_amdgcn_s_sleep(1);
        if ((++sp & 255u) == 0u) { if (xb_ld(&bar[XB_TMO])) break; if (sp > XB_SPIN_CAP) { atomicAdd(&bar[XB_TMO], 1u); break; } }
    }
    nloc = mine > 0u ? mine : 1u; nx = cnt > 0u ? cnt : 1u;
}

__device__ __forceinline__ void xcd_barrier(const XcdBarrier& b) {
    asm volatile("s_waitcnt vmcnt(0)" ::: "memory");
    __syncthreads();
    if (threadIdx.x == 0) {
        unsigned* bar = b.bar;
        __builtin_amdgcn_s_waitcnt(0);
        unsigned nloc = b.st[0], nx = b.st[1];
        if (nloc == 0u) { xcd_barrier_complete(bar, b.x, nloc, nx); b.st[0] = nloc; b.st[1] = nx; }
        const unsigned old = xb_add(&bar[XB_XSUB(b.x)], 1u);
        const unsigned gen = old / nloc;
        if (old + 1u == (gen + 1u) * nloc) {
            __builtin_amdgcn_fence(__ATOMIC_RELEASE, "agent");
            asm volatile("s_waitcnt vmcnt(0)" ::: "memory");
            const unsigned og = xb_add(&bar[XB_TOP], 1u);
            const unsigned tg = og / nx;
            if (og + 1u == (tg + 1u) * nx) xb_add(&bar[XB_TOPGEN], 1u);
            else XB_SPIN(xb_ld(&bar[XB_TOPGEN]) == tg, bar);
            __builtin_amdgcn_fence(__ATOMIC_ACQUIRE, "agent");
            xb_add(&bar[XB_XGEN(b.x)], 1u);
            asm volatile("s_waitcnt vmcnt(0)" ::: "memory");
        } else {
            XB_SPIN(xb_ld(&bar[XB_XGEN(b.x)]) == gen, bar);
            __builtin_amdgcn_fence(__ATOMIC_ACQUIRE, "agent");
            asm volatile("s_waitcnt vmcnt(0)" ::: "memory");
        }
    }
    __syncthreads();
}


#define XB_SUBBAR 3520
__device__ __forceinline__ void sub_barrier(unsigned* ctr, unsigned n) {
    asm volatile("s_waitcnt vmcnt(0)" ::: "memory");
    __syncthreads();
    if (threadIdx.x == 0) {
        __builtin_amdgcn_s_waitcnt(0);
        __builtin_amdgcn_fence(__ATOMIC_RELEASE, "agent");
        asm volatile("s_waitcnt vmcnt(0)" ::: "memory");
        (void)xb_add(ctr, 1u);
        unsigned sp = 0u;
        while (xb_ld(ctr) < n) { __builtin_amdgcn_s_sleep(1); if (++sp > XB_SPIN_CAP) break; }
        __builtin_amdgcn_fence(__ATOMIC_ACQUIRE, "agent");
        asm volatile("s_waitcnt vmcnt(0)" ::: "memory");
    }
    __syncthreads();
}

#define XB_C0 3584
#define XB_C5(j) (3600 + 4 * (j))
__device__ __forceinline__ void cnt_arrive(unsigned* ctr) {
    asm volatile("s_waitcnt vmcnt(0)" ::: "memory");
    __syncthreads();
    if (threadIdx.x == 0) {
        __builtin_amdgcn_s_waitcnt(0);
        __builtin_amdgcn_fence(__ATOMIC_RELEASE, "agent");
        asm volatile("s_waitcnt vmcnt(0)" ::: "memory");
        (void)xb_add(ctr, 1u);
    }
}
__device__ __forceinline__ void cnt_wait(unsigned* ctr, unsigned n) {
    if (threadIdx.x == 0) {
        unsigned sp = 0u;
        while (xb_ld(ctr) < n) { __builtin_amdgcn_s_sleep(1); if (++sp > XB_SPIN_CAP) break; }
        __builtin_amdgcn_fence(__ATOMIC_ACQUIRE, "agent");
        asm volatile("s_waitcnt vmcnt(0)" ::: "memory");
    }
    __syncthreads();
}

constexpr int LDS_MAX = 160 * 1024;
constexpr int XB_LDS_OFF = LDS_MAX - 16;

__global__ void __launch_bounds__(NT, 2) k_mega(Params p) {
  extern __shared__ __attribute__((aligned(16))) char shm[];
  const int wg = blockIdx.x, nwg = gridDim.x;
  CParams* kp = KARGS;
  if (threadIdx.x == 0) *(uint4*)(shm + XB_LDS_OFF) = make_uint4(0u, 0u, 0u, 0u);
  __syncthreads();
  XcdBarrier bar = xcd_barrier_post(kp->bar, (volatile LAS unsigned*)(shm + XB_LDS_OFF));
  if (nwg == 256) {
    phase0_units(*launder(kp), wg, nwg);
    if (wg < U_MOD) cnt_arrive(kp->bar + XB_C0);
    phase0_cvt(*launder(kp), wg, nwg);
    cnt_wait(kp->bar + XB_C0, U_MOD);
    phase1_rows(*launder(kp), wg, nwg);
  } else {
    phase0_units(*launder(kp), wg, nwg); phase0_cvt(*launder(kp), wg, nwg);
    xcd_barrier(bar);
    phase1_rows(*launder(kp), wg, nwg);
  }
  xcd_barrier(bar);
  phase2_inproj(*launder(kp), wg, nwg);
  xcd_barrier(bar);
  if (nwg >= 128) {
    if (wg >= 64) { phase3_rows(*launder(kp), wg - 64, nwg - 64); sub_barrier(kp->bar + XB_SUBBAR, (unsigned)(nwg - 64)); }
    phase4_up(*launder(kp), wg, nwg);
  } else {
    phase3_rows(*launder(kp), wg, nwg);
    xcd_barrier(bar);
    phase4_up(*launder(kp), wg, nwg);
  }
  xcd_barrier(bar);
  if (nwg == 256) {
    const int x = wg & 7, y = wg >> 3; const bool late = (y >> 2) & 1;
    if (!late) hg::hgrn_unit(*launder(kp), 4 * (x + 8 * (y >> 2)) + (y & 3), wg, true);
    phase5a_attn(*launder(kp), 16 * (2 * x + (y >> 4)) + (y & 15), wg, FILL_HG, FILL_A0);
    if (late) hg::hgrn_unit(*launder(kp), 4 * (x + 8 * (y >> 2)) + (y & 3), wg, true);
    phase5a_attn(*launder(kp), 16 * (16 + 2 * x + (y >> 4)) + (y & 15), wg, FILL_HG + FILL_A0, FILL_A1);
  } else {
    for (int u = wg; u < 256; u += nwg) hg::hgrn_unit(*launder(kp), u, wg, false);
    for (int u = wg; u < 512; u += nwg) phase5a_attn(*launder(kp), u);
  }
  xcd_barrier(bar);
  if (nwg == 256) {
    const int j = wg & 63, base = j * 256 + (wg >> 6) * 64;
    phase5c_rec(*launder(kp), base, 8, base + 64);
    cnt_arrive(kp->bar + XB_C5(j));
    cnt_wait(kp->bar + XB_C5(j), 4u);
    phase6_outproj(*launder(kp), wg, nwg);
  } else {
    phase5c_rec(*launder(kp), wg * 8, nwg * 8, NLAT);
    xcd_barrier(bar);
    phase6_outproj(*launder(kp), wg, nwg);
  }
  xcd_barrier(bar);
  phase7_post<true>(*launder(kp), wg, nwg);
  xcd_barrier(bar);
  phase_moe<0>(*launder(kp), wg, nwg);
  xcd_barrier(bar);
  phase_moe<1>(*launder(kp), wg, nwg);
  xcd_barrier(bar);
  phase11_final(*launder(kp), wg, nwg);
}

static size_t carve(size_t& off, size_t bytes) { const size_t o = off; off += (bytes + 255) & ~(size_t)255; return o; }

extern "C" void kernel_launch(void* const* d_in, const int* in_sizes, int n_in, void* d_out, int out_size, void* d_ws, size_t ws_size, hipStream_t stream) {
  Params p{};
  p.x = (const float*)d_in[0]; p.c = (const float*)d_in[1]; p.ctx = (const float*)d_in[2]; p.c_ctx = (const float*)d_in[3]; p.w_mod = (const float*)d_in[4]; p.b_mod = (const float*)d_in[5];
  p.ln_mix_pre = (const float*)d_in[6]; p.ln_mix_post = (const float*)d_in[7]; p.ln_ffn_pre = (const float*)d_in[8]; p.ln_ffn_post = (const float*)d_in[9]; p.w_in = (const float*)d_in[10];
  p.q_norm = (const float*)d_in[11]; p.kv_norm = (const float*)d_in[12]; p.w_uq = (const float*)d_in[13]; p.w_ukv = (const float*)d_in[14]; p.hgrn_lb = (const float*)d_in[15];
  p.g_norm = (const float*)d_in[16]; p.w_out = (const float*)d_in[17]; p.router_w = (const float*)d_in[18]; p.router_b = (const float*)d_in[19]; p.w_gu = (const float*)d_in[20];
  p.b_gu = (const float*)d_in[21]; p.w_dn = (const float*)d_in[22]; p.b_dn = (const float*)d_in[23];
  p.out = (float*)d_out;
  char* ws = (char*)d_ws; size_t off = 0;
  p.bar = (unsigned*)(ws + carve(off, 16384));
  p.cnt = (int*)(ws + carve(off, NE * CNT_LD * 4));
  const size_t zero_bytes = off;
  p.wt_in = (bf16_t*)(ws + carve(off, (size_t)INCP * 2048 * 2)); p.wt_uq = (bf16_t*)(ws + carve(off, (size_t)1536 * 512 * 2)); p.wt_ukv = (bf16_t*)(ws + carve(off, (size_t)2048 * 256 * 2));
  p.wt_out = (bf16_t*)(ws + carve(off, (size_t)2048 * 2048 * 2)); p.wt_gu8 = (unsigned char*)(ws + carve(off, (size_t)NE * 4096 * 2048)); p.wt_dn8 = (unsigned char*)(ws + carve(off, (size_t)NE * 2048 * 2048));
  p.mod = (float*)(ws + carve(off, 5 * 12288 * 4)); p.rope = (float*)(ws + carve(off, 4096 * 64 * 4));
  p.h = (bf16_t*)(ws + carve(off, (size_t)NROW * DM * 2));
  p.cq = (bf16_t*)(ws + carve(off, (size_t)NLAT * QRANK * 2)); p.cqn = (bf16_t*)(ws + carve(off, (size_t)NLAT * QRANK * 2));
  p.ckv = (bf16_t*)(ws + carve(off, (size_t)NROW * KVRANK * 2)); p.ckvn = (bf16_t*)(ws + carve(off, (size_t)NROW * KVRANK * 2));
  p.kr = (float*)(ws + carve(off, (size_t)NROW * ROPE * 4));
  p.qh = (bf16_t*)(ws + carve(off, (size_t)NROW * 1024 * 2)); p.gf = (float*)(ws + carve(off, (size_t)NROW * 1024 * 4)); p.gb = (float*)(ws + carve(off, (size_t)NROW * 1024 * 4));
  p.vh = (bf16_t*)(ws + carve(off, (size_t)NROW * 1024 * 2)); p.gate = (bf16_t*)(ws + carve(off, (size_t)NROW * 1024 * 2));
  p.qf = (bf16_t*)(ws + carve(off, (size_t)NBATCH * NH * SEQ * QK * 2)); p.kf = (bf16_t*)(ws + carve(off, (size_t)NBATCH * NH * KEYS * QK * 2)); p.vf = (bf16_t*)(ws + carve(off, (size_t)NBATCH * NH * KEYS * DV * 2));
  p.aout = (bf16_t*)(ws + carve(off, (size_t)NLAT * DM * 2)); p.of = (bf16_t*)(ws + carve(off, (size_t)NLAT * 1024 * 2)); p.ob = (bf16_t*)(ws + carve(off, (size_t)NLAT * 1024 * 2));
  p.mix = (bf16_t*)(ws + carve(off, (size_t)NLAT * DM * 2)); p.x1 = (bf16_t*)(ws + carve(off, (size_t)NLAT * DM * 2)); p.h2_8 = (unsigned char*)(ws + carve(off, (size_t)NLAT * DM));
  p.tok_e = (int*)(ws + carve(off, (size_t)NLAT * 4 * 4)); p.tok_pos = (int*)(ws + carve(off, (size_t)NLAT * 4 * 4)); p.tok_gate = (float*)(ws + carve(off, (size_t)NLAT * 4 * 4));
  p.idx = (int*)(ws + carve(off, (size_t)NE * NLAT * 4));
  p.act8 = (unsigned char*)(ws + carve(off, (size_t)MAXSLOT * DFF)); p.ys8 = (unsigned char*)(ws + carve(off, (size_t)MAXSLOT * DM));
  if (off > ws_size) { fprintf(stderr, "kernel_launch: workspace too small: need %zu have %zu\n", off, ws_size); return; }
  static int grid = 0;
  if (!grid) {
    if (hipFuncSetAttribute((const void*)k_mega, hipFuncAttributeMaxDynamicSharedMemorySize, LDS_MAX) != hipSuccess) { fprintf(stderr, "kernel_launch: hipFuncSetAttribute failed\n"); return; }
    int dev = 0, cus = 0, per_cu = 0;
    (void)hipGetDevice(&dev);
    (void)hipDeviceGetAttribute(&cus, hipDeviceAttributeMultiprocessorCount, dev);
    (void)hipOccupancyMaxActiveBlocksPerMultiprocessor(&per_cu, k_mega, NT, LDS_MAX);
    if (per_cu < 1 || cus < 1) { fprintf(stderr, "kernel_launch: occupancy query says %d blocks per CU on %d CUs\n", per_cu, cus); return; }
    grid = cus & ~15;
  }
  (void)hipMemsetAsync(ws, 0, zero_bytes, stream);
  hipLaunchKernelGGL(k_mega, dim3(grid), dim3(NT), LDS_MAX, stream, p);
  const hipError_t le = hipPeekAtLastError();
  if (le != hipSuccess) fprintf(stderr, "kernel_launch: launch failed: %s\n", hipGetErrorName(le));
}
```

```cpp
#include <hip/hip_runtime.h>
#include <stdint.h>
#include <stdio.h>

#define DEV __device__ __forceinline__
typedef unsigned short bf16_t;
typedef short bf16x8 __attribute__((ext_vector_type(8)));
typedef short s16x4 __attribute__((ext_vector_type(4)));
typedef float f32x4 __attribute__((ext_vector_type(4)));
typedef float f32x2 __attribute__((ext_vector_type(2)));
typedef float f32x16 __attribute__((ext_vector_type(16)));
typedef unsigned u32x4 __attribute__((ext_vector_type(4)));
typedef unsigned u32x2 __attribute__((ext_vector_type(2)));

constexpr int DM = 2048, NBATCH = 4, SEQ = 4096, CTX = 256, KEYS = CTX + SEQ;
constexpr int NLAT = NBATCH * SEQ, NCTX = NBATCH * CTX, NROW = NLAT + NCTX;
constexpr int NH = 8, QRANK = 512, KVRANK = 256, ROPE = 64, QK = 192, DV = 128, DK = 128;
constexpr int INC = 5952, INCP = 6144;
constexpr int NE = 32, TOPK = 4, DFF = 2048;
constexpr int MAXSLOT = 65536 + NE * 256;
constexpr int MAXTILES = MAXSLOT / 256;
constexpr int CNT_LD = 64;
constexpr int NT = 512;
constexpr float EPS = 1e-6f;
constexpr int FP8_WSCALE_LOG2_ = 6;

struct Params {
  const float *x, *c, *ctx, *c_ctx, *w_mod, *b_mod, *ln_mix_pre, *ln_mix_post, *ln_ffn_pre, *ln_ffn_post, *w_in, *q_norm, *kv_norm, *w_uq, *w_ukv, *hgrn_lb, *g_norm, *w_out,
      *router_w, *router_b, *w_gu, *b_gu, *w_dn, *b_dn;
  float* out;
  bf16_t *wt_in, *wt_uq, *wt_ukv, *wt_out;
  unsigned char *wt_gu8, *wt_dn8;
  unsigned char *h2_8, *act8;
  float* mod;
  float* rope;
  bf16_t* h;
  bf16_t *cq, *cqn;
  bf16_t *ckv, *ckvn;
  float* kr;
  bf16_t* qh;
  float *gf, *gb;
  bf16_t* vh;
  bf16_t* gate;
  bf16_t *qf, *kf, *vf;
  bf16_t* aout;
  bf16_t *of, *ob;
  bf16_t* mix;
  bf16_t* x1;
  int *tok_e, *tok_pos;
  float* tok_gate;
  int* cnt;
  int* idx;
  unsigned char* ys8;
  unsigned* bar;
};

DEV int ltid() { int t = threadIdx.x; asm volatile("" : "+v"(t)); return t; }
typedef const __attribute__((address_space(4))) Params CParams;
DEV CParams* launder(CParams* p) { asm volatile("" : "+s"(p)); return p; }
#define KARGS ((CParams*)__builtin_amdgcn_kernarg_segment_ptr())
typedef __bf16 bf16n2 __attribute__((ext_vector_type(2)));
DEV unsigned cvt_pk_bf16(float lo, float hi) { const f32x2 v = {lo, hi}; const bf16n2 r = __builtin_convertvector(v, bf16n2); return __builtin_bit_cast(unsigned, r); }
DEV unsigned cvt_pk4_fp8(f32x4 v) { unsigned r = 0; r = __builtin_amdgcn_cvt_pk_fp8_f32(v[0], v[1], r, false); r = __builtin_amdgcn_cvt_pk_fp8_f32(v[2], v[3], r, true); return r; }
DEV float bf2f(bf16_t v) { return __uint_as_float(((unsigned)v) << 16); }
DEV float bflo(unsigned v) { return __uint_as_float(v << 16); }
DEV float bfhi(unsigned v) { return __uint_as_float(v & 0xffff0000u); }
DEV bf16_t f2bf(float f) { const __bf16 r = (__bf16)f; return __builtin_bit_cast(bf16_t, r); }
DEV float wave_sum(float v) {
#pragma unroll
  for (int o = 32; o > 0; o >>= 1) v += __shfl_xor(v, o);
  return v;
}
DEV float sigmoidf_(float v) { return __builtin_amdgcn_rcpf(1.f + __builtin_amdgcn_exp2f(-1.4426950408889634f * v)); }
DEV float siluf_(float v) { return v * __builtin_amdgcn_rcpf(1.f + __builtin_amdgcn_exp2f(-1.4426950408889634f * v)); }

DEV void mod_unit(CParams& p, int u) {
  extern __shared__ __attribute__((aligned(16))) char shm[];
  float* sc = (float*)shm;
  float* red = (float*)(shm + 5 * 2048 * 4);
  const int tid = ltid(), wid = tid >> 6, lane = tid & 63, cl = lane & 15, kr = lane >> 4;
  for (int i = tid; i < 5 * 2048; i += NT) { const int v = i >> 11, k = i & 2047; const float cv = v < 4 ? p.c[v * 2048 + k] : p.c_ctx[k]; sc[i] = siluf_(cv); }
  __syncthreads();
  f32x4 acc[5];
#pragma unroll
  for (int v = 0; v < 5; ++v) acc[v] = (f32x4){0.f, 0.f, 0.f, 0.f};
  const float* wp = p.w_mod + (long)(wid * 256 + kr) * 12288 + u * 64 + cl * 4;
  const float* sp = sc + wid * 256 + kr;
#pragma unroll 1
  for (int k = 0; k < 256; k += 32) {
    f32x4 w[8];
#pragma unroll
    for (int j = 0; j < 8; ++j) w[j] = *(const f32x4*)(wp + (long)(k + 4 * j) * 12288);
#pragma unroll
    for (int j = 0; j < 8; ++j)
#pragma unroll
      for (int v = 0; v < 5; ++v) { const float s = sp[v * 2048 + k + 4 * j]; acc[v] += w[j] * s; }
  }
#pragma unroll
  for (int v = 0; v < 5; ++v)
#pragma unroll
    for (int j = 0; j < 4; ++j) { float a = acc[v][j]; a += __shfl_xor(a, 16); a += __shfl_xor(a, 32); acc[v][j] = a; }
  if (kr == 0) {
#pragma unroll
    for (int v = 0; v < 5; ++v) *(f32x4*)(red + (wid * 5 + v) * 64 + cl * 4) = acc[v];
  }
  __syncthreads();
  if (tid < 5 * 64) {
    const int v = tid >> 6, cc = tid & 63; float s = p.b_mod[u * 64 + cc];
#pragma unroll
    for (int w = 0; w < 8; ++w) s += red[(w * 5 + v) * 64 + cc];
    p.mod[v * 12288 + u * 64 + cc] = s;
  }
  __syncthreads();
}

DEV int perm_row(int perm, int n) {
  if (perm == 1) return n < 832 ? n : n + 192;
  if (perm == 2) { const int lin = n >= 2048 ? 1 : 0, j = n - lin * 2048; return (j >> 7) * 256 + lin * 128 + (j & 127); }
  return n;
}
struct CvtDesc { const float* src; void* dst; int ldsrc, N, lddst, k0, n0, perm, fp8; };
constexpr int U_MOD = 192, U_ROPE = 16;
constexpr int U_GU = NE * 16 * 32, U_DN = NE * 16 * 16, U_IN = 16 * 47, U_OUT = 16 * 16, U_UQ = 4 * 12, U_UKV = 2 * 16;
constexpr int U_CVT = U_GU + U_DN + U_IN + U_OUT + U_UQ + U_UKV;
DEV CvtDesc cvt_decode(CParams& p, int u) {
  CvtDesc d;
  if (u < U_GU) { const int e = u >> 9, r = u & 511, kt = r >> 5, nt = r & 31;
    d.src = p.w_gu + (long)e * 2048 * 4096; d.ldsrc = 4096; d.N = 4096; d.dst = p.wt_gu8 + (long)e * 4096 * 2048; d.lddst = 2048; d.k0 = kt * 128; d.n0 = nt * 128; d.perm = 2; d.fp8 = 1; return d; }
  u -= U_GU;
  if (u < U_DN) { const int e = u >> 8, r = u & 255, kt = r >> 4, nt = r & 15;
    d.src = p.w_dn + (long)e * 2048 * 2048; d.ldsrc = 2048; d.N = 2048; d.dst = p.wt_dn8 + (long)e * 2048 * 2048; d.lddst = 2048; d.k0 = kt * 128; d.n0 = nt * 128; d.perm = 0; d.fp8 = 1; return d; }
  u -= U_DN;
  if (u < U_IN) { const int kt = u / 47, nt = u % 47; d.src = p.w_in; d.ldsrc = INC; d.N = INC; d.dst = p.wt_in; d.lddst = 2048; d.k0 = kt * 128; d.n0 = nt * 128; d.perm = 1; d.fp8 = 0; return d; }
  u -= U_IN;
  if (u < U_OUT) { const int kt = u >> 4, nt = u & 15; d.src = p.w_out; d.ldsrc = 2048; d.N = 2048; d.dst = p.wt_out; d.lddst = 2048; d.k0 = kt * 128; d.n0 = nt * 128; d.perm = 0; d.fp8 = 0; return d; }
  u -= U_OUT;
  if (u < U_UQ) { const int kt = u / 12, nt = u % 12; d.src = p.w_uq; d.ldsrc = 1536; d.N = 1536; d.dst = p.wt_uq; d.lddst = 512; d.k0 = kt * 128; d.n0 = nt * 128; d.perm = 0; d.fp8 = 0; return d; }
  u -= U_UQ;
  { const int kt = u >> 4, nt = u & 15; d.src = p.w_ukv; d.ldsrc = 2048; d.N = 2048; d.dst = p.wt_ukv; d.lddst = 256; d.k0 = kt * 128; d.n0 = nt * 128; d.perm = 0; d.fp8 = 0; }
  return d;
}
DEV void cvt_load(const CvtDesc& d, f32x4 (&ld)[8]) {
  const int tid = ltid(), tx = tid & 31, ty = tid >> 5;
  const bool ok = (d.n0 + 4 * tx) < d.N;
#pragma unroll
  for (int x = 0; x < 8; ++x) {
    const int row = d.fp8 ? 4 * (ty + 16 * (x >> 2)) + (x & 3) : 2 * (ty + 16 * (x >> 1)) + (x & 1);
    const float* sp = d.src + (long)(d.k0 + row) * d.ldsrc + d.n0 + 4 * tx;
    ld[x] = ok ? __builtin_nontemporal_load((const f32x4*)sp) : (f32x4){0.f, 0.f, 0.f, 0.f};
  }
}
DEV void cvt_store(const CvtDesc& d, const f32x4 (&ld)[8]) {
  extern __shared__ __attribute__((aligned(16))) char shm[];
  unsigned* T = (unsigned*)shm;
  const int tid = ltid(), tx = tid & 31, ty = tid >> 5;
  if (d.fp8) {
    constexpr float WS = (float)(1 << FP8_WSCALE_LOG2_);
#pragma unroll
    for (int i = 0; i < 2; ++i) {
      const int q = ty + 16 * i;
#pragma unroll
      for (int j = 0; j < 4; ++j) T[(4 * tx + j) * 33 + q] = cvt_pk4_fp8((f32x4){ld[4 * i][j] * WS, ld[4 * i + 1][j] * WS, ld[4 * i + 2][j] * WS, ld[4 * i + 3][j] * WS});
    }
    __syncthreads();
#pragma unroll
    for (int j = 0; j < 2; ++j) {
      const int id = tid + NT * j, nl = id >> 3, cc = id & 7, n = d.n0 + nl;
      u32x4 v; v.x = T[nl * 33 + 4 * cc]; v.y = T[nl * 33 + 4 * cc + 1]; v.z = T[nl * 33 + 4 * cc + 2]; v.w = T[nl * 33 + 4 * cc + 3];
      if (n < d.N) *(u32x4*)((unsigned char*)d.dst + (long)perm_row(d.perm, n) * d.lddst + d.k0 + 16 * cc) = v;
    }
  } else {
#pragma unroll
    for (int i = 0; i < 4; ++i) {
      const int q = ty + 16 * i;
#pragma unroll
      for (int j = 0; j < 4; ++j) T[(4 * tx + j) * 65 + q] = cvt_pk_bf16(ld[2 * i][j], ld[2 * i + 1][j]);
    }
    __syncthreads();
#pragma unroll
    for (int j = 0; j < 4; ++j) {
      const int id = tid + NT * j, nl = id >> 4, cc = id & 15, n = d.n0 + nl;
      u32x4 v; v.x = T[nl * 65 + 4 * cc]; v.y = T[nl * 65 + 4 * cc + 1]; v.z = T[nl * 65 + 4 * cc + 2]; v.w = T[nl * 65 + 4 * cc + 3];
      if (n < d.N) *(u32x4*)((bf16_t*)d.dst + (long)perm_row(d.perm, n) * d.lddst + d.k0 + 8 * cc) = v;
    }
  }
  __syncthreads();
}
constexpr int FILL_LDS_OFF = 133120, FILL_TB = 128 * 17 * 4;
constexpr int FILL_HALVES = 2 * (NE * 16 * 32 + NE * 16 * 16);
#ifndef FILL_HG
#define FILL_HG 67
#endif
#ifndef FILL_A0
#define FILL_A0 63
#endif
#ifndef FILL_A1
#define FILL_A1 62
#endif
constexpr int FILL_SLOTS = FILL_HG + FILL_A0 + FILL_A1;
static_assert(FILL_HG <= 67 && FILL_A0 <= 68 && FILL_A1 <= 68 && FILL_SLOTS * 256 <= FILL_HALVES, "filler split");
struct FillDesc { const float* src; unsigned char* dst; int ldsrc, perm, n0, kh; };
DEV FillDesc fill_decode(CParams& p, int wg, int slot) {
  const int h = slot * 256 + wg, t = h >> 1, half = h & 1; FillDesc d;
  if (t < NE * 512) { const int e = t >> 9, r = t & 511; d.src = p.w_gu + (long)e * 2048 * 4096; d.ldsrc = 4096; d.dst = p.wt_gu8 + (long)e * 4096 * 2048; d.perm = 2; d.n0 = (r & 31) * 128 + 64 * half; d.kh = (r >> 5) * 128; }
  else { const int v = t - NE * 512, e = v >> 8, r = v & 255; d.src = p.w_dn + (long)e * 2048 * 2048; d.ldsrc = 2048; d.dst = p.wt_dn8 + (long)e * 2048 * 2048; d.perm = 0; d.n0 = (r & 15) * 128 + 64 * half; d.kh = (r >> 4) * 128; }
  return d;
}
DEV void fill_load(CParams& p, int wg, int slot, f32x4 (&ld)[4]) {
  const FillDesc d = fill_decode(p, wg, slot); const int tid = ltid(), tx = tid & 15, ty = tid >> 4;
  const float* sp = d.src + (long)(d.kh + 4 * ty) * d.ldsrc + d.n0 + 4 * tx;
#pragma unroll
  for (int r = 0; r < 4; ++r) ld[r] = *(const f32x4*)(sp + (long)r * d.ldsrc);
}
DEV void fill_write(const f32x4 (&ld)[4], int bufsel) {
  extern __shared__ __attribute__((aligned(16))) char shm[];
  unsigned* T = (unsigned*)(shm + FILL_LDS_OFF + bufsel * FILL_TB); const int tid = ltid(), tx = tid & 15, ty = tid >> 4;
  constexpr float WS = (float)(1 << FP8_WSCALE_LOG2_);
#pragma unroll
  for (int j = 0; j < 4; ++j) T[(4 * tx + j) * 33 + ty] = cvt_pk4_fp8((f32x4){ld[0][j] * WS, ld[1][j] * WS, ld[2][j] * WS, ld[3][j] * WS});
}
DEV void fill_store(CParams& p, int wg, int slot, int bufsel) {
  extern __shared__ __attribute__((aligned(16))) char shm[];
  const unsigned* T = (const unsigned*)(shm + FILL_LDS_OFF + bufsel * FILL_TB); const int tid = ltid(), nl = tid >> 3, cc = tid & 7;
  const FillDesc d = fill_decode(p, wg, slot);
  u32x4 v; v.x = T[nl * 33 + 4 * cc]; v.y = T[nl * 33 + 4 * cc + 1]; v.z = T[nl * 33 + 4 * cc + 2]; v.w = T[nl * 33 + 4 * cc + 3];
  *(u32x4*)(d.dst + (long)perm_row(d.perm, d.n0 + nl) * 2048 + d.kh + 16 * cc) = v;
}
DEV void rope_unit(CParams& p, int u) {
  for (int i = ltid(); i < 256 * 32; i += NT) {
    const int t = u * 256 + (i >> 5), a = i & 31; const int fi = a & 15;
    const float inv = powf(10000.0f, -(float)fi / 16.0f);
    const float pos = a < 16 ? (float)(t >> 6) : (float)(t & 63);
    const float ang = pos * inv; float s, c; sincosf(ang, &s, &c);
    p.rope[t * 64 + a] = c; p.rope[t * 64 + 32 + a] = s;
  }
}
DEV void phase0(CParams& p, int wg, int nwg) {
  if (wg < U_MOD) mod_unit(p, wg); else if (wg < U_MOD + U_ROPE) rope_unit(p, wg - U_MOD);
  if (nwg < U_MOD + U_ROPE) { for (int u = wg + nwg; u < U_MOD + U_ROPE; u += nwg) { if (u < U_MOD) mod_unit(p, u); else rope_unit(p, u - U_MOD); } }
  f32x4 ld[8], ld2[8];
  int u = (nwg == 256 ? FILL_SLOTS * 128 : 0) + wg;
  if (u < U_CVT) { const CvtDesc d = cvt_decode(p, u); cvt_load(d, ld); }
  for (; u < U_CVT; u += nwg) {
    const CvtDesc d = cvt_decode(p, u);
    const int un = u + nwg;
    if (un < U_CVT) { const CvtDesc dn = cvt_decode(p, un); cvt_load(dn, ld2); }
    cvt_store(d, ld);
#pragma unroll
    for (int i = 0; i < 8; ++i) ld[i] = ld2[i];
  }
}

DEV void phase1_rows(CParams& p, int wg, int nwg) {
  const int wid = ltid() >> 6, lane = ltid() & 63;
  for (int row = wg * 8 + wid; row < NROW; row += nwg * 8) {
    const float* xr; int v;
    if (row < NCTX) { xr = p.ctx + (long)row * DM; v = 4; } else { xr = p.x + (long)(row - NCTX) * DM; v = (row - NCTX) >> 12; }
    const float* sh = p.mod + v * 12288; const float* sc = sh + 2048;
    f32x4 xv[8]; float ss = 0.f;
#pragma unroll
    for (int i = 0; i < 8; ++i) { xv[i] = *(const f32x4*)(xr + i * 256 + lane * 4); ss += xv[i][0] * xv[i][0] + xv[i][1] * xv[i][1] + xv[i][2] * xv[i][2] + xv[i][3] * xv[i][3]; }
    ss = wave_sum(ss);
    const float rstd = rsqrtf(ss * (1.f / DM) + EPS);
#pragma unroll
    for (int i = 0; i < 8; ++i) {
      const int c0 = i * 256 + lane * 4;
      const f32x4 w = *(const f32x4*)(p.ln_mix_pre + c0), s1 = *(const f32x4*)(sc + c0), s0 = *(const f32x4*)(sh + c0);
      f32x4 y;
#pragma unroll
      for (int j = 0; j < 4; ++j) y[j] = xv[i][j] * rstd * w[j] * (1.f + s1[j]) + s0[j];
      u32x2 o; o.x = cvt_pk_bf16(y[0], y[1]); o.y = cvt_pk_bf16(y[2], y[3]);
      *(u32x2*)(p.h + (long)row * DM + c0) = o;
    }
  }
}
#define LAS __attribute__((address_space(3)))
constexpr int BM = 256, BK = 64, HALF = 128, HTB = HALF * BK * 2, GEMM_LDS = 8 * HTB;
constexpr int GEMM_AROW_OFF = GEMM_LDS;
constexpr int GEMM_BIAS_OFF = ((GEMM_AROW_OFF + 2 * 256 * 4 + (3 * MAXTILES + 2) * 4 + 15) / 16) * 16 + 2 * 9216;
DEV int lds_byte(int r, int c) { const int st = (r >> 4) * 2 + (c >> 5), rr = r & 15, cc = c & 31, ob = rr * 64 + cc * 2; return st * 1024 + (ob ^ (((ob >> 9) & 1) << 5)); }
DEV void stage_rc(int b, int& R, int& C) { const int st = b / 1024, sb = b % 1024, swz = sb ^ (((sb >> 9) & 1) << 5); R = (st >> 1) * 16 + swz / 64; C = (st & 1) * 32 + (swz % 64) / 2; }
typedef f32x4 AccT[2][2][4][2];
struct Unit { int pm, pn, e, r0, rv; };
typedef int i32x8 __attribute__((ext_vector_type(8)));
typedef int i32x4 __attribute__((ext_vector_type(4)));
DEV int g8(int r) { const int q = ((r & 15) >> 1) + 2; return 2 * (q & 3) + 1 - ((q >> 2) & 1); }
constexpr int FP8_WSCALE_LOG2 = FP8_WSCALE_LOG2_;
constexpr int FP8_SCALE_W = 0x01010101 * (127 - FP8_WSCALE_LOG2), FP8_SCALE_1 = 0x7f7f7f7f;

DEV void mfma_fp8(f32x4& acc, const i32x8& w, const i32x8& a, int sw, int sa) {
  asm volatile("v_mfma_scale_f32_16x16x128_f8f6f4 %0, %1, %2, %0, %3, %4 op_sel_hi:[0,0,0]" : "+v"(acc) : "v"(w), "v"(a), "v"(sw), "v"(sa));
}
template <class P>
DEV void gemm_stream(const P& pol) {
  extern __shared__ __attribute__((aligned(16))) char shm[];
  LAS unsigned char* lds = (LAS unsigned char*)shm;
  LAS int* arow = (LAS int*)(shm + GEMM_AROW_OFF);
  const int tid = ltid(), wid = __builtin_amdgcn_readfirstlane(tid >> 6), lane = tid & 63, wr = wid >> 2, wc = wid & 3, fr = lane & 15, fq = lane >> 4;
  const int KB = pol.KB, nt = KB / 128;
  Unit cur, nxt; int ui = 0;
  if (!pol.get(0, cur)) return;
  unsigned voffB[2], vAc[2][2];
#define G_SRC(i_, R_, C_) do { const int b_ = ltid() * 16 + (i_) * 8192; if (P::FP8) { R_ = b_ >> 7; C_ = (((b_ >> 4) & 7) ^ g8(R_)) << 4; } else { stage_rc(b_, R_, C_); C_ *= 2; } } while (0)
#define G_GATHER_OFFS(tab_, rv_) do { _Pragma("unroll") for (int i = 0; i < 2; ++i) { int R_, C_; G_SRC(i, R_, C_); const int ra_ = (tab_)[R_], rb_ = (tab_)[HALF + R_];        \
    vAc[0][i] = (unsigned)((R_ < (rv_) ? ra_ : 0) * KB + C_); vAc[1][i] = (unsigned)((HALF + R_ < (rv_) ? rb_ : 0) * KB + C_); } } while (0)
#pragma unroll
  for (int i = 0; i < 2; ++i) { int R_, C_; G_SRC(i, R_, C_); const int rho = R_ & 31, Rb = (R_ & ~31) + 8 * ((rho & 15) >> 2) + 4 * (rho >> 4) + (rho & 3); voffB[i] = (unsigned)(Rb * KB + C_); }
  if (P::GATHER) {
    pol.arow_fill(cur, (int*)(shm + GEMM_AROW_OFF));
    __syncthreads();
    G_GATHER_OFFS(arow, cur.rv);
  } else {
#pragma unroll
    for (int i = 0; i < 2; ++i) { int R_, C_; G_SRC(i, R_, C_); vAc[0][i] = (unsigned)(R_ * KB + C_); vAc[1][i] = vAc[0][i]; }
  }
  const size_t kstep = 128, hstep = (size_t)HALF * KB;
  const unsigned ldsw = (unsigned)wid * 1024u;
  const int aoff = P::FP8 ? (wr * 64 + fr) * 128 + (((2 * fq) ^ g8(fr)) << 4) : lds_byte(wr * 64 + fr, fq * 8);
  const int boff = P::FP8 ? (wc * 32 + fr) * 128 + (((2 * fq) ^ g8(fr)) << 4) : lds_byte(wc * 32 + fr, fq * 8);
  const int aoff1 = (wr * 64 + fr) * 128 + (((2 * fq + 1) ^ g8(fr)) << 4), boff1 = (wc * 32 + fr) * 128 + (((2 * fq + 1) ^ g8(fr)) << 4);
#define G_SA(b, h) (((b) * 2 + (h)) * HTB)
#define G_SB(b, h) ((4 + (b) * 2 + (h)) * HTB)
#define G_STAGE(bufoff, gbase, voff) do { _Pragma("unroll") for (int _i = 0; _i < 2; ++_i) \
    __builtin_amdgcn_global_load_lds((const unsigned*)((const char*)(gbase) + (voff)[_i]), (LAS unsigned*)(lds + (bufoff) + ldsw + _i * 8192), 16, 0, 0); } while (0)
#define G_LD2(o0, o1) __builtin_shufflevector(*(const LAS i32x4*)(lds + (o0)), *(const LAS i32x4*)(lds + (o1)), 0, 1, 2, 3, 4, 5, 6, 7)
#define G_LDA(dst, b, h) do { _Pragma("unroll") for (int m = 0; m < 4; ++m) dst[m] = G_LD2(G_SA(b, h) + aoff + m * 2048, G_SA(b, h) + (P::FP8 ? aoff1 : aoff + 1024) + m * 2048); } while (0)
#define G_LDB(dst, b, h) do { _Pragma("unroll") for (int n = 0; n < 2; ++n) dst[n] = G_LD2(G_SB(b, h) + boff + n * 2048, G_SB(b, h) + (P::FP8 ? boff1 : boff + 1024) + n * 2048); } while (0)
#define G_LO(x_) __builtin_bit_cast(bf16x8, __builtin_shufflevector(x_, x_, 0, 1, 2, 3))
#define G_HI(x_) __builtin_bit_cast(bf16x8, __builtin_shufflevector(x_, x_, 4, 5, 6, 7))
#define G_MMA(ai, bj, At_, Bt_) do { if (P::ROWSKIP && rvw <= 128 * (ai)) break;        \
    __builtin_amdgcn_s_setprio(1); _Pragma("unroll") for (int m = 0; m < 4; ++m) _Pragma("unroll") for (int n = 0; n < 2; ++n) { \
    if (P::FP8) mfma_fp8(acc[ai][bj][m][n], Bt_[n], At_[m], sclw, scla); \
    else { acc[ai][bj][m][n] = __builtin_amdgcn_mfma_f32_16x16x32_bf16(G_LO(Bt_[n]), G_LO(At_[m]), acc[ai][bj][m][n], 0, 0, 0); \
           acc[ai][bj][m][n] = __builtin_amdgcn_mfma_f32_16x16x32_bf16(G_HI(Bt_[n]), G_HI(At_[m]), acc[ai][bj][m][n], 0, 0, 0); } } \
    __builtin_amdgcn_s_setprio(0); } while (0)
#define G_ZERO() do { _Pragma("unroll") for (int a_ = 0; a_ < 2; ++a_) _Pragma("unroll") for (int b_ = 0; b_ < 2; ++b_) _Pragma("unroll") for (int m_ = 0; m_ < 4; ++m_) _Pragma("unroll") for (int n_ = 0; n_ < 2; ++n_) \
    acc[a_][b_][m_][n_] = (f32x4){0.f, 0.f, 0.f, 0.f}; } while (0)
#define WAIT_V(n) asm volatile("s_waitcnt vmcnt(" #n ")" ::: "memory")
#define WAIT_L(n) asm volatile("s_waitcnt lgkmcnt(" #n ")" ::: "memory")
#define BAR __builtin_amdgcn_s_barrier()
#define SCHED __builtin_amdgcn_sched_barrier(0)
  int sclw = P::SCALE_B, scla = P::SCALE_A;
  f32x4 acc[2][2][4][2];
  f32x4 bv[2][2];
  LAS float* btab = (LAS float*)(shm + GEMM_BIAS_OFF);
#define G_BIAS(tab_) do { _Pragma("unroll") for (int b_ = 0; b_ < 2; ++b_) _Pragma("unroll") for (int n_ = 0; n_ < 2; ++n_) { bv[b_][n_] = *(const LAS f32x4*)((tab_) + 128 * b_ + 32 * wc + 8 * fq + 4 * n_); \
    if (b_ == 1 && P::BIAS_LIN1) bv[b_][n_] = bv[b_][n_] + 1.0f; } } while (0)
#define G_INIT() do { _Pragma("unroll") for (int a_ = 0; a_ < 2; ++a_) _Pragma("unroll") for (int b_ = 0; b_ < 2; ++b_) _Pragma("unroll") for (int m_ = 0; m_ < 4; ++m_) _Pragma("unroll") for (int n_ = 0; n_ < 2; ++n_) \
    acc[a_][b_][m_][n_] = bv[b_][n_]; } while (0)
  if (P::HASBIAS) { pol.bias_fill(cur, (float*)(shm + GEMM_BIAS_OFF)); __syncthreads(); G_BIAS(btab); G_INIT(); } else G_ZERO();
  i32x8 At[4], B0[2], B1[2];
  int rvw = P::ROWSKIP ? cur.rv - 64 * wr : 256;
  const char* cA0 = pol.abase(cur, 0); const char* cA1 = pol.abase(cur, 1); const char* cB = pol.bbase(cur);
  G_STAGE(G_SB(0, 0), cB, voffB); G_STAGE(G_SA(0, 0), cA0, vAc[0]); G_STAGE(G_SB(0, 1), cB + hstep, voffB); G_STAGE(G_SA(0, 1), cA1, vAc[1]);
  if (wr == 1) BAR;
  WAIT_V(4); BAR;
  G_STAGE(G_SB(1, 0), cB + kstep, voffB); G_STAGE(G_SA(1, 0), cA0 + kstep, vAc[0]); G_STAGE(G_SB(1, 1), cB + hstep + kstep, voffB);
  WAIT_V(6); BAR;
  for (;;) {
    const bool has_next = pol.get(ui + 1, nxt);
    const char* nA0 = has_next ? pol.abase(nxt, 0) : cA0; const char* nA1 = has_next ? pol.abase(nxt, 1) : cA1; const char* nB = has_next ? pol.bbase(nxt) : cB;
    for (int t = 0; t < nt; t += 2) {
      const bool last = (t == nt - 2);
      const size_t k1 = (size_t)(t + 1) * kstep, k2 = (size_t)(t + 2) * kstep;
      const char* a20 = last ? nA0 : cA0 + k2; const char* a21 = last ? nA1 : cA1 + k2; const char* b2 = last ? nB : cB + k2;
      G_LDB(B0, 0, 0); SCHED; G_LDA(At, 0, 0); G_STAGE(G_SA(1, 1), cA1 + k1, vAc[1]);
      WAIT_L(8); BAR; WAIT_L(0); G_MMA(0, 0, At, B0); BAR; SCHED;
      if (P::GATHER && last && has_next) { LAS int* tab = arow + ((ui + 1) & 1) * 256; G_GATHER_OFFS(tab, nxt.rv); }
      G_LDB(B1, 0, 1); G_STAGE(G_SB(0, 0), b2, voffB);
      BAR; WAIT_L(0); G_MMA(0, 1, At, B1); BAR;
      G_LDA(At, 0, 1); G_STAGE(G_SA(0, 0), a20, vAc[0]);
      BAR; WAIT_L(0); G_MMA(1, 0, At, B0); BAR; SCHED;
      G_STAGE(G_SB(0, 1), b2 + hstep, voffB);
      WAIT_V(6); BAR; G_MMA(1, 1, At, B1); BAR;
      G_LDB(B0, 1, 0); SCHED; G_LDA(At, 1, 0); G_STAGE(G_SA(0, 1), a21, vAc[1]);
      WAIT_L(8); BAR; WAIT_L(0); G_MMA(0, 0, At, B0); BAR; SCHED;
      G_LDB(B1, 1, 1); G_STAGE(G_SB(1, 0), b2 + kstep, voffB);
      BAR; WAIT_L(0); G_MMA(0, 1, At, B1); BAR;
      G_LDA(At, 1, 1); G_STAGE(G_SA(1, 0), a20 + kstep, vAc[0]);
      BAR; WAIT_L(0); G_MMA(1, 0, At, B0); BAR; SCHED;
      G_STAGE(G_SB(1, 1), b2 + hstep + kstep, voffB);
      WAIT_V(6); BAR; G_MMA(1, 1, At, B1); BAR;
      if (P::HASBIAS && has_next && t == 0) pol.bias_dma(nxt, btab + ((ui + 1) & 1) * 256 + ((wid & 3) << 6));
      if (P::GATHER && has_next && t == 0) pol.arow_dma(nxt, arow + ((ui + 1) & 1) * 256 + ((wid & 3) << 6));
    }
    if (P::FP8) asm volatile("s_nop 7\n\ts_nop 7" ::: "memory");
    pol.epi(cur, acc, wr, wc, fr, fq);
    if (!has_next) break;
    if (P::HASBIAS) { G_BIAS(btab + ((ui + 1) & 1) * 256); G_INIT(); } else G_ZERO();
    cur = nxt; cA0 = nA0; cA1 = nA1; cB = nB; ++ui;
    if (P::ROWSKIP) rvw = cur.rv - 64 * wr;
  }
  WAIT_V(0);
  if (wr == 0) BAR;
  __syncthreads();
#undef G_SA
#undef G_SB
#undef G_STAGE
#undef G_LDA
#undef G_LDB
#undef G_MMA
#undef G_LD2
#undef G_SRC
#undef G_GATHER_OFFS
#undef G_LO
#undef G_HI
#undef G_ZERO
#undef G_INIT
#undef G_BIAS
}

constexpr int MOE_TAB_OFF_ = GEMM_AROW_OFF + 2 * 256 * 4;
DEV void st_bf16x4(bf16_t* p, f32x4 v) { u32x2 o; o.x = cvt_pk_bf16(v[0], v[1]); o.y = cvt_pk_bf16(v[2], v[3]); *(u32x2*)p = o; }
DEV void st_bf16x8(bf16_t* p, f32x4 a, f32x4 b) { u32x4 o; o.x = cvt_pk_bf16(a[0], a[1]); o.y = cvt_pk_bf16(a[2], a[3]); o.z = cvt_pk_bf16(b[0], b[1]); o.w = cvt_pk_bf16(b[2], b[3]); *(u32x4*)p = o; }
DEV void st_fp8x8(unsigned char* p, f32x4 a, f32x4 b) { u32x2 o; o.x = cvt_pk4_fp8(a); o.y = cvt_pk4_fp8(b); *(u32x2*)p = o; }

DEV f32x4 sig4(f32x4 v) {
  const f32x4 t = v * -1.4426950408889634f; f32x4 e;
#pragma unroll
  for (int j = 0; j < 4; ++j) e[j] = __builtin_amdgcn_exp2f(t[j]);
  e = e + 1.0f; f32x4 r;
#pragma unroll
  for (int j = 0; j < 4; ++j) r[j] = __builtin_amdgcn_rcpf(e[j]);
  return r;
}
struct EpiIn {
  CParams* p; int pm, pn;
  template <int KIND> DEV void run(const AccT& acc, int wr, int wc, int fr, int fq) const;
  DEV void operator()(const AccT& acc, int wr, int wc, int fr, int fq) const {
    if (pn < 2) run<0>(acc, wr, wc, fr, fq); else if (pn == 2) run<1>(acc, wr, wc, fr, fq); else if (pn == 3) run<2>(acc, wr, wc, fr, fq);
    else if (pn < 8 || pn >= 20) run<3>(acc, wr, wc, fr, fq); else if (pn < 16) run<4>(acc, wr, wc, fr, fq); else run<5>(acc, wr, wc, fr, fq);
  }
};
DEV void row_to_bkey(int row, int& b, int& key) { if (row < NCTX) { b = row >> 8; key = row & 255; } else { const int r = row - NCTX; b = r >> 12; key = CTX + (r & 4095); } }

struct EpiKV {
  CParams* p; int pm, pn;
  DEV void operator()(const AccT& acc, int wr, int wc, int fr, int fq) const {
    CParams& P = *launder(p); const int row0 = pm * BM + wr * 64 + fr;
#pragma unroll
    for (int ai = 0; ai < 2; ++ai)
#pragma unroll
      for (int m = 0; m < 4; ++m) {
        const int row = row0 + ai * HALF + m * 16; int b, key; row_to_bkey(row, b, key);
        const long bh = (long)(b * NH + pn) * KEYS + key; const int c = wc * 32 + 8 * fq;
        st_bf16x8(P.kf + bh * QK + c, acc[ai][0][m][0], acc[ai][0][m][1]);
        st_bf16x8(P.vf + bh * DV + c, acc[ai][1][m][0], acc[ai][1][m][1]);
      }
  }
};
struct EpiQ {
  CParams* p; int pm, pn;
  DEV void operator()(const AccT& acc, int wr, int wc, int fr, int fq) const {
    CParams& P = *launder(p); const int row0 = pm * BM + wr * 64 + fr;
#pragma unroll
    for (int ai = 0; ai < 2; ++ai)
#pragma unroll
      for (int m = 0; m < 4; ++m) {
        const int row = row0 + ai * HALF + m * 16, b = row >> 12, t = row & 4095;
#pragma unroll
        for (int bj = 0; bj < 2; ++bj) {
          const int col = pn * 256 + bj * HALF + wc * 32 + 8 * fq, hh = col / QK, e = col - hh * QK;
          st_bf16x8(P.qf + ((long)(b * NH + hh) * SEQ + t) * QK + e, acc[ai][bj][m][0], acc[ai][bj][m][1]);
        }
      }
  }
};
struct EpiOut {
  CParams* p; int pm, pn;
  DEV void operator()(const AccT& acc, int wr, int wc, int fr, int fq) const;
};
constexpr int STG_OFF = ((MOE_TAB_OFF_ + (3 * MAXTILES + 2) * 4 + 15) / 16) * 16, STG_HALF = 9216;
static_assert(GEMM_BIAS_OFF == STG_OFF + 2 * STG_HALF, "bias tables sit right behind the staging region");
template <int LB> DEV void stage_store_block(const unsigned (&v)[4][LB / 4], unsigned char* dst, long row_stride) {
  extern __shared__ __attribute__((aligned(16))) char shm[];
  constexpr int MP = LB == 8 ? 4 : (LB == 16 ? 2 : 1), PITCH = 16 * LB + 16, ROWS = 16 * MP;
  static_assert(ROWS * PITCH <= STG_HALF, "staging region");
  const int tid = ltid(), wr = tid >> 8, wc = (tid >> 6) & 3, fr = tid & 15, fq = (tid >> 4) & 3;
  char* stg = shm + STG_OFF + wr * STG_HALF;
  const int t4 = tid & 255;
#pragma unroll
  for (int ps = 0; ps < 4 / MP; ++ps) {
#pragma unroll
    for (int mm = 0; mm < MP; ++mm) {
      char* wp = stg + (16 * mm + fr) * PITCH + (4 * wc + fq) * LB; const int m = ps * MP + mm;
      if (LB == 8) *(u32x2*)wp = (u32x2){v[m][0], v[m][1]};
      else { *(u32x4*)wp = (u32x4){v[m][0], v[m][1], v[m][2], v[m][3]}; if (LB == 32) *(u32x4*)(wp + 16) = (u32x4){v[m][LB / 4 - 4], v[m][LB / 4 - 3], v[m][LB / 4 - 2], v[m][LB / 4 - 1]}; }
    }
    asm volatile("s_waitcnt lgkmcnt(0)" ::: "memory"); __builtin_amdgcn_s_barrier(); asm volatile("" ::: "memory");
#pragma unroll
    for (int k = 0; k < 2; ++k) { const int idx = k * 256 + t4, row = idx / LB, ch = idx % LB;
      *(u32x4*)(dst + (long)(ps * ROWS + row) * row_stride + ch * 16) = *(const u32x4*)(stg + row * PITCH + ch * 16); }
    asm volatile("s_waitcnt lgkmcnt(0)" ::: "memory"); __builtin_amdgcn_s_barrier(); asm volatile("" ::: "memory");
  }
}
DEV void pk_bf16x8(unsigned (&o)[4], f32x4 a, f32x4 b) { o[0] = cvt_pk_bf16(a[0], a[1]); o[1] = cvt_pk_bf16(a[2], a[3]); o[2] = cvt_pk_bf16(b[0], b[1]); o[3] = cvt_pk_bf16(b[2], b[3]); }
DEV void pk_f32x8(unsigned (&o)[8], f32x4 a, f32x4 b) {
#pragma unroll
  for (int j = 0; j < 4; ++j) { o[j] = __float_as_uint(a[j]); o[4 + j] = __float_as_uint(b[j]); } }
template <int KIND> DEV void EpiIn::run(const AccT& acc, int wr, int wc, int fr, int fq) const {
  CParams& P = *launder(p);
  const int rowh = pm * BM + wr * 64;
  if (KIND == 2) {
#pragma unroll
    for (int ai = 0; ai < 2; ++ai)
#pragma unroll
      for (int m = 0; m < 4; ++m) { const int row = rowh + fr + ai * HALF + m * 16, c = wc * 32 + 8 * fq;
        if (c < 64) { *(f32x4*)(P.kr + (long)row * ROPE + c) = acc[ai][0][m][0]; *(f32x4*)(P.kr + (long)row * ROPE + c + 4) = acc[ai][0][m][1]; } }
    return;
  }
  if (KIND == 0 && pm < 4) return;
  f32x4 lbv[2][2], oml[2][2];
  if (KIND == 4) {
    const int dir = (pn - 8) >> 2;
#pragma unroll
    for (int bj = 0; bj < 2; ++bj)
#pragma unroll
      for (int n = 0; n < 2; ++n) {
        const int col = ((pn - 8) & 3) * 256 + bj * HALF + wc * 32 + 8 * fq + 4 * n;
        const f32x4 a0 = *(const f32x4*)(P.hgrn_lb + dir * 2048 + col), a1 = *(const f32x4*)(P.hgrn_lb + dir * 2048 + 1024 + col);
#pragma unroll
        for (int j = 0; j < 4; ++j) lbv[bj][n][j] = sigmoidf_(a0[j] - a1[j]);
        oml[bj][n] = 1.0f - lbv[bj][n];
      }
  }
#pragma unroll
  for (int ai = 0; ai < 2; ++ai)
#pragma unroll
    for (int bj = 0; bj < 2; ++bj) {
      const long row = rowh + ai * HALF; const int cb = bj * HALF;
      if (KIND == 4) {
        unsigned vals[4][8];
#pragma unroll
        for (int m = 0; m < 4; ++m) pk_f32x8(vals[m], lbv[bj][0] + oml[bj][0] * sig4(acc[ai][bj][m][0]), lbv[bj][1] + oml[bj][1] * sig4(acc[ai][bj][m][1]));
        stage_store_block<32>(vals, (unsigned char*)(((pn - 8) >> 2 ? P.gb : P.gf) + row * 1024 + ((pn - 8) & 3) * 256 + cb), 1024 * 4);
      } else {
        unsigned vals[4][4];
#pragma unroll
        for (int m = 0; m < 4; ++m) {
          if (KIND == 3) pk_bf16x8(vals[m], acc[ai][bj][m][0] * sig4(acc[ai][bj][m][0]), acc[ai][bj][m][1] * sig4(acc[ai][bj][m][1]));
          else pk_bf16x8(vals[m], acc[ai][bj][m][0], acc[ai][bj][m][1]);
        }
        bf16_t* dst;
        if (KIND == 0) dst = P.cq + (row - NCTX) * QRANK + pn * 256 + cb;
        else if (KIND == 1) dst = P.ckv + row * KVRANK + cb;
        else if (KIND == 3) dst = (pn < 8 ? P.qh + (pn - 4) * 256 : P.gate + (pn - 20) * 256) + row * 1024 + cb;
        else dst = P.vh + row * 1024 + (pn - 16) * 256 + cb;
        stage_store_block<16>(vals, (unsigned char*)dst, (KIND == 0 ? QRANK : (KIND == 1 ? KVRANK : 1024)) * 2);
      }
    }
}
DEV void EpiOut::operator()(const AccT& acc, int wr, int wc, int fr, int fq) const {
  CParams& P = *launder(p);
#pragma unroll
  for (int ai = 0; ai < 2; ++ai)
#pragma unroll
    for (int bj = 0; bj < 2; ++bj) {
      unsigned vals[4][4];
#pragma unroll
      for (int m = 0; m < 4; ++m) pk_bf16x8(vals[m], acc[ai][bj][m][0], acc[ai][bj][m][1]);
      stage_store_block<16>(vals, (unsigned char*)(P.mix + (long)(pm * BM + ai * HALF + wr * 64) * DM + pn * 256 + bj * HALF), DM * 2);
    }
}
struct EpiGU {
  CParams* p; int e, srow0, pn;
  DEV static f32x4 act4(f32x4 g, f32x4 l) {
    constexpr float KS = -1.702f * 1.4426950408889634f;
    f32x4 a;
#pragma unroll
    for (int h2 = 0; h2 < 2; ++h2) {
      f32x2 gl, li1, sg;
      gl.x = fminf(g[2 * h2], 7.f); gl.y = fminf(g[2 * h2 + 1], 7.f);
      li1.x = fminf(fmaxf(l[2 * h2], -6.f), 8.f); li1.y = fminf(fmaxf(l[2 * h2 + 1], -6.f), 8.f);
      const f32x2 t = gl * KS;
      f32x2 d; d.x = __builtin_amdgcn_exp2f(t.x); d.y = __builtin_amdgcn_exp2f(t.y);
      d = d + 1.0f;
      sg.x = __builtin_amdgcn_rcpf(d.x); sg.y = __builtin_amdgcn_rcpf(d.y);
      const f32x2 r = (gl * sg) * li1;
      a[2 * h2] = r.x; a[2 * h2 + 1] = r.y;
    }
    return a;
  }
  DEV void operator()(const AccT& acc, int wr, int wc, int fr, int fq) const {
    CParams& P = *launder(p); const int row0 = srow0 + wr * 64 + fr;
    const int c = wc * 32 + 8 * fq;
#pragma unroll
    for (int ai = 0; ai < 2; ++ai) {
      unsigned vals[4][2];
#pragma unroll
      for (int m = 0; m < 4; ++m) { vals[m][0] = cvt_pk4_fp8(act4(acc[ai][0][m][0], acc[ai][1][m][0])); vals[m][1] = cvt_pk4_fp8(act4(acc[ai][0][m][1], acc[ai][1][m][1])); }
      stage_store_block<8>(vals, P.act8 + (long)(srow0 + ai * HALF + wr * 64) * DFF + pn * 128, DFF);
    }
  }
};
struct EpiDN {
  CParams* p; int e, srow0, pn;
  DEV void operator()(const AccT& acc, int wr, int wc, int fr, int fq) const {
    CParams& P = *launder(p); const int row0 = srow0 + wr * 64 + fr;
#pragma unroll
    for (int bj = 0; bj < 2; ++bj)
#pragma unroll
      for (int ai = 0; ai < 2; ++ai) {
        unsigned vals[4][2];
#pragma unroll
        for (int m = 0; m < 4; ++m) { vals[m][0] = cvt_pk4_fp8(acc[ai][bj][m][0]); vals[m][1] = cvt_pk4_fp8(acc[ai][bj][m][1]); }
        stage_store_block<8>(vals, P.ys8 + (long)(srow0 + ai * HALF + wr * 64) * DM + pn * 256 + bj * HALF, DM);
      }
  }
};

struct PolIn {
  static constexpr bool GATHER = false;
  static constexpr bool FP8 = false, HASBIAS = false, ROWSKIP = false, BIAS_LIN1 = false; static constexpr int SCALE_A = 0, SCALE_B = 0;
  CParams* p; const char* A; const char* B; int wg, nwg, KB, part;
  DEV bool get(int i, Unit& u) const {
    const int id = wg + i * nwg;
    if (part) { if (id >= 64) return false; u.pn = 23; u.pm = 4 + id; u.e = 0; u.r0 = 0; u.rv = 256; return true; }
    if (id >= 1528) return false;
    if (id < 1472) { u.pn = id >> 6; u.pm = 4 + (id & 63); } else { const int v = id - 1472, j = v >> 2; u.pm = v & 3; u.pn = j < 2 ? 2 + j : 6 + j; }
    u.e = 0; u.r0 = 0; u.rv = 256; return true; }
  DEV const char* abase(const Unit& u, int half) const { return A + (size_t)(u.pm * BM + half * HALF) * KB; }
  DEV const char* bbase(const Unit& u) const { return B + (size_t)(u.pn * BM) * KB; }
  DEV void arow_fill(const Unit&, int*) const {}
  DEV void arow_dma(const Unit&, LAS int*) const {}
  DEV void bias_fill(const Unit&, float*) const {}
  DEV void bias_dma(const Unit&, LAS float*) const {}
  DEV void epi(const Unit& u, const AccT& acc, int wr, int wc, int fr, int fq) const { EpiIn e{p, u.pm, u.pn}; e(acc, wr, wc, fr, fq); }
};
DEV void phase2_inproj(CParams& p, int wg, int nwg) { PolIn pol{&p, (const char*)p.h, (const char*)p.wt_in, wg, nwg, DM * 2, 0}; gemm_stream(pol); }

struct PolKV {
  static constexpr bool GATHER = false;
  static constexpr bool FP8 = false, HASBIAS = false, ROWSKIP = false, BIAS_LIN1 = false; static constexpr int SCALE_A = 0, SCALE_B = 0;
  CParams* p; const char* A; const char* B; int wg, nwg, KB;
  DEV bool get(int i, Unit& u) const { const int id = wg + i * nwg; if (id >= 68 * 8) return false; u.pn = id / 68; u.pm = id % 68; u.e = 0; u.r0 = 0; u.rv = 256; return true; }
  DEV const char* abase(const Unit& u, int half) const { return A + (size_t)(u.pm * BM + half * HALF) * KB; }
  DEV const char* bbase(const Unit& u) const { return B + (size_t)(u.pn * BM) * KB; }
  DEV void arow_fill(const Unit&, int*) const {}
  DEV void arow_dma(const Unit&, LAS int*) const {}
  DEV void bias_fill(const Unit&, float*) const {}
  DEV void bias_dma(const Unit&, LAS float*) const {}
  DEV void epi(const Unit& u, const AccT& acc, int wr, int wc, int fr, int fq) const { EpiKV e{p, u.pm, u.pn}; e(acc, wr, wc, fr, fq); }
};
struct PolQ {
  static constexpr bool GATHER = false;
  static constexpr bool FP8 = false, HASBIAS = false, ROWSKIP = false, BIAS_LIN1 = false; static constexpr int SCALE_A = 0, SCALE_B = 0;
  CParams* p; const char* A; const char* B; int wg, nwg, KB;
  DEV bool get(int i, Unit& u) const { const int id = wg + i * nwg; if (id >= 64 * 6) return false; u.pn = id >> 6; u.pm = id & 63; u.e = 0; u.r0 = 0; u.rv = 256; return true; }
  DEV const char* abase(const Unit& u, int half) const { return A + (size_t)(u.pm * BM + half * HALF) * KB; }
  DEV const char* bbase(const Unit& u) const { return B + (size_t)(u.pn * BM) * KB; }
  DEV void arow_fill(const Unit&, int*) const {}
  DEV void arow_dma(const Unit&, LAS int*) const {}
  DEV void bias_fill(const Unit&, float*) const {}
  DEV void bias_dma(const Unit&, LAS float*) const {}
  DEV void epi(const Unit& u, const AccT& acc, int wr, int wc, int fr, int fq) const { EpiQ e{p, u.pm, u.pn}; e(acc, wr, wc, fr, fq); }
};
DEV void phase4_up(CParams& p, int wg, int nwg) {
  if (nwg >= 128) {
    if (wg < 64) { PolIn pol{&p, (const char*)p.h, (const char*)p.wt_in, wg, nwg, DM * 2, 1}; gemm_stream(pol); }
    else {
      { PolKV pol{&p, (const char*)p.ckvn, (const char*)p.wt_ukv, wg - 64, nwg - 64, KVRANK * 2}; gemm_stream(pol); }
      { PolQ pol{&p, (const char*)p.cqn, (const char*)p.wt_uq, (wg - 64 + 32) % (nwg - 64), nwg - 64, QRANK * 2}; gemm_stream(pol); }
    }
  } else {
    { PolIn pol{&p, (const char*)p.h, (const char*)p.wt_in, wg, nwg, DM * 2, 1}; gemm_stream(pol); }
    { PolKV pol{&p, (const char*)p.ckvn, (const char*)p.wt_ukv, wg, nwg, KVRANK * 2}; gemm_stream(pol); }
    { PolQ pol{&p, (const char*)p.cqn, (const char*)p.wt_uq, wg, nwg, QRANK * 2}; gemm_stream(pol); }
  }
}
struct PolOut {
  static constexpr bool GATHER = false;
  static constexpr bool FP8 = false, HASBIAS = false, ROWSKIP = false, BIAS_LIN1 = false; static constexpr int SCALE_A = 0, SCALE_B = 0;
  CParams* p; const char* A; const char* B; int wg, nwg, KB;
  DEV bool get(int i, Unit& u) const { const int id = wg + i * nwg; if (id >= 64 * 8) return false; u.pn = id >> 6; u.pm = id & 63; u.e = 0; u.r0 = 0; u.rv = 256; return true; }
  DEV const char* abase(const Unit& u, int half) const { return A + (size_t)(u.pm * BM + half * HALF) * KB; }
  DEV const char* bbase(const Unit& u) const { return B + (size_t)(u.pn * BM) * KB; }
  DEV void arow_fill(const Unit&, int*) const {}
  DEV void arow_dma(const Unit&, LAS int*) const {}
  DEV void bias_fill(const Unit&, float*) const {}
  DEV void bias_dma(const Unit&, LAS float*) const {}
  DEV void epi(const Unit& u, const AccT& acc, int wr, int wc, int fr, int fq) const { EpiOut e{p, u.pm, u.pn}; e(acc, wr, wc, fr, fq); }
};
DEV void phase6_outproj(CParams& p, int wg, int nwg) { PolOut pol{&p, (const char*)p.aout, (const char*)p.wt_out, wg, nwg, DM * 2}; gemm_stream(pol); }

constexpr int MOE_TAB_OFF = MOE_TAB_OFF_;
DEV int moe_prefix(CParams& p, int* tile_e, int* tile_r0, int* tile_rv) {
  const int t = ltid();
  if (t < 64) {
    const int c = t < NE ? p.cnt[t * CNT_LD] : 0, n = (c + 255) >> 8; int inc = n;
#pragma unroll
    for (int st = 1; st < 32; st <<= 1) { const int v = __shfl_up(inc, st); if ((t & 63) >= st) inc += v; }
    const int first = inc - n;
    if (t < NE) for (int i = 0; i < n; ++i) { tile_e[first + i] = t; tile_r0[first + i] = i * 256; tile_rv[first + i] = min(256, c - i * 256); }
    if (t == NE - 1) tile_e[MAXTILES] = inc;
  }
  __syncthreads();
  return tile_e[MAXTILES];
}
struct PolGU {
  static constexpr bool GATHER = true, FP8 = true, HASBIAS = true, ROWSKIP = false, BIAS_LIN1 = true; static constexpr int SCALE_A = FP8_SCALE_1, SCALE_B = FP8_SCALE_W;
  CParams* p; const char* A; const char* B; const int* tile_e; const int* tile_r0; const int* tile_rv; int ntot, rbase, rstep, pncol, KB, noepi;
  DEV bool get(int i, Unit& u) const {
    u.pm = rstep * i + rbase; u.pn = pncol; if (u.pm >= ntot) return false;
    u.e = __builtin_amdgcn_readfirstlane(tile_e[u.pm]); u.r0 = __builtin_amdgcn_readfirstlane(tile_r0[u.pm]); u.rv = __builtin_amdgcn_readfirstlane(tile_rv[u.pm]); return true; }
  DEV const char* abase(const Unit&, int) const { return A; }
  DEV const char* bbase(const Unit& u) const { return B + ((size_t)u.e * 4096 + u.pn * BM) * KB; }
  DEV void arow_fill(const Unit& u, int* tab) const { const int t = ltid(); if (t < 256) { const int v = p->idx[u.e * NLAT + u.r0 + t]; tab[t] = t < u.rv ? v : 0; } }
  DEV void arow_dma(const Unit& u, LAS int* tabw) const { const int t = ltid() & 255;
    __builtin_amdgcn_global_load_lds((const unsigned*)(p->idx + u.e * NLAT + u.r0 + t), (LAS unsigned*)tabw, 4, 0, 0); }
  DEV const float* bias_src(const Unit& u, int t) const { return p->b_gu + (long)u.e * 4096 + u.pn * 128 + (t < 128 ? t : 2048 + t - 128); }
  DEV void bias_fill(const Unit& u, float* tab) const { const int t = ltid(); if (t < 256) tab[t] = *bias_src(u, t); }
  DEV void bias_dma(const Unit& u, LAS float* tabw) const { __builtin_amdgcn_global_load_lds((const unsigned*)bias_src(u, ltid() & 255), (LAS unsigned*)tabw, 4, 0, 0); }
  DEV void epi(const Unit& u, const AccT& acc, int wr, int wc, int fr, int fq) const { if (noepi) return; EpiGU e{p, u.e, u.pm * 256, u.pn}; e(acc, wr, wc, fr, fq); }
};
struct PolDN {
  static constexpr bool GATHER = false, FP8 = true, HASBIAS = true, ROWSKIP = false, BIAS_LIN1 = false; static constexpr int SCALE_A = FP8_SCALE_1, SCALE_B = FP8_SCALE_W;
  CParams* p; const char* A; const char* B; const int* tile_e; const int* tile_rv; int ntot, rbase, rstep, pncol, KB, noepi;
  DEV bool get(int i, Unit& u) const {
    u.pm = rstep * i + rbase; u.pn = pncol; if (u.pm >= ntot) return false;
    u.e = __builtin_amdgcn_readfirstlane(tile_e[u.pm]); u.r0 = 0; u.rv = __builtin_amdgcn_readfirstlane(tile_rv[u.pm]); return true; }
  DEV const char* abase(const Unit& u, int half) const { return A + (size_t)(u.pm * BM + half * HALF) * KB; }
  DEV const char* bbase(const Unit& u) const { return B + ((size_t)u.e * 2048 + u.pn * BM) * KB; }
  DEV void arow_fill(const Unit&, int*) const {}
  DEV void arow_dma(const Unit&, LAS int*) const {}
  DEV const float* bias_src(const Unit& u, int t) const { return p->b_dn + (long)u.e * 2048 + u.pn * 256 + t; }
  DEV void bias_fill(const Unit& u, float* tab) const { const int t = ltid(); if (t < 256) tab[t] = *bias_src(u, t); }
  DEV void bias_dma(const Unit& u, LAS float* tabw) const { __builtin_amdgcn_global_load_lds((const unsigned*)bias_src(u, ltid() & 255), (LAS unsigned*)tabw, 4, 0, 0); }
  DEV void epi(const Unit& u, const AccT& acc, int wr, int wc, int fr, int fq) const { if (noepi) return; EpiDN e{p, u.e, u.pm * 256, u.pn}; e(acc, wr, wc, fr, fq); }
};
template <int WHICH> DEV void phase_moe(CParams& p, int wg, int nwg, int noepi = 0) {
  extern __shared__ __attribute__((aligned(16))) char shm[];
  int* tile_e = (int*)(shm + MOE_TAB_OFF); int* tile_r0 = tile_e + MAXTILES + 1; int* tile_rv = tile_r0 + MAXTILES;
  const int ntiles = moe_prefix(p, tile_e, tile_r0, tile_rv);
  constexpr int NC = WHICH == 0 ? 16 : 8;
  int rbase, rstep, pncol;
  if (nwg == 256) { const int x = wg & 7, y = wg >> 3; rstep = 256 / NC; if (WHICH == 0) { rbase = 4 * (x >> 1) + (y >> 3); pncol = 8 * (x & 1) + (y & 7); } else { rbase = 4 * x + (y >> 3); pncol = y & 7; } }
  else { rbase = wg / NC; rstep = nwg / NC; pncol = wg % NC; }
  if (WHICH == 0) { PolGU pol{&p, (const char*)p.h2_8, (const char*)p.wt_gu8, tile_e, tile_r0, tile_rv, ntiles, rbase, rstep, pncol, DM, noepi}; gemm_stream(pol); }
  else { PolDN pol{&p, (const char*)p.act8, (const char*)p.wt_dn8, tile_e, tile_rv, ntiles, rbase, rstep, pncol, DFF, noepi}; gemm_stream(pol); }
}
DEV void phase3_rows(CParams& p, int wg, int nwg) {
  const int wid = ltid() >> 6, lane = ltid() & 63;
  for (int row = wg * 8 + wid; row < NROW; row += nwg * 8) {
    if (row >= NCTX) {
      const int lr = row - NCTX;
      const u32x4 raw = *(const u32x4*)(p.cq + (long)lr * QRANK + lane * 8);
      float v[8]; v[0] = bflo(raw.x); v[1] = bfhi(raw.x); v[2] = bflo(raw.y); v[3] = bfhi(raw.y); v[4] = bflo(raw.z); v[5] = bfhi(raw.z); v[6] = bflo(raw.w); v[7] = bfhi(raw.w);
      float ss = 0.f;
#pragma unroll
      for (int j = 0; j < 8; ++j) ss += v[j] * v[j];
      ss = wave_sum(ss); const float rstd = rsqrtf(ss * (1.f / QRANK) + EPS);
      const f32x4 w0 = *(const f32x4*)(p.q_norm + lane * 8), w1 = *(const f32x4*)(p.q_norm + lane * 8 + 4);
      u32x4 o; o.x = cvt_pk_bf16(v[0] * rstd * w0[0], v[1] * rstd * w0[1]); o.y = cvt_pk_bf16(v[2] * rstd * w0[2], v[3] * rstd * w0[3]);
      o.z = cvt_pk_bf16(v[4] * rstd * w1[0], v[5] * rstd * w1[1]); o.w = cvt_pk_bf16(v[6] * rstd * w1[2], v[7] * rstd * w1[3]);
      *(u32x4*)(p.cqn + (long)lr * QRANK + lane * 8) = o;
    }
    {
      const u32x2 raw = *(const u32x2*)(p.ckv + (long)row * KVRANK + lane * 4);
      float v[4]; v[0] = bflo(raw.x); v[1] = bfhi(raw.x); v[2] = bflo(raw.y); v[3] = bfhi(raw.y);
      float ss = v[0] * v[0] + v[1] * v[1] + v[2] * v[2] + v[3] * v[3];
      ss = wave_sum(ss); const float rstd = rsqrtf(ss * (1.f / KVRANK) + EPS);
      const f32x4 w0 = *(const f32x4*)(p.kv_norm + lane * 4);
      u32x2 o; o.x = cvt_pk_bf16(v[0] * rstd * w0[0], v[1] * rstd * w0[1]); o.y = cvt_pk_bf16(v[2] * rstd * w0[2], v[3] * rstd * w0[3]);
      *(u32x2*)(p.ckvn + (long)row * KVRANK + lane * 4) = o;
    }
    {
      const float kv = p.kr[(long)row * ROPE + lane];
      const float other = __shfl_xor(kv, 32);
      float o = kv;
      int b, key; row_to_bkey(row, b, key);
      if (row >= NCTX) {
        const int t = (row - NCTX) & 4095, a = lane & 31;
        const float cs = p.rope[t * 64 + a], sn = p.rope[t * 64 + 32 + a];
        o = lane < 32 ? kv * cs - other * sn : other * sn + kv * cs;
      }
      bf16_t* kd = p.kf + ((long)(b * NH) * KEYS + key) * QK + 128 + lane; const bf16_t ob = f2bf(o);
#pragma unroll
      for (int hh = 0; hh < NH; ++hh) kd[(long)hh * KEYS * QK] = ob;
    }
  }
}

DEV void phase5c_rec(CParams& p, int wg, int nwg) {
  const int wid = ltid() >> 6, lane = ltid() & 63;
  for (int row = wg * 8 + wid; row < NLAT; row += nwg * 8) {
    const bf16_t* a = p.of + (long)row * 1024 + lane * 16; const bf16_t* b = p.ob + (long)row * 1024 + lane * 16;
    const u32x4 a0 = *(const u32x4*)a, a1 = *(const u32x4*)(a + 8), b0 = *(const u32x4*)b, b1 = *(const u32x4*)(b + 8);
    const unsigned aw[8] = {a0.x, a0.y, a0.z, a0.w, a1.x, a1.y, a1.z, a1.w}, bw[8] = {b0.x, b0.y, b0.z, b0.w, b1.x, b1.y, b1.z, b1.w};
    float v[16]; float ss = 0.f;
#pragma unroll
    for (int i = 0; i < 8; ++i) { v[2 * i] = bflo(aw[i]) + bflo(bw[i]); v[2 * i + 1] = bfhi(aw[i]) + bfhi(bw[i]); ss += v[2 * i] * v[2 * i] + v[2 * i + 1] * v[2 * i + 1]; }
    ss += __shfl_xor(ss, 1); ss += __shfl_xor(ss, 2); ss += __shfl_xor(ss, 4);
    const float rstd = rsqrtf(ss * (1.f / DV) + EPS);
    const bf16_t* gp = p.gate + (long)(NCTX + row) * 1024 + lane * 16;
    const u32x4 g0 = *(const u32x4*)gp, g1 = *(const u32x4*)(gp + 8);
    float gt[16]; gt[0] = bflo(g0.x); gt[1] = bfhi(g0.x); gt[2] = bflo(g0.y); gt[3] = bfhi(g0.y); gt[4] = bflo(g0.z); gt[5] = bfhi(g0.z); gt[6] = bflo(g0.w); gt[7] = bfhi(g0.w);
    gt[8] = bflo(g1.x); gt[9] = bfhi(g1.x); gt[10] = bflo(g1.y); gt[11] = bfhi(g1.y); gt[12] = bflo(g1.z); gt[13] = bfhi(g1.z); gt[14] = bflo(g1.w); gt[15] = bfhi(g1.w);
    const float* gn = p.g_norm + (lane & 7) * 16;
    unsigned o[8];
#pragma unroll
    for (int j = 0; j < 8; ++j) o[j] = cvt_pk_bf16(v[2 * j] * rstd * gn[2 * j] * gt[2 * j], v[2 * j + 1] * rstd * gn[2 * j + 1] * gt[2 * j + 1]);
    bf16_t* op = p.aout + (long)row * DM + 1024 + lane * 16;
    *(u32x4*)op = (u32x4){o[0], o[1], o[2], o[3]}; *(u32x4*)(op + 8) = (u32x4){o[4], o[5], o[6], o[7]};
  }
}

constexpr int H2S_LD = 2052;
template <bool ROUTE> DEV void phase7_post(CParams& p, int wg, int nwg) {
  extern __shared__ __attribute__((aligned(16))) char shm[];
  float* h2s = (float*)shm;
  float* red = (float*)(shm + 16 * H2S_LD * 4);
  int* lcnt = (int*)(shm + 16 * H2S_LD * 4 + 8 * 16 * 32 * 4); int* lbase = lcnt + NE; int* rt_e = lbase + NE; int* rt_lp = rt_e + 256;
  const int tid = ltid(), wid = tid >> 6, lane = tid & 63;
  if (tid < NE) lcnt[tid] = 0;
  int gi = 0;
  u32x2 m2[2][8]; f32x4 xv[2][8];
#define P7_LOAD_A(g_) do { const long row_ = (g_) * 16 + wid * 2; const bf16_t* mr = p.mix + row_ * DM + lane * 4; const float* xr = p.x + row_ * DM + lane * 4; \
    _Pragma("unroll") for (int i = 0; i < 8; ++i) m2[0][i] = *(const u32x2*)(mr + i * 256); \
    _Pragma("unroll") for (int i = 0; i < 8; ++i) xv[0][i] = *(const f32x4*)(xr + i * 256); } while (0)
#define P7_LOAD_B(g_) do { const long row_ = (g_) * 16 + wid * 2 + 1; const bf16_t* mr = p.mix + row_ * DM + lane * 4; const float* xr = p.x + row_ * DM + lane * 4; \
    _Pragma("unroll") for (int i = 0; i < 8; ++i) m2[1][i] = *(const u32x2*)(mr + i * 256); \
    _Pragma("unroll") for (int i = 0; i < 8; ++i) xv[1][i] = *(const f32x4*)(xr + i * 256); } while (0)
  if (wg < NLAT / 16) P7_LOAD_A(wg);
  for (int g = wg; g < NLAT / 16; g += nwg, ++gi) {
    {
      P7_LOAD_B(g);
      const int row0 = g * 16 + wid * 2, b = row0 >> 12;
      const float* mod = p.mod + b * 12288;
      float ss[2] = {0.f, 0.f};
#pragma unroll
      for (int rr = 0; rr < 2; ++rr)
#pragma unroll
        for (int i = 0; i < 8; ++i) { const float a0 = bflo(m2[rr][i].x), a1 = bfhi(m2[rr][i].x), a2 = bflo(m2[rr][i].y), a3 = bfhi(m2[rr][i].y); ss[rr] += a0 * a0 + a1 * a1 + a2 * a2 + a3 * a3; }
      ss[0] = wave_sum(ss[0]); ss[1] = wave_sum(ss[1]);
      const float rstd[2] = {rsqrtf(ss[0] * (1.f / DM) + EPS), rsqrtf(ss[1] * (1.f / DM) + EPS)};
      float s2[2] = {0.f, 0.f};
      __builtin_amdgcn_sched_barrier(0);
#pragma unroll
      for (int i = 0; i < 8; ++i) {
        const int c0 = i * 256 + lane * 4;
        const f32x4 w = *(const f32x4*)(p.ln_mix_post + c0), gm = *(const f32x4*)(mod + 4096 + c0);
#pragma unroll
        for (int rr = 0; rr < 2; ++rr) {
          const f32x4 mv = {bflo(m2[rr][i].x), bfhi(m2[rr][i].x), bflo(m2[rr][i].y), bfhi(m2[rr][i].y)};
#pragma unroll
          for (int j = 0; j < 4; ++j) { xv[rr][i][j] = xv[rr][i][j] + gm[j] * (mv[j] * rstd[rr] * w[j]); s2[rr] += xv[rr][i][j] * xv[rr][i][j]; }
          st_bf16x4(p.x1 + (long)(row0 + rr) * DM + c0, xv[rr][i]);
        }
      }
      s2[0] = wave_sum(s2[0]); s2[1] = wave_sum(s2[1]);
      const float rstd2[2] = {rsqrtf(s2[0] * (1.f / DM) + EPS), rsqrtf(s2[1] * (1.f / DM) + EPS)};
      __builtin_amdgcn_sched_barrier(0);
#pragma unroll
      for (int i = 0; i < 8; ++i) {
        const int c0 = i * 256 + lane * 4;
        const f32x4 w = *(const f32x4*)(p.ln_ffn_pre + c0), s1 = *(const f32x4*)(mod + 8192 + c0), s0 = *(const f32x4*)(mod + 6144 + c0);
#pragma unroll
        for (int rr = 0; rr < 2; ++rr) {
          f32x4 y;
#pragma unroll
          for (int j = 0; j < 4; ++j) y[j] = xv[rr][i][j] * rstd2[rr] * w[j] * (1.f + s1[j]) + s0[j];
          *(unsigned*)(p.h2_8 + (long)(row0 + rr) * DM + c0) = cvt_pk4_fp8(y);
          *(f32x4*)(h2s + (wid * 2 + rr) * H2S_LD + c0) = y;
        }
      }
    }
    {
      f32x4 a0 = {0.f, 0.f, 0.f, 0.f}, a1 = {0.f, 0.f, 0.f, 0.f};
      const int r16 = lane & 15, kq = lane >> 4;
      const float* ap = h2s + r16 * H2S_LD + wid * 256 + kq;
      const float* bp = p.router_w + (long)(wid * 256 + kq) * NE + r16; asm volatile("" : "+v"(bp));
      float bw0[64], bw1[64];
#pragma unroll
      for (int s = 0; s < 64; ++s) { bw0[s] = bp[(long)(4 * s) * NE]; bw1[s] = bp[(long)(4 * s) * NE + 16]; }
      asm volatile("" ::: "memory");
      if (g + nwg < NLAT / 16) P7_LOAD_A(g + nwg);
      __syncthreads();
#pragma unroll
      for (int s = 0; s < 64; ++s) {
        const float av = ap[4 * s];
        a0 = __builtin_amdgcn_mfma_f32_16x16x4f32(av, bw0[s], a0, 0, 0, 0);
        a1 = __builtin_amdgcn_mfma_f32_16x16x4f32(av, bw1[s], a1, 0, 0, 0);
      }
#pragma unroll
      for (int j = 0; j < 4; ++j) { red[(wid * 16 + 4 * kq + j) * 32 + r16] = a0[j]; red[(wid * 16 + 4 * kq + j) * 32 + 16 + r16] = a1[j]; }
    }
    __syncthreads();
    {
      const int r = tid >> 5, e = tid & 31; float sl = p.router_b[e];
#pragma unroll
      for (int w = 0; w < 8; ++w) sl += red[(w * 16 + r) * 32 + e];
      if (ROUTE) {
        const int row = g * 16 + r;
        float sv[4]; int sel[4];
#pragma unroll
        for (int k = 0; k < 4; ++k) {
          float bv = sl; int bi = e;
#pragma unroll
          for (int st = 1; st < 32; st <<= 1) { const float ov = __shfl_xor(bv, st); const int oi = __shfl_xor(bi, st); const bool take = ov > bv || (ov == bv && oi < bi); bv = take ? ov : bv; bi = take ? oi : bi; }
          sv[k] = bv; sel[k] = bi; if (e == bi) sl = -3.0e38f;
        }
        const float e1 = __expf(sv[1] - sv[0]), e2 = __expf(sv[2] - sv[0]), e3 = __expf(sv[3] - sv[0]), inv = 1.f / (1.f + e1 + e2 + e3);
        if (e < 4) {
          const int se = e == 0 ? sel[0] : (e == 1 ? sel[1] : (e == 2 ? sel[2] : sel[3]));
          const float gk = (e == 0 ? 1.f : (e == 1 ? e1 : (e == 2 ? e2 : e3))) * inv;
          const int li = (gi & 3) * 64 + r * 4 + e;
          rt_e[li] = se; rt_lp[li] = atomicAdd(&lcnt[se], 1);
          p.tok_e[row * 4 + e] = se; p.tok_gate[row * 4 + e] = gk;
        }
      }
    }
    if (ROUTE && ((gi & 3) == 3 || g + nwg >= NLAT / 16)) {
      __syncthreads();
      if (tid < NE) { const int c = lcnt[tid]; lbase[tid] = c ? atomicAdd(p.cnt + tid * CNT_LD, c) : 0; lcnt[tid] = 0; }
      __syncthreads();
      const int nent = ((gi & 3) + 1) * 64;
      if (tid < nent) {
        const int se = rt_e[tid], pos = lbase[se] + rt_lp[tid], row = (g - ((gi & 3) - (tid >> 6)) * nwg) * 16 + ((tid >> 2) & 15);
        p.idx[se * NLAT + pos] = row; p.tok_pos[row * 4 + (tid & 3)] = pos;
      }
    }
  }
#undef P7_LOAD_A
#undef P7_LOAD_B
}

DEV void phase11_final(CParams& p, int wg, int nwg) {
  extern __shared__ __attribute__((aligned(16))) char shm[];
  int* rowbase = (int*)shm;
  if (ltid() < 64) {
    const int t = ltid(), n = t < NE ? (p.cnt[t * CNT_LD] + 255) >> 8 : 0; int inc = n;
#pragma unroll
    for (int st = 1; st < 32; st <<= 1) { const int v = __shfl_up(inc, st); if (t >= st) inc += v; }
    if (t < NE) rowbase[t] = (inc - n) * 256;
  }
  __syncthreads();
  const int wid = ltid() >> 6, lane = ltid() & 63;
  i32x4 te_n, tp_n; f32x4 tg_n;
  { const int r0 = wg * 8 + wid; if (r0 < NLAT) { te_n = *(const i32x4*)(p.tok_e + r0 * 4); tp_n = *(const i32x4*)(p.tok_pos + r0 * 4); tg_n = *(const f32x4*)(p.tok_gate + r0 * 4); } }
  for (int row = wg * 8 + wid; row < NLAT; row += nwg * 8) {
    const int b = row >> 12; const float* mod = p.mod + b * 12288;
    const i32x4 te = te_n, tp = tp_n; const f32x4 tg = tg_n;
    { const int rn = row + nwg * 8; if (rn < NLAT) { te_n = *(const i32x4*)(p.tok_e + rn * 4); tp_n = *(const i32x4*)(p.tok_pos + rn * 4); tg_n = *(const f32x4*)(p.tok_gate + rn * 4); } }
    f32x4 y[2][4]; u32x4 xr[2][2];
#pragma unroll
    for (int i = 0; i < 2; ++i) { const bf16_t* xp = p.x1 + (long)row * DM + 1024 * i + lane * 16; xr[i][0] = *(const u32x4*)xp; xr[i][1] = *(const u32x4*)(xp + 8); }
#pragma unroll
    for (int i = 0; i < 2; ++i)
#pragma unroll
      for (int j = 0; j < 4; ++j) y[i][j] = (f32x4){0.f, 0.f, 0.f, 0.f};
#pragma unroll
    for (int k = 0; k < 4; ++k) {
      const int e = te[k], pos = tp[k]; const float gt = tg[k];
      const unsigned char* yr = p.ys8 + (long)(rowbase[e] + pos) * DM + lane * 16;
#pragma unroll
      for (int i = 0; i < 2; ++i) {
        const u32x4 r = *(const u32x4*)(yr + 1024 * i); const unsigned rw[4] = {r.x, r.y, r.z, r.w};
#pragma unroll
        for (int j = 0; j < 4; ++j) { const f32x2 lo = __builtin_amdgcn_cvt_pk_f32_fp8(rw[j], false), hi = __builtin_amdgcn_cvt_pk_f32_fp8(rw[j], true);
          y[i][j][0] += gt * lo.x; y[i][j][1] += gt * lo.y; y[i][j][2] += gt * hi.x; y[i][j][3] += gt * hi.y; }
      }
    }
    float ss = 0.f;
#pragma unroll
    for (int i = 0; i < 2; ++i)
#pragma unroll
      for (int j = 0; j < 4; ++j) ss += y[i][j][0] * y[i][j][0] + y[i][j][1] * y[i][j][1] + y[i][j][2] * y[i][j][2] + y[i][j][3] * y[i][j][3];
    ss = wave_sum(ss); const float rstd = rsqrtf(ss * (1.f / DM) + EPS);
#pragma unroll
    for (int i = 0; i < 2; ++i)
#pragma unroll
      for (int j = 0; j < 4; ++j) {
        const int c0 = 1024 * i + lane * 16 + 4 * j;
        const f32x4 w = *(const f32x4*)(p.ln_ffn_post + c0), gf = *(const f32x4*)(mod + 10240 + c0);
        const unsigned x01 = xr[i][j >> 1][(j & 1) * 2], x23 = xr[i][j >> 1][(j & 1) * 2 + 1]; const f32x4 xx = {bflo(x01), bfhi(x01), bflo(x23), bfhi(x23)};
        f32x4 o;
#pragma unroll
        for (int jj = 0; jj < 4; ++jj) o[jj] = xx[jj] + gf[jj] * (y[i][j][jj] * rstd * w[jj]);
        *(f32x4*)(p.out + (long)row * DM + c0) = o;
      }
  }
}
namespace att {
constexpr int NW = 8, QBLK = 32, KVBLK = 64;
constexpr float SCALE = 0.07216878364870322f;
constexpr float THR = 8.f;
constexpr int SHM_V = KVBLK * DV * 2, SHM_K = KVBLK * 512;
constexpr int LDS_BYTES = 2 * SHM_V + 2 * SHM_K + NW * 64 * 4;
#define KSWZ2(row, colB) ((row) * 512 + ((colB) ^ (((row) & 15) << 4)))
#define SBAR() __builtin_amdgcn_sched_barrier(0)
DEV int crow(int r, int hi) { return (r & 3) + 8 * (r >> 2) + 4 * hi; }

DEV void partialSM(f32x16& p0, f32x16& p1, float& m_reg, float& mn, float& alpha) {
  constexpr float C = SCALE * 1.4426950408889634f;
  float pmax = p0[0];
#pragma unroll
  for (int r = 1; r < 16; ++r) pmax = fmaxf(pmax, p0[r]);
#pragma unroll
  for (int r = 0; r < 16; ++r) pmax = fmaxf(pmax, p1[r]);
  { auto rr = __builtin_amdgcn_permlane32_swap(__float_as_uint(pmax), __float_as_uint(pmax), false, false);
    pmax = fmaxf(__uint_as_float(rr[0]), __uint_as_float(rr[1])); }
  if (__builtin_expect(__all(pmax - m_reg <= THR / SCALE), 1)) { mn = m_reg; alpha = 1.f; }
  else { mn = fmaxf(m_reg, pmax); alpha = __builtin_amdgcn_exp2f((m_reg - mn) * C); m_reg = mn; }
  const float mnC = -mn * C;
#pragma unroll
  for (int r = 0; r < 16; ++r) p0[r] = fmaf(p0[r], C, mnC);
#pragma unroll
  for (int r = 0; r < 16; ++r) p1[r] = fmaf(p1[r], C, mnC);
#pragma unroll
  for (int r = 0; r < 16; ++r) p0[r] = __builtin_amdgcn_exp2f(p0[r]);
}
DEV void finishSM(f32x16& p0, f32x16& p1, float alpha, float& l_reg, bf16x8& pa0, bf16x8& pa1, bf16x8& pa2, bf16x8& pa3) {
#pragma unroll
  for (int r = 0; r < 16; ++r) p1[r] = __builtin_amdgcn_exp2f(p1[r]);
  float ps = 0;
#pragma unroll
  for (int r = 0; r < 16; ++r) ps += p0[r];
#pragma unroll
  for (int r = 0; r < 16; ++r) ps += p1[r];
  { auto rr = __builtin_amdgcn_permlane32_swap(__float_as_uint(ps), __float_as_uint(ps), false, false);
    ps = __uint_as_float(rr[0]) + __uint_as_float(rr[1]); }
  l_reg = l_reg * alpha + ps;
#define PK4(P, BASE, OUT) do { unsigned a0 = cvt_pk_bf16(P[BASE + 0], P[BASE + 1]), a1 = cvt_pk_bf16(P[BASE + 2], P[BASE + 3]);   \
    unsigned b0 = cvt_pk_bf16(P[BASE + 4], P[BASE + 5]), b1 = cvt_pk_bf16(P[BASE + 6], P[BASE + 7]);                              \
    auto r0 = __builtin_amdgcn_permlane32_swap(a0, b0, false, false); auto r1 = __builtin_amdgcn_permlane32_swap(a1, b1, false, false); \
    u32x4 w = {r0[0], r1[0], r0[1], r1[1]}; OUT = *reinterpret_cast<bf16x8*>(&w); } while (0)
  PK4(p0, 0, pa0); PK4(p0, 8, pa1); PK4(p1, 0, pa2); PK4(p1, 8, pa3);
#undef PK4
}
DEV void qkt(f32x16& p0, f32x16& p1, const char* Ks, const bf16x8* qr, int r32, int hi) {
  p0 = f32x16{}; p1 = f32x16{};
#pragma unroll
  for (int d0 = 0; d0 < 12; ++d0) { const int cb = (d0 * 16 + hi * 8) * 2;
    const bf16x8 b0 = *reinterpret_cast<const bf16x8*>(Ks + KSWZ2(r32, cb));
    const bf16x8 b1 = *reinterpret_cast<const bf16x8*>(Ks + KSWZ2(32 + r32, cb));
    p0 = __builtin_amdgcn_mfma_f32_32x32x16_bf16(b0, qr[d0], p0, 0, 0, 0);
    p1 = __builtin_amdgcn_mfma_f32_32x32x16_bf16(b1, qr[d0], p1, 0, 0, 0); }
}
DEV int v_st(int k, int c) { const int kk = (k & ~0xC) | ((k & 4) << 1) | ((k & 8) >> 1); return ((kk >> 3) * 4 + (c >> 5)) * 512 + ((kk & 7) * 32 + (c & 31)) * 2; }
DEV int v_rd_base(int lane) { return ((lane & 3) << 3) | (((lane >> 2) & 3) << 6) | (((lane >> 4) & 1) << 5) | (((lane >> 5) & 1) << 8); }
constexpr int v_rd_off(int d0, int ks, int half) { return d0 * 512 + ks * 4096 + half * 2048; }
template <int OFF> DEV s16x4 tr_read(int vb) { s16x4 r; asm volatile("ds_read_b64_tr_b16 %0, %1 offset:%2" : "=&v"(r) : "v"(vb), "i"(OFF) : "memory"); return r; }
struct VFrag { s16x4 l0, h0, l1, h1, l2, h2, l3, h3; };
template <int D0> DEV void pv_read(VFrag& f, int vb) {
  f.l0 = tr_read<v_rd_off(D0, 0, 0)>(vb); f.h0 = tr_read<v_rd_off(D0, 0, 1)>(vb); f.l1 = tr_read<v_rd_off(D0, 1, 0)>(vb); f.h1 = tr_read<v_rd_off(D0, 1, 1)>(vb);
  f.l2 = tr_read<v_rd_off(D0, 2, 0)>(vb); f.h2 = tr_read<v_rd_off(D0, 2, 1)>(vb); f.l3 = tr_read<v_rd_off(D0, 3, 0)>(vb); f.h3 = tr_read<v_rd_off(D0, 3, 1)>(vb);
}
DEV void pv_mma(f32x16& od, const VFrag& f, bf16x8 pa0, bf16x8 pa1, bf16x8 pa2, bf16x8 pa3) {
#define PK(L, H) (bf16x8){L[0], L[1], L[2], L[3], H[0], H[1], H[2], H[3]}
  od = __builtin_amdgcn_mfma_f32_32x32x16_bf16(pa0, PK(f.l0, f.h0), od, 0, 0, 0);
  od = __builtin_amdgcn_mfma_f32_32x32x16_bf16(pa1, PK(f.l1, f.h1), od, 0, 0, 0);
  od = __builtin_amdgcn_mfma_f32_32x32x16_bf16(pa2, PK(f.l2, f.h2), od, 0, 0, 0);
  od = __builtin_amdgcn_mfma_f32_32x32x16_bf16(pa3, PK(f.l3, f.h3), od, 0, 0, 0);
#undef PK
}
#define PV_WAIT(n) do { asm volatile("s_waitcnt lgkmcnt(" #n ")" ::: "memory"); SBAR(); } while (0)
DEV void pv_d0(f32x16* o, int vb, bf16x8 pa0, bf16x8 pa1, bf16x8 pa2, bf16x8 pa3) {
  VFrag fa, fb;
  pv_read<0>(fa, vb);
  pv_read<1>(fb, vb); PV_WAIT(8); pv_mma(o[0], fa, pa0, pa1, pa2, pa3); SBAR();
  pv_read<2>(fa, vb); PV_WAIT(8); pv_mma(o[1], fb, pa0, pa1, pa2, pa3); SBAR();
  pv_read<3>(fb, vb); PV_WAIT(8); pv_mma(o[2], fa, pa0, pa1, pa2, pa3); SBAR();
  PV_WAIT(0); pv_mma(o[3], fb, pa0, pa1, pa2, pa3);
}

DEV void attn_unit(const bf16_t* __restrict__ Qb, const bf16_t* __restrict__ Kh, const bf16_t* __restrict__ Vh, const float* __restrict__ rp, bf16_t* __restrict__ Ob, CParams& fp, int fwg, int fbase, int fn) {
  extern __shared__ __attribute__((aligned(16))) char shm[];
  const int tid = ltid(), wid = tid >> 6, lane = tid & 63, r32 = lane & 31, hi = lane >> 5;
  char* V_lds = shm; char* K_lds = shm + 2 * SHM_V;
  float* ws = (float*)(shm + 2 * SHM_V + 2 * SHM_K) + wid * 64; float* li_l = ws; float* al_l = ws + 32;
  float m_reg = -1e30f, l_reg = 0; f32x16 o[4] = {}; bf16x8 qr[12];
  {
    const bf16_t* Qw = Qb + (long)(wid * QBLK + r32) * QK + hi * 8;
#pragma unroll
    for (int d0 = 0; d0 < 12; ++d0) qr[d0] = *reinterpret_cast<const bf16x8*>(Qw + d0 * 16);
    const float* rr = rp + (long)(wid * QBLK + r32) * 64;
#pragma unroll
    for (int dd = 0; dd < 2; ++dd) {
      const int a0 = 16 * dd + 8 * hi;
      const f32x4 c0 = *(const f32x4*)(rr + a0), c1 = *(const f32x4*)(rr + a0 + 4), s0 = *(const f32x4*)(rr + 32 + a0), s1 = *(const f32x4*)(rr + 32 + a0 + 4);
      float cs[8] = {c0[0], c0[1], c0[2], c0[3], c1[0], c1[1], c1[2], c1[3]}, sn[8] = {s0[0], s0[1], s0[2], s0[3], s1[0], s1[1], s1[2], s1[3]};
      const bf16x8 x1 = qr[8 + dd], x2 = qr[10 + dd]; bf16x8 y1, y2;
#pragma unroll
      for (int j = 0; j < 8; j += 2) {
        const float a1 = bf2f((bf16_t)x1[j]), a2 = bf2f((bf16_t)x2[j]), b1 = bf2f((bf16_t)x1[j + 1]), b2 = bf2f((bf16_t)x2[j + 1]);
        const unsigned u1 = cvt_pk_bf16(a1 * cs[j] - a2 * sn[j], b1 * cs[j + 1] - b2 * sn[j + 1]);
        const unsigned u2 = cvt_pk_bf16(a1 * sn[j] + a2 * cs[j], b1 * sn[j + 1] + b2 * cs[j + 1]);
        y1[j] = (short)(u1 & 0xffff); y1[j + 1] = (short)(u1 >> 16); y2[j] = (short)(u2 & 0xffff); y2[j + 1] = (short)(u2 >> 16);
      }
      qr[8 + dd] = y1; qr[10 + dd] = y2;
    }
  }
  const int sr = tid >> 4, sc = (tid & 15) * 8, vst0 = v_st(sr, sc), vst1 = v_st(32 + sr, sc);
  int kst[3];
#pragma unroll
  for (int i = 0; i < 3; ++i) { const int id = tid + 512 * i, row = id / 24, ch = id % 24; kst[i] = KSWZ2(row, ch * 16); }
  const int vb0 = (int)(uintptr_t)V_lds + v_rd_base(lane);
  bf16x8 vs0, vs1, ks0, ks1, ks2;
#define SLOAD(k0) do { vs0 = *reinterpret_cast<const bf16x8*>(Vh + (long)((k0) + sr) * DV + sc); vs1 = *reinterpret_cast<const bf16x8*>(Vh + (long)((k0) + 32 + sr) * DV + sc); \
    const bf16_t* kp_ = Kh + (long)(k0) * QK + tid * 8; ks0 = *reinterpret_cast<const bf16x8*>(kp_); ks1 = *reinterpret_cast<const bf16x8*>(kp_ + 4096); ks2 = *reinterpret_cast<const bf16x8*>(kp_ + 8192); } while (0)
#define SWRITE(b) do { *(bf16x8*)(V_lds + (b) * SHM_V + vst0) = vs0; *(bf16x8*)(V_lds + (b) * SHM_V + vst1) = vs1; \
    *(bf16x8*)(K_lds + (b) * SHM_K + kst[0]) = ks0; *(bf16x8*)(K_lds + (b) * SHM_K + kst[1]) = ks1; *(bf16x8*)(K_lds + (b) * SHM_K + kst[2]) = ks2; } while (0)
#define SWAIT() asm volatile("s_waitcnt vmcnt(0)" ::: "memory")
#define RESC(a) do { if (__any((a) < 1.f)) { if (hi == 0) al_l[r32] = (a); asm volatile("s_waitcnt lgkmcnt(0)" ::: "memory"); \
    _Pragma("unroll") for (int d = 0; d < 4; ++d) _Pragma("unroll") for (int r = 0; r < 16; ++r) o[d][r] *= al_l[crow(r, hi)]; } } while (0)
  f32x16 p0, p1; float mn, al; bf16x8 pa0, pa1, pa2, pa3; constexpr int NTL = KEYS / KVBLK;
  f32x4 fld[4];
  if (fn > 0) fill_load(fp, fwg, fbase, fld);
  SLOAD(0); SWAIT(); SWRITE(0); SLOAD(KVBLK); __syncthreads();
#pragma unroll 1
  for (int j = 0; j < NTL; ++j) {
    const int cb = j & 1;
    if (j + 1 < NTL) { if (j >= 2 && j < fn) asm volatile("s_waitcnt vmcnt(5)" ::: "memory"); else SWAIT(); SWRITE(cb ^ 1); }
    if (j + 2 < NTL) SLOAD((j + 2) * KVBLK);
    if (j > 0 && j <= fn) fill_store(fp, fwg, fbase + j - 1, (j - 1) & 1);
    SBAR(); qkt(p0, p1, K_lds + cb * SHM_K, qr, r32, hi);
    partialSM(p0, p1, m_reg, mn, al);
    RESC(al);
    finishSM(p0, p1, al, l_reg, pa0, pa1, pa2, pa3); SBAR();
    pv_d0(o, vb0 + cb * SHM_V, pa0, pa1, pa2, pa3);
    if (j < fn) { fill_write(fld, j & 1); if (j + 1 < fn) fill_load(fp, fwg, fbase + j + 1, fld); }
    __syncthreads();
  }
  if (fn == NTL) fill_store(fp, fwg, fbase + NTL - 1, (NTL - 1) & 1);
  if (hi == 0) li_l[r32] = l_reg;
  asm volatile("s_waitcnt lgkmcnt(0)" ::: "memory");
  float rli[16];
#pragma unroll
  for (int r = 0; r < 16; ++r) rli[r] = __builtin_amdgcn_rcpf(li_l[crow(r, hi)]);
  bf16_t* Ow = Ob + (long)(wid * QBLK) * DM;
  constexpr int OPITCH = DV * 2 + 16;
  char* ost = shm + wid * (QBLK * OPITCH);
#pragma unroll
  for (int r = 0; r < 16; ++r) { const int orow = crow(r, hi);
#pragma unroll
    for (int d0 = 0; d0 < 4; ++d0) *(bf16_t*)(ost + orow * OPITCH + (d0 * 32 + r32) * 2) = f2bf(o[d0][r] * rli[r]); }
  asm volatile("s_waitcnt lgkmcnt(0)" ::: "memory");
#pragma unroll
  for (int k = 0; k < 8; ++k) { const int idx = k * 64 + lane, row = idx >> 4, ch = idx & 15;
    *(u32x4*)(Ow + (long)row * DM + ch * 8) = *(const u32x4*)(ost + row * OPITCH + ch * 16); }
  __syncthreads();
#undef SLOAD
#undef SWRITE
#undef SWAIT
#undef RESC
}
}

DEV void phase5a_attn(CParams& p, int u, int fwg = 0, int fbase = 0, int fn = 0) {
  const int qb = u & 15, h = (u >> 4) & 7, b = u >> 7;
  const long bh = b * NH + h;
  att::attn_unit(p.qf + (bh * SEQ + qb * 256) * QK, p.kf + bh * KEYS * QK, p.vf + bh * KEYS * DV, p.rope + (long)(qb * 256) * 64,
                 p.aout + (long)(b * SEQ + qb * 256) * DM + h * DV, p, fwg, fbase, fn);
}
namespace hg {
constexpr int LQ = 136, LS = 72;
constexpr int O_QT = 0, O_KT = O_QT + 64 * LQ * 2, O_KHT = O_KT + 64 * LQ * 2, O_VT = O_KHT + 128 * LS * 2, O_ST = O_VT + 32 * LS * 2, BUF = O_ST + 32 * LQ * 2;
constexpr int LDS_BYTES = 2 * BUF;
DEV bf16x8 ld8(const char* p) { return *reinterpret_cast<const bf16x8*>(p); }
DEV int qk_off(int row, int colb) { return row * (LQ * 2) + ((((colb >> 4) ^ ((row >> 3) & 7)) << 4) | (colb & 15)); }
DEV bf16x8 ld44(const char* p0, const char* p1) { const s16x4 a = *reinterpret_cast<const s16x4*>(p0), b = *reinterpret_cast<const s16x4*>(p1); return (bf16x8){a[0], a[1], a[2], a[3], b[0], b[1], b[2], b[3]}; }

DEV void hgrn_unit(CParams& p, int u, int wg, bool fill) {
  extern __shared__ __attribute__((aligned(16))) char shm[];
  const int sl = u & 3, dir = (u >> 2) & 1, h = (u >> 3) & 7, b = u >> 6;
  const int tid = ltid(), wid = tid >> 6, lane = tid & 63, fr = lane & 15, fq = lane >> 4;
  const int dp = lane & 7, seg = lane >> 3, d0 = 16 * wid + 2 * dp;
  const float* G = dir ? p.gb : p.gf;
  bf16_t* O = dir ? p.ob : p.of;
  const int sgn = dir ? -1 : 1;
#define HG_ROW0(c_, r0_) do { if ((c_) < 4) r0_ = dir ? b * 256 + 255 - 64 * (c_) : b * 256 + 64 * (c_); \
    else r0_ = dir ? NCTX + b * 4096 + 4095 - 64 * ((c_) - 4) : NCTX + b * 4096 + 64 * ((c_) - 4); } while (0)
#define HG_LOAD(c_, G_, Q_, V_) do { int r0n_; HG_ROW0(c_, r0n_); \
    _Pragma("unroll") for (int ii = 0; ii < 8; ++ii) { const long row_ = r0n_ + sgn * (8 * seg + ii); G_[ii] = *(const f32x2*)(G + row_ * 1024 + h * 128 + d0); Q_[ii] = *(const unsigned*)(p.qh + row_ * 1024 + h * 128 + d0); } \
    { const long row_ = r0n_ + sgn * (tid >> 3); V_ = *(const u32x2*)(p.vh + row_ * 1024 + h * 128 + sl * 32 + (tid & 7) * 4); } } while (0)
  f32x4 S[2] = {{0.f, 0.f, 0.f, 0.f}, {0.f, 0.f, 0.f, 0.f}};
  float dec = 0.f;
  f32x2 g[8]; unsigned q[8]; u32x2 v;
  f32x2 gN[8]; unsigned qN[8]; u32x2 vN;
#define HG_ELEM(cn_, LATN_) do { char* bufn = shm + ((cn_) & 1) * BUF; \
    { bf16_t* VT = (bf16_t*)(bufn + O_VT); const int i = tid >> 3, e4 = (tid & 7) * 4; \
      VT[(e4 + 0) * LS + i] = (bf16_t)(v.x & 0xffff); VT[(e4 + 1) * LS + i] = (bf16_t)(v.x >> 16); VT[(e4 + 2) * LS + i] = (bf16_t)(v.y & 0xffff); VT[(e4 + 3) * LS + i] = (bf16_t)(v.y >> 16); } \
    f32x2 cp[8]; cp[0] = g[0]; \
    _Pragma("unroll") for (int ii = 1; ii < 8; ++ii) cp[ii] = cp[ii - 1] * g[ii]; \
    f32x2 inc = cp[7]; \
    _Pragma("unroll") for (int st = 8; st < 64; st <<= 1) { const float t0 = __shfl_up(inc[0], st), t1 = __shfl_up(inc[1], st); if (lane >= st) { inc[0] *= t0; inc[1] *= t1; } } \
    f32x2 off; { const float t0 = __shfl_up(inc[0], 8), t1 = __shfl_up(inc[1], 8); off[0] = lane >= 8 ? t0 : 1.f; off[1] = lane >= 8 ? t1 : 1.f; } \
    f32x2 BL, R; BL[0] = __shfl(inc[0], dp + 56); BL[1] = __shfl(inc[1], dp + 56); R[0] = __shfl(inc[0], dp + 24); R[1] = __shfl(inc[1], dp + 24); \
    const float Ri0 = __builtin_amdgcn_rcpf(fmaxf(R[0], 1e-35f)), Ri1 = __builtin_amdgcn_rcpf(fmaxf(R[1], 1e-35f)); \
    const float ebl0 = BL[0] * Ri0, ebl1 = BL[1] * Ri1; \
    const float b0s = __shfl(BL[0], fr >> 1), b1s = __shfl(BL[1], fr >> 1), r0s = __shfl(R[0], fr >> 1), r1s = __shfl(R[1], fr >> 1); \
    dec = (fr & 1) ? b1s : b0s; \
    if (LATN_) { const float er = (fr & 1) ? r1s : r0s; bf16_t* ST = (bf16_t*)(bufn + O_ST); \
      _Pragma("unroll") for (int eb = 0; eb < 2; ++eb) _Pragma("unroll") for (int j = 0; j < 4; ++j) ST[(eb * 16 + 4 * fq + j) * LQ + wid * 16 + fr] = f2bf(S[eb][j] * er); } \
    unsigned kh0[4], kh1[4]; \
    _Pragma("unroll") for (int ii = 0; ii < 8; ii += 2) { float k0v[2], k1v[2]; \
      _Pragma("unroll") for (int z = 0; z < 2; ++z) { const int i = 8 * seg + ii + z; \
        const float E0 = fminf(fmaxf(off[0] * cp[ii + z][0] * Ri0, 1e-30f), 1e30f), E1 = fminf(fmaxf(off[1] * cp[ii + z][1] * Ri1, 1e-30f), 1e30f); \
        const float Ei0 = __builtin_amdgcn_rcpf(E0), Ei1 = __builtin_amdgcn_rcpf(E1); \
        const float kt0 = (1.f - g[ii + z][0]) * Ei0, kt1 = (1.f - g[ii + z][1]) * Ei1; \
        *(unsigned*)(bufn + O_KT + qk_off(i, d0 * 2)) = cvt_pk_bf16(kt0, kt1); \
        if (LATN_) *(unsigned*)(bufn + O_QT + qk_off(i, d0 * 2)) = cvt_pk_bf16(bflo(q[ii + z]) * E0, bfhi(q[ii + z]) * E1); \
        k0v[z] = kt0 * ebl0; k1v[z] = kt1 * ebl1; } \
      kh0[ii >> 1] = cvt_pk_bf16(k0v[0], k0v[1]); kh1[ii >> 1] = cvt_pk_bf16(k1v[0], k1v[1]); } \
    *(u32x4*)(bufn + O_KHT + (d0 * LS + 8 * seg) * 2) = (u32x4){kh0[0], kh0[1], kh0[2], kh0[3]}; \
    *(u32x4*)(bufn + O_KHT + ((d0 + 1) * LS + 8 * seg) * 2) = (u32x4){kh1[0], kh1[1], kh1[2], kh1[3]}; } while (0)
#define HG_MMA(c_, LATC_) do { const char* bufc = shm + ((c_) & 1) * BUF; \
    if (LATC_) { const int tb = wid >> 1, eb = wid & 1; f32x4 P[4]; bf16x8 qt[4];        \
      _Pragma("unroll") for (int ks = 0; ks < 4; ++ks) qt[ks] = ld8(bufc + O_QT + qk_off(tb * 16 + fr, 64 * ks + 16 * fq)); \
      _Pragma("unroll") for (int sb = 0; sb < 4; ++sb) { P[sb] = (f32x4){0.f, 0.f, 0.f, 0.f}; \
        if (sb <= tb) { \
          _Pragma("unroll") for (int ks = 0; ks < 4; ++ks) { \
            const bf16x8 a = ld8(bufc + O_KT + qk_off(sb * 16 + fr, 64 * ks + 16 * fq)); \
            P[sb] = __builtin_amdgcn_mfma_f32_16x16x32_bf16(a, qt[ks], P[sb], 0, 0, 0); }        \
          if (sb == tb) { _Pragma("unroll") for (int j = 0; j < 4; ++j) P[sb][j] = (4 * fq + j <= fr) ? P[sb][j] : 0.f; } } } \
      f32x4 acc = {0.f, 0.f, 0.f, 0.f}; \
      _Pragma("unroll") for (int pr = 0; pr < 2; ++pr) {        \
        if (2 * pr <= tb) { \
          const u32x4 pw = {cvt_pk_bf16(P[2 * pr][0], P[2 * pr][1]), cvt_pk_bf16(P[2 * pr][2], P[2 * pr][3]), cvt_pk_bf16(P[2 * pr + 1][0], P[2 * pr + 1][1]), cvt_pk_bf16(P[2 * pr + 1][2], P[2 * pr + 1][3])}; \
          const char* vrow = bufc + O_VT + ((eb * 16 + fr) * LS + 32 * pr + 4 * fq) * 2; \
          acc = __builtin_amdgcn_mfma_f32_16x16x32_bf16(ld44(vrow, vrow + 32), __builtin_bit_cast(bf16x8, pw), acc, 0, 0, 0); } } \
      _Pragma("unroll") for (int ks = 0; ks < 4; ++ks) { \
        const bf16x8 a = ld8(bufc + O_ST + ((eb * 16 + fr) * LQ + 32 * ks + 8 * fq) * 2); \
        acc = __builtin_amdgcn_mfma_f32_16x16x32_bf16(a, qt[ks], acc, 0, 0, 0); } \
      int r0; HG_ROW0(c_, r0); const long row = r0 + sgn * (tb * 16 + fr) - NCTX; \
      st_bf16x4(O + row * 1024 + h * 128 + sl * 32 + eb * 16 + 4 * fq, acc); }        \
    { bf16x8 kh[2]; _Pragma("unroll") for (int ks = 0; ks < 2; ++ks) kh[ks] = ld8(bufc + O_KHT + ((wid * 16 + fr) * LS + 32 * ks + 8 * fq) * 2); \
    _Pragma("unroll") for (int eb = 0; eb < 2; ++eb) { f32x4 acc = S[eb] * dec; \
      _Pragma("unroll") for (int ks = 0; ks < 2; ++ks) { \
        const bf16x8 a = ld8(bufc + O_VT + ((eb * 16 + fr) * LS + 32 * ks + 8 * fq) * 2); \
        acc = __builtin_amdgcn_mfma_f32_16x16x32_bf16(a, kh[ks], acc, 0, 0, 0); } \
      S[eb] = acc; } } } while (0)
#define HG_STEP(c_, LATC_, LATN_, FLD_) do { HG_LOAD((c_) + 2 < 68 ? (c_) + 2 : 67, gN, qN, vN); if (fill && (c_) > 0 && (c_) <= FILL_HG) fill_store(p, wg, (c_) - 1, ((c_) - 1) & 1); \
    HG_MMA(c_, LATC_); HG_ELEM((c_) + 1, LATN_); if (fill && (c_) < FILL_HG) { fill_write(FLD_, (c_) & 1); if ((c_) + 2 < FILL_HG) fill_load(p, wg, (c_) + 2, FLD_); } __syncthreads(); \
    _Pragma("unroll") for (int ii = 0; ii < 8; ++ii) { g[ii] = gN[ii]; q[ii] = qN[ii]; } v = vN; } while (0)
  f32x4 fldA[4], fldB[4];
  if (fill && FILL_HG > 0) { fill_load(p, wg, 0, fldA); if (FILL_HG > 1) fill_load(p, wg, 1, fldB); }
  HG_LOAD(0, g, q, v);
  HG_ELEM(0, false);
  HG_LOAD(1, g, q, v);
  __syncthreads();
  HG_STEP(0, false, false, fldA); HG_STEP(1, false, false, fldB); HG_STEP(2, false, false, fldA);
  HG_STEP(3, false, true, fldB);
#pragma unroll 1
  for (int c = 4; c < 66; c += 2) { HG_STEP(c, true, true, fldA); HG_STEP(c + 1, true, true, fldB); }
  HG_STEP(66, true, true, fldA);
  HG_MMA(67, true);
  __syncthreads();
  if (fill && FILL_HG == 67) fill_store(p, wg, 66, 0);
#undef HG_ELEM
#undef HG_MMA
#undef HG_STEP
#undef HG_ROW0
#undef HG_LOAD
}
}

#define XB_TMO      128
#define XB_XCNT(j)  (256  + 64 * (j))
#define XB_XSUB(j)  (1280 + 64 * (j))
#define XB_XGEN(j)  (2304 + 64 * (j))
#define XB_TOP      3328
#define XB_TOPGEN   3392
#define XCD_BAR_WORDS 3456
#define XB_SPIN_CAP (1u << 21)

__device__ __forceinline__ unsigned xb_ld(unsigned* p)              { return __hip_atomic_load(p, __ATOMIC_RELAXED, __HIP_MEMORY_SCOPE_AGENT); }
__device__ __forceinline__ unsigned xb_add(unsigned* p, unsigned v) { return __hip_atomic_fetch_add(p, v, __ATOMIC_RELAXED, __HIP_MEMORY_SCOPE_AGENT); }
__device__ __forceinline__ unsigned xb_xcc_id() { return (unsigned)__builtin_amdgcn_s_getreg((3 << 11) | 20) & 0xFu; }
#define XB_SPIN(cond, bar) do { unsigned _sp = 0; while (cond) { __builtin_amdgcn_s_sleep(1); \
    if ((++_sp & 255u) == 0u) { if (xb_ld(&(bar)[XB_TMO])) break; if (_sp > XB_SPIN_CAP) { atomicAdd(&(bar)[XB_TMO], 1u); break; } } } } while (0)

struct XcdBarrier {
    unsigned* bar; unsigned x;
    volatile LAS unsigned* st;
};

__device__ __forceinline__ XcdBarrier xcd_barrier_post(unsigned* bar, volatile LAS unsigned* st) {
    XcdBarrier b; b.bar = bar; b.x = xb_xcc_id(); b.st = st;
    if (threadIdx.x == 0) (void)xb_add(&bar[XB_XCNT(b.x)], 1u);
    return b;
}
__device__ __forceinline__ void xcd_barrier_complete(unsigned* bar, unsigned x, unsigned& nloc, unsigned& nx) {
    const unsigned G = gridDim.x * gridDim.y * gridDim.z;
    unsigned sum, cnt, mine, sp = 0u;
    for (;;) {
        sum = 0u; cnt = 0u; mine = 0u;
#pragma unroll
        for (unsigned j = 0; j < 16; ++j) { const unsigned c = xb_ld(&bar[XB_XCNT(j)]); sum += c; cnt += (c > 0u) ? 1u : 0u; mine = (j == x) ? c : mine; }
        if (sum == G) break;
        __builtin_amdgcn_s_sleep(1);
        if ((++sp & 255u) == 0u) { if (xb_ld(&bar[XB_TMO])) break; if (sp > XB_SPIN_CAP) { atomicAdd(&bar[XB_TMO], 1u); break; } }
    }
    nloc = mine > 0u ? mine : 1u; nx = cnt > 0u ? cnt : 1u;
}

__device__ __forceinline__ void xcd_barrier(const XcdBarrier& b) {
    asm volatile("s_waitcnt vmcnt(0)" ::: "memory");
    __syncthreads();
    if (threadIdx.x == 0) {
        unsigned* bar = b.bar;
        __builtin_amdgcn_s_waitcnt(0);
        unsigned nloc = b.st[0], nx = b.st[1];
        if (nloc == 0u) { xcd_barrier_complete(bar, b.x, nloc, nx); b.st[0] = nloc; b.st[1] = nx; }
        const unsigned old = xb_add(&bar[XB_XSUB(b.x)], 1u);
        const unsigned gen = old / nloc;
        if (old + 1u == (gen + 1u) * nloc) {
            __builtin_amdgcn_fence(__ATOMIC_RELEASE, "agent");
            asm volatile("s_waitcnt vmcnt(0)" ::: "memory");
            const unsigned og = xb_add(&bar[XB_TOP], 1u);
            const unsigned tg = og / nx;
            if (og + 1u == (tg + 1u) * nx) xb_add(&bar[XB_TOPGEN], 1u);
            else XB_SPIN(xb_ld(&bar[XB_TOPGEN]) == tg, bar);
            __builtin_amdgcn_fence(__ATOMIC_ACQUIRE, "agent");
            xb_add(&bar[XB_XGEN(b.x)], 1u);
            asm volatile("s_waitcnt vmcnt(0)" ::: "memory");
        } else {
            XB_SPIN(xb_ld(&bar[XB_XGEN(b.x)]) == gen, bar);
            __builtin_amdgcn_fence(__ATOMIC_ACQUIRE, "agent");
            asm volatile("s_waitcnt vmcnt(0)" ::: "memory");
        }
    }
    __syncthreads();
}


constexpr int LDS_MAX = 160 * 1024;
constexpr int XB_LDS_OFF = LDS_MAX - 16;

__global__ void __launch_bounds__(NT, 2) k_mega(Params p) {
  extern __shared__ __attribute__((aligned(16))) char shm[];
  const int wg = blockIdx.x, nwg = gridDim.x;
  CParams* kp = KARGS;
  if (threadIdx.x == 0) *(uint4*)(shm + XB_LDS_OFF) = make_uint4(0u, 0u, 0u, 0u);
  __syncthreads();
  XcdBarrier bar = xcd_barrier_post(kp->bar, (volatile LAS unsigned*)(shm + XB_LDS_OFF));
  phase0(*launder(kp), wg, nwg);
  xcd_barrier(bar);
  phase1_rows(*launder(kp), wg, nwg);
  xcd_barrier(bar);
  phase2_inproj(*launder(kp), wg, nwg);
  xcd_barrier(bar);
  phase3_rows(*launder(kp), wg, nwg);
  xcd_barrier(bar);
  phase4_up(*launder(kp), wg, nwg);
  xcd_barrier(bar);
  if (nwg == 256) {
    const int x = wg & 7, y = wg >> 3; const bool late = (y >> 2) & 1;
    if (!late) hg::hgrn_unit(*launder(kp), 4 * (x + 8 * (y >> 2)) + (y & 3), wg, true);
    phase5a_attn(*launder(kp), 16 * (2 * x + (y >> 4)) + (y & 15), wg, FILL_HG, FILL_A0);
    if (late) hg::hgrn_unit(*launder(kp), 4 * (x + 8 * (y >> 2)) + (y & 3), wg, true);
    phase5a_attn(*launder(kp), 16 * (16 + 2 * x + (y >> 4)) + (y & 15), wg, FILL_HG + FILL_A0, FILL_A1);
  } else {
    for (int u = wg; u < 256; u += nwg) hg::hgrn_unit(*launder(kp), u, wg, false);
    for (int u = wg; u < 512; u += nwg) phase5a_attn(*launder(kp), u);
  }
  xcd_barrier(bar);
  phase5c_rec(*launder(kp), wg, nwg);
  xcd_barrier(bar);
  phase6_outproj(*launder(kp), wg, nwg);
  xcd_barrier(bar);
  phase7_post<true>(*launder(kp), wg, nwg);
  xcd_barrier(bar);
  phase_moe<0>(*launder(kp), wg, nwg);
  xcd_barrier(bar);
  phase_moe<1>(*launder(kp), wg, nwg);
  xcd_barrier(bar);
  phase11_final(*launder(kp), wg, nwg);
}

static size_t carve(size_t& off, size_t bytes) { const size_t o = off; off += (bytes + 255) & ~(size_t)255; return o; }

extern "C" void kernel_launch(void* const* d_in, const int* in_sizes, int n_in, void* d_out, int out_size, void* d_ws, size_t ws_size, hipStream_t stream) {
  Params p{};
  p.x = (const float*)d_in[0]; p.c = (const float*)d_in[1]; p.ctx = (const float*)d_in[2]; p.c_ctx = (const float*)d_in[3]; p.w_mod = (const float*)d_in[4]; p.b_mod = (const float*)d_in[5];
  p.ln_mix_pre = (const float*)d_in[6]; p.ln_mix_post = (const float*)d_in[7]; p.ln_ffn_pre = (const float*)d_in[8]; p.ln_ffn_post = (const float*)d_in[9]; p.w_in = (const float*)d_in[10];
  p.q_norm = (const float*)d_in[11]; p.kv_norm = (const float*)d_in[12]; p.w_uq = (const float*)d_in[13]; p.w_ukv = (const float*)d_in[14]; p.hgrn_lb = (const float*)d_in[15];
  p.g_norm = (const float*)d_in[16]; p.w_out = (const float*)d_in[17]; p.router_w = (const float*)d_in[18]; p.router_b = (const float*)d_in[19]; p.w_gu = (const float*)d_in[20];
  p.b_gu = (const float*)d_in[21]; p.w_dn = (const float*)d_in[22]; p.b_dn = (const float*)d_in[23];
  p.out = (float*)d_out;
  char* ws = (char*)d_ws; size_t off = 0;
  p.bar = (unsigned*)(ws + carve(off, 16384));
  p.cnt = (int*)(ws + carve(off, NE * CNT_LD * 4));
  const size_t zero_bytes = off;
  p.wt_in = (bf16_t*)(ws + carve(off, (size_t)INCP * 2048 * 2)); p.wt_uq = (bf16_t*)(ws + carve(off, (size_t)1536 * 512 * 2)); p.wt_ukv = (bf16_t*)(ws + carve(off, (size_t)2048 * 256 * 2));
  p.wt_out = (bf16_t*)(ws + carve(off, (size_t)2048 * 2048 * 2)); p.wt_gu8 = (unsigned char*)(ws + carve(off, (size_t)NE * 4096 * 2048)); p.wt_dn8 = (unsigned char*)(ws + carve(off, (size_t)NE * 2048 * 2048));
  p.mod = (float*)(ws + carve(off, 5 * 12288 * 4)); p.rope = (float*)(ws + carve(off, 4096 * 64 * 4));
  p.h = (bf16_t*)(ws + carve(off, (size_t)NROW * DM * 2));
  p.cq = (bf16_t*)(ws + carve(off, (size_t)NLAT * QRANK * 2)); p.cqn = (bf16_t*)(ws + carve(off, (size_t)NLAT * QRANK * 2));
  p.ckv = (bf16_t*)(ws + carve(off, (size_t)NROW * KVRANK * 2)); p.ckvn = (bf16_t*)(ws + carve(off, (size_t)NROW * KVRANK * 2));
  p.kr = (float*)(ws + carve(off, (size_t)NROW * ROPE * 4));
  p.qh = (bf16_t*)(ws + carve(off, (size_t)NROW * 1024 * 2)); p.gf = (float*)(ws + carve(off, (size_t)NROW * 1024 * 4)); p.gb = (float*)(ws + carve(off, (size_t)NROW * 1024 * 4));
  p.vh = (bf16_t*)(ws + carve(off, (size_t)NROW * 1024 * 2)); p.gate = (bf16_t*)(ws + carve(off, (size_t)NROW * 1024 * 2));
  p.qf = (bf16_t*)(ws + carve(off, (size_t)NBATCH * NH * SEQ * QK * 2)); p.kf = (bf16_t*)(ws + carve(off, (size_t)NBATCH * NH * KEYS * QK * 2)); p.vf = (bf16_t*)(ws + carve(off, (size_t)NBATCH * NH * KEYS * DV * 2));
  p.aout = (bf16_t*)(ws + carve(off, (size_t)NLAT * DM * 2)); p.of = (bf16_t*)(ws + carve(off, (size_t)NLAT * 1024 * 2)); p.ob = (bf16_t*)(ws + carve(off, (size_t)NLAT * 1024 * 2));
  p.mix = (bf16_t*)(ws + carve(off, (size_t)NLAT * DM * 2)); p.x1 = (bf16_t*)(ws + carve(off, (size_t)NLAT * DM * 2)); p.h2_8 = (unsigned char*)(ws + carve(off, (size_t)NLAT * DM));
  p.tok_e = (int*)(ws + carve(off, (size_t)NLAT * 4 * 4)); p.tok_pos = (int*)(ws + carve(off, (size_t)NLAT * 4 * 4)); p.tok_gate = (float*)(ws + carve(off, (size_t)NLAT * 4 * 4));
  p.idx = (int*)(ws + carve(off, (size_t)NE * NLAT * 4));
  p.act8 = (unsigned char*)(ws + carve(off, (size_t)MAXSLOT * DFF)); p.ys8 = (unsigned char*)(ws + carve(off, (size_t)MAXSLOT * DM));
  if (off > ws_size) { fprintf(stderr, "kernel_launch: workspace too small: need %zu have %zu\n", off, ws_size); return; }
  static int grid = 0;
  if (!grid) {
    if (hipFuncSetAttribute((const void*)k_mega, hipFuncAttributeMaxDynamicSharedMemorySize, LDS_MAX) != hipSuccess) { fprintf(stderr, "kernel_launch: hipFuncSetAttribute failed\n"); return; }
    int dev = 0, cus = 0, per_cu = 0;
    (void)hipGetDevice(&dev);
    (void)hipDeviceGetAttribute(&cus, hipDeviceAttributeMultiprocessorCount, dev);
    (void)hipOccupancyMaxActiveBlocksPerMultiprocessor(&per_cu, k_mega, NT, LDS_MAX);
    if (per_cu < 1 || cus < 1) { fprintf(stderr, "kernel_launch: occupancy query says %d blocks per CU on %d CUs\n", per_cu, cus); return; }
    grid = cus & ~15;
  }
  (void)hipMemsetAsync(ws, 0, zero_bytes, stream);
  hipLaunchKernelGGL(k_mega, dim3(grid), dim3(NT), LDS_MAX, stream, p);
  const hipError_t le = hipPeekAtLastError();
  if (le != hipSuccess) fprintf(stderr, "kernel_launch: launch failed: %s\n", hipGetErrorName(le));
}
```

```cpp
#include <hip/hip_runtime.h>
#include <stdint.h>
#include <stdio.h>

#define DEV __device__ __forceinline__
typedef unsigned short bf16_t;
typedef short bf16x8 __attribute__((ext_vector_type(8)));
typedef short s16x4 __attribute__((ext_vector_type(4)));
typedef float f32x4 __attribute__((ext_vector_type(4)));
typedef float f32x2 __attribute__((ext_vector_type(2)));
typedef float f32x16 __attribute__((ext_vector_type(16)));
typedef unsigned u32x4 __attribute__((ext_vector_type(4)));
typedef unsigned u32x2 __attribute__((ext_vector_type(2)));

constexpr int DM = 2048, NBATCH = 4, SEQ = 4096, CTX = 256, KEYS = CTX + SEQ;
constexpr int NLAT = NBATCH * SEQ, NCTX = NBATCH * CTX, NROW = NLAT + NCTX;
constexpr int NH = 8, QRANK = 512, KVRANK = 256, ROPE = 64, QK = 192, DV = 128, DK = 128;
constexpr int INC = 5952, INCP = 6144;
constexpr int NE = 32, TOPK = 4, DFF = 2048;
constexpr int MAXSLOT = 65536 + NE * 256;
constexpr int MAXTILES = MAXSLOT / 256;
constexpr int CNT_LD = 64;
constexpr int NT = 512;
constexpr float EPS = 1e-6f;
constexpr int FP8_WSCALE_LOG2_ = 6;

struct Params {
  const float *x, *c, *ctx, *c_ctx, *w_mod, *b_mod, *ln_mix_pre, *ln_mix_post, *ln_ffn_pre, *ln_ffn_post, *w_in, *q_norm, *kv_norm, *w_uq, *w_ukv, *hgrn_lb, *g_norm, *w_out,
      *router_w, *router_b, *w_gu, *b_gu, *w_dn, *b_dn;
  float* out;
  bf16_t *wt_in, *wt_uq, *wt_ukv, *wt_out;
  unsigned char *wt_gu8, *wt_dn8;
  unsigned char *h2_8, *act8;
  float* mod;
  float* rope;
  bf16_t* h;
  bf16_t *cq, *cqn;
  bf16_t *ckv, *ckvn;
  float* kr;
  bf16_t* qh;
  float *gf, *gb;
  bf16_t* vh;
  bf16_t* gate;
  bf16_t *qf, *kf, *vf;
  bf16_t* aout;
  bf16_t *of, *ob;
  bf16_t* mix;
  bf16_t* x1;
  int *tok_e, *tok_pos;
  float* tok_gate;
  int* cnt;
  int* idx;
  unsigned char* ys8;
  unsigned* bar;
};

DEV int ltid() { int t = threadIdx.x; asm volatile("" : "+v"(t)); return t; }
typedef const __attribute__((address_space(4))) Params CParams;
DEV CParams* launder(CParams* p) { asm volatile("" : "+s"(p)); return p; }
#define KARGS ((CParams*)__builtin_amdgcn_kernarg_segment_ptr())
typedef __bf16 bf16n2 __attribute__((ext_vector_type(2)));
DEV unsigned cvt_pk_bf16(float lo, float hi) { const f32x2 v = {lo, hi}; const bf16n2 r = __builtin_convertvector(v, bf16n2); return __builtin_bit_cast(unsigned, r); }
DEV unsigned cvt_pk4_fp8(f32x4 v) { unsigned r = 0; r = __builtin_amdgcn_cvt_pk_fp8_f32(v[0], v[1], r, false); r = __builtin_amdgcn_cvt_pk_fp8_f32(v[2], v[3], r, true); return r; }
DEV float bf2f(bf16_t v) { return __uint_as_float(((unsigned)v) << 16); }
DEV float bflo(unsigned v) { return __uint_as_float(v << 16); }
DEV float bfhi(unsigned v) { return __uint_as_float(v & 0xffff0000u); }
DEV bf16_t f2bf(float f) { const __bf16 r = (__bf16)f; return __builtin_bit_cast(bf16_t, r); }
DEV float wave_sum(float v) {
#pragma unroll
  for (int o = 32; o > 0; o >>= 1) v += __shfl_xor(v, o);
  return v;
}
DEV float sigmoidf_(float v) { return __builtin_amdgcn_rcpf(1.f + __builtin_amdgcn_exp2f(-1.4426950408889634f * v)); }
DEV float siluf_(float v) { return v * __builtin_amdgcn_rcpf(1.f + __builtin_amdgcn_exp2f(-1.4426950408889634f * v)); }

DEV void mod_unit(CParams& p, int u) {
  extern __shared__ __attribute__((aligned(16))) char shm[];
  float* sc = (float*)shm;
  float* red = (float*)(shm + 5 * 2048 * 4);
  const int tid = ltid(), wid = tid >> 6, lane = tid & 63, cl = lane & 15, kr = lane >> 4;
  for (int i = tid; i < 5 * 2048; i += NT) { const int v = i >> 11, k = i & 2047; const float cv = v < 4 ? p.c[v * 2048 + k] : p.c_ctx[k]; sc[i] = siluf_(cv); }
  __syncthreads();
  f32x4 acc[5];
#pragma unroll
  for (int v = 0; v < 5; ++v) acc[v] = (f32x4){0.f, 0.f, 0.f, 0.f};
  const float* wp = p.w_mod + (long)(wid * 256 + kr) * 12288 + u * 64 + cl * 4;
  const float* sp = sc + wid * 256 + kr;
#pragma unroll 1
  for (int k = 0; k < 256; k += 32) {
    f32x4 w[8];
#pragma unroll
    for (int j = 0; j < 8; ++j) w[j] = *(const f32x4*)(wp + (long)(k + 4 * j) * 12288);
#pragma unroll
    for (int j = 0; j < 8; ++j)
#pragma unroll
      for (int v = 0; v < 5; ++v) { const float s = sp[v * 2048 + k + 4 * j]; acc[v] += w[j] * s; }
  }
#pragma unroll
  for (int v = 0; v < 5; ++v)
#pragma unroll
    for (int j = 0; j < 4; ++j) { float a = acc[v][j]; a += __shfl_xor(a, 16); a += __shfl_xor(a, 32); acc[v][j] = a; }
  if (kr == 0) {
#pragma unroll
    for (int v = 0; v < 5; ++v) *(f32x4*)(red + (wid * 5 + v) * 64 + cl * 4) = acc[v];
  }
  __syncthreads();
  if (tid < 5 * 64) {
    const int v = tid >> 6, cc = tid & 63; float s = p.b_mod[u * 64 + cc];
#pragma unroll
    for (int w = 0; w < 8; ++w) s += red[(w * 5 + v) * 64 + cc];
    p.mod[v * 12288 + u * 64 + cc] = s;
  }
  __syncthreads();
}

DEV int perm_row(int perm, int n) {
  if (perm == 1) return n < 832 ? n : n + 192;
  if (perm == 2) { const int lin = n >= 2048 ? 1 : 0, j = n - lin * 2048; return (j >> 7) * 256 + lin * 128 + (j & 127); }
  return n;
}
struct CvtDesc { const float* src; void* dst; int ldsrc, N, lddst, k0, n0, perm, fp8; };
constexpr int U_MOD = 192, U_ROPE = 16;
constexpr int U_GU = NE * 16 * 32, U_DN = NE * 16 * 16, U_IN = 16 * 47, U_OUT = 16 * 16, U_UQ = 4 * 12, U_UKV = 2 * 16;
constexpr int U_CVT = U_GU + U_DN + U_IN + U_OUT + U_UQ + U_UKV;
DEV CvtDesc cvt_decode(CParams& p, int u) {
  CvtDesc d;
  if (u < U_GU) { const int e = u >> 9, r = u & 511, kt = r >> 5, nt = r & 31;
    d.src = p.w_gu + (long)e * 2048 * 4096; d.ldsrc = 4096; d.N = 4096; d.dst = p.wt_gu8 + (long)e * 4096 * 2048; d.lddst = 2048; d.k0 = kt * 128; d.n0 = nt * 128; d.perm = 2; d.fp8 = 1; return d; }
  u -= U_GU;
  if (u < U_DN) { const int e = u >> 8, r = u & 255, kt = r >> 4, nt = r & 15;
    d.src = p.w_dn + (long)e * 2048 * 2048; d.ldsrc = 2048; d.N = 2048; d.dst = p.wt_dn8 + (long)e * 2048 * 2048; d.lddst = 2048; d.k0 = kt * 128; d.n0 = nt * 128; d.perm = 0; d.fp8 = 1; return d; }
  u -= U_DN;
  if (u < U_IN) { const int kt = u / 47, nt = u % 47; d.src = p.w_in; d.ldsrc = INC; d.N = INC; d.dst = p.wt_in; d.lddst = 2048; d.k0 = kt * 128; d.n0 = nt * 128; d.perm = 1; d.fp8 = 0; return d; }
  u -= U_IN;
  if (u < U_OUT) { const int kt = u >> 4, nt = u & 15; d.src = p.w_out; d.ldsrc = 2048; d.N = 2048; d.dst = p.wt_out; d.lddst = 2048; d.k0 = kt * 128; d.n0 = nt * 128; d.perm = 0; d.fp8 = 0; return d; }
  u -= U_OUT;
  if (u < U_UQ) { const int kt = u / 12, nt = u % 12; d.src = p.w_uq; d.ldsrc = 1536; d.N = 1536; d.dst = p.wt_uq; d.lddst = 512; d.k0 = kt * 128; d.n0 = nt * 128; d.perm = 0; d.fp8 = 0; return d; }
  u -= U_UQ;
  { const int kt = u >> 4, nt = u & 15; d.src = p.w_ukv; d.ldsrc = 2048; d.N = 2048; d.dst = p.wt_ukv; d.lddst = 256; d.k0 = kt * 128; d.n0 = nt * 128; d.perm = 0; d.fp8 = 0; }
  return d;
}
DEV void cvt_load(const CvtDesc& d, f32x4 (&ld)[8]) {
  const int tid = ltid(), tx = tid & 31, ty = tid >> 5;
  const bool ok = (d.n0 + 4 * tx) < d.N;
#pragma unroll
  for (int x = 0; x < 8; ++x) {
    const int row = d.fp8 ? 4 * (ty + 16 * (x >> 2)) + (x & 3) : 2 * (ty + 16 * (x >> 1)) + (x & 1);
    const float* sp = d.src + (long)(d.k0 + row) * d.ldsrc + d.n0 + 4 * tx;
    ld[x] = ok ? __builtin_nontemporal_load((const f32x4*)sp) : (f32x4){0.f, 0.f, 0.f, 0.f};
  }
}
DEV void cvt_store(const CvtDesc& d, const f32x4 (&ld)[8]) {
  extern __shared__ __attribute__((aligned(16))) char shm[];
  unsigned* T = (unsigned*)shm;
  const int tid = ltid(), tx = tid & 31, ty = tid >> 5;
  if (d.fp8) {
    constexpr float WS = (float)(1 << FP8_WSCALE_LOG2_);
#pragma unroll
    for (int i = 0; i < 2; ++i) {
      const int q = ty + 16 * i;
#pragma unroll
      for (int j = 0; j < 4; ++j) T[(4 * tx + j) * 33 + q] = cvt_pk4_fp8((f32x4){ld[4 * i][j] * WS, ld[4 * i + 1][j] * WS, ld[4 * i + 2][j] * WS, ld[4 * i + 3][j] * WS});
    }
    __syncthreads();
#pragma unroll
    for (int j = 0; j < 2; ++j) {
      const int id = tid + NT * j, nl = id >> 3, cc = id & 7, n = d.n0 + nl;
      u32x4 v; v.x = T[nl * 33 + 4 * cc]; v.y = T[nl * 33 + 4 * cc + 1]; v.z = T[nl * 33 + 4 * cc + 2]; v.w = T[nl * 33 + 4 * cc + 3];
      if (n < d.N) *(u32x4*)((unsigned char*)d.dst + (long)perm_row(d.perm, n) * d.lddst + d.k0 + 16 * cc) = v;
    }
  } else {
#pragma unroll
    for (int i = 0; i < 4; ++i) {
      const int q = ty + 16 * i;
#pragma unroll
      for (int j = 0; j < 4; ++j) T[(4 * tx + j) * 65 + q] = cvt_pk_bf16(ld[2 * i][j], ld[2 * i + 1][j]);
    }
    __syncthreads();
#pragma unroll
    for (int j = 0; j < 4; ++j) {
      const int id = tid + NT * j, nl = id >> 4, cc = id & 15, n = d.n0 + nl;
      u32x4 v; v.x = T[nl * 65 + 4 * cc]; v.y = T[nl * 65 + 4 * cc + 1]; v.z = T[nl * 65 + 4 * cc + 2]; v.w = T[nl * 65 + 4 * cc + 3];
      if (n < d.N) *(u32x4*)((bf16_t*)d.dst + (long)perm_row(d.perm, n) * d.lddst + d.k0 + 8 * cc) = v;
    }
  }
  __syncthreads();
}
constexpr int FILL_LDS_OFF = 133120, FILL_TB = 128 * 17 * 4;
constexpr int FILL_HALVES = 2 * (NE * 16 * 32 + NE * 16 * 16);
#ifndef FILL_HG
#define FILL_HG 67
#endif
#ifndef FILL_A0
#define FILL_A0 63
#endif
#ifndef FILL_A1
#define FILL_A1 62
#endif
constexpr int FILL_SLOTS = FILL_HG + FILL_A0 + FILL_A1;
static_assert(FILL_HG <= 67 && FILL_A0 <= 68 && FILL_A1 <= 68 && FILL_SLOTS * 256 <= FILL_HALVES, "filler split");
struct FillDesc { const float* src; unsigned char* dst; int ldsrc, perm, n0, kh; };
DEV FillDesc fill_decode(CParams& p, int wg, int slot) {
  const int h = slot * 256 + wg, t = h >> 1, half = h & 1; FillDesc d;
  if (t < NE * 512) { const int e = t >> 9, r = t & 511; d.src = p.w_gu + (long)e * 2048 * 4096; d.ldsrc = 4096; d.dst = p.wt_gu8 + (long)e * 4096 * 2048; d.perm = 2; d.n0 = (r & 31) * 128 + 64 * half; d.kh = (r >> 5) * 128; }
  else { const int v = t - NE * 512, e = v >> 8, r = v & 255; d.src = p.w_dn + (long)e * 2048 * 2048; d.ldsrc = 2048; d.dst = p.wt_dn8 + (long)e * 2048 * 2048; d.perm = 0; d.n0 = (r & 15) * 128 + 64 * half; d.kh = (r >> 4) * 128; }
  return d;
}
DEV void fill_load(CParams& p, int wg, int slot, f32x4 (&ld)[4]) {
  const FillDesc d = fill_decode(p, wg, slot); const int tid = ltid(), tx = tid & 15, ty = tid >> 4;
  const float* sp = d.src + (long)(d.kh + 4 * ty) * d.ldsrc + d.n0 + 4 * tx;
#pragma unroll
  for (int r = 0; r < 4; ++r) ld[r] = *(const f32x4*)(sp + (long)r * d.ldsrc);
}
DEV void fill_write(const f32x4 (&ld)[4], int bufsel) {
  extern __shared__ __attribute__((aligned(16))) char shm[];
  unsigned* T = (unsigned*)(shm + FILL_LDS_OFF + bufsel * FILL_TB); const int tid = ltid(), tx = tid & 15, ty = tid >> 4;
  constexpr float WS = (float)(1 << FP8_WSCALE_LOG2_);
#pragma unroll
  for (int j = 0; j < 4; ++j) T[(4 * tx + j) * 33 + ty] = cvt_pk4_fp8((f32x4){ld[0][j] * WS, ld[1][j] * WS, ld[2][j] * WS, ld[3][j] * WS});
}
DEV void fill_store(CParams& p, int wg, int slot, int bufsel) {
  extern __shared__ __attribute__((aligned(16))) char shm[];
  const unsigned* T = (const unsigned*)(shm + FILL_LDS_OFF + bufsel * FILL_TB); const int tid = ltid(), nl = tid >> 3, cc = tid & 7;
  const FillDesc d = fill_decode(p, wg, slot);
  u32x4 v; v.x = T[nl * 33 + 4 * cc]; v.y = T[nl * 33 + 4 * cc + 1]; v.z = T[nl * 33 + 4 * cc + 2]; v.w = T[nl * 33 + 4 * cc + 3];
  *(u32x4*)(d.dst + (long)perm_row(d.perm, d.n0 + nl) * 2048 + d.kh + 16 * cc) = v;
}
DEV void rope_unit(CParams& p, int u) {
  for (int i = ltid(); i < 256 * 32; i += NT) {
    const int t = u * 256 + (i >> 5), a = i & 31; const int fi = a & 15;
    const float inv = powf(10000.0f, -(float)fi / 16.0f);
    const float pos = a < 16 ? (float)(t >> 6) : (float)(t & 63);
    const float ang = pos * inv; float s, c; sincosf(ang, &s, &c);
    p.rope[t * 64 + a] = c; p.rope[t * 64 + 32 + a] = s;
  }
}
DEV void phase0(CParams& p, int wg, int nwg) {
  if (wg < U_MOD) mod_unit(p, wg); else if (wg < U_MOD + U_ROPE) rope_unit(p, wg - U_MOD);
  if (nwg < U_MOD + U_ROPE) { for (int u = wg + nwg; u < U_MOD + U_ROPE; u += nwg) { if (u < U_MOD) mod_unit(p, u); else rope_unit(p, u - U_MOD); } }
  f32x4 ld[8], ld2[8];
  int u = (nwg == 256 ? FILL_SLOTS * 128 : 0) + wg;
  if (u < U_CVT) { const CvtDesc d = cvt_decode(p, u); cvt_load(d, ld); }
  for (; u < U_CVT; u += nwg) {
    const CvtDesc d = cvt_decode(p, u);
    const int un = u + nwg;
    if (un < U_CVT) { const CvtDesc dn = cvt_decode(p, un); cvt_load(dn, ld2); }
    cvt_store(d, ld);
#pragma unroll
    for (int i = 0; i < 8; ++i) ld[i] = ld2[i];
  }
}

DEV void phase1_rows(CParams& p, int wg, int nwg) {
  const int wid = ltid() >> 6, lane = ltid() & 63;
  for (int row = wg * 8 + wid; row < NROW; row += nwg * 8) {
    const float* xr; int v;
    if (row < NCTX) { xr = p.ctx + (long)row * DM; v = 4; } else { xr = p.x + (long)(row - NCTX) * DM; v = (row - NCTX) >> 12; }
    const float* sh = p.mod + v * 12288; const float* sc = sh + 2048;
    f32x4 xv[8]; float ss = 0.f;
#pragma unroll
    for (int i = 0; i < 8; ++i) { xv[i] = *(const f32x4*)(xr + i * 256 + lane * 4); ss += xv[i][0] * xv[i][0] + xv[i][1] * xv[i][1] + xv[i][2] * xv[i][2] + xv[i][3] * xv[i][3]; }
    ss = wave_sum(ss);
    const float rstd = rsqrtf(ss * (1.f / DM) + EPS);
#pragma unroll
    for (int i = 0; i < 8; ++i) {
      const int c0 = i * 256 + lane * 4;
      const f32x4 w = *(const f32x4*)(p.ln_mix_pre + c0), s1 = *(const f32x4*)(sc + c0), s0 = *(const f32x4*)(sh + c0);
      f32x4 y;
#pragma unroll
      for (int j = 0; j < 4; ++j) y[j] = xv[i][j] * rstd * w[j] * (1.f + s1[j]) + s0[j];
      u32x2 o; o.x = cvt_pk_bf16(y[0], y[1]); o.y = cvt_pk_bf16(y[2], y[3]);
      *(u32x2*)(p.h + (long)row * DM + c0) = o;
    }
  }
}
#define LAS __attribute__((address_space(3)))
constexpr int BM = 256, BK = 64, HALF = 128, HTB = HALF * BK * 2, GEMM_LDS = 8 * HTB;
constexpr int GEMM_AROW_OFF = GEMM_LDS;
constexpr int GEMM_BIAS_OFF = ((GEMM_AROW_OFF + 2 * 256 * 4 + (3 * MAXTILES + 2) * 4 + 15) / 16) * 16 + 2 * 9216;
DEV int lds_byte(int r, int c) { const int st = (r >> 4) * 2 + (c >> 5), rr = r & 15, cc = c & 31, ob = rr * 64 + cc * 2; return st * 1024 + (ob ^ (((ob >> 9) & 1) << 5)); }
DEV void stage_rc(int b, int& R, int& C) { const int st = b / 1024, sb = b % 1024, swz = sb ^ (((sb >> 9) & 1) << 5); R = (st >> 1) * 16 + swz / 64; C = (st & 1) * 32 + (swz % 64) / 2; }
typedef f32x4 AccT[2][2][4][2];
struct Unit { int pm, pn, e, r0, rv; };
typedef int i32x8 __attribute__((ext_vector_type(8)));
typedef int i32x4 __attribute__((ext_vector_type(4)));
DEV int g8(int r) { const int q = ((r & 15) >> 1) + 2; return 2 * (q & 3) + 1 - ((q >> 2) & 1); }
constexpr int FP8_WSCALE_LOG2 = FP8_WSCALE_LOG2_;
constexpr int FP8_SCALE_W = 0x01010101 * (127 - FP8_WSCALE_LOG2), FP8_SCALE_1 = 0x7f7f7f7f;

DEV void mfma_fp8(f32x4& acc, const i32x8& w, const i32x8& a, int sw, int sa) {
  asm volatile("v_mfma_scale_f32_16x16x128_f8f6f4 %0, %1, %2, %0, %3, %4 op_sel_hi:[0,0,0]" : "+v"(acc) : "v"(w), "v"(a), "v"(sw), "v"(sa));
}
template <class P>
DEV void gemm_stream(const P& pol) {
  extern __shared__ __attribute__((aligned(16))) char shm[];
  LAS unsigned char* lds = (LAS unsigned char*)shm;
  LAS int* arow = (LAS int*)(shm + GEMM_AROW_OFF);
  const int tid = ltid(), wid = __builtin_amdgcn_readfirstlane(tid >> 6), lane = tid & 63, wr = wid >> 2, wc = wid & 3, fr = lane & 15, fq = lane >> 4;
  const int KB = pol.KB, nt = KB / 128;
  Unit cur, nxt; int ui = 0;
  if (!pol.get(0, cur)) return;
  unsigned voffB[2], vAc[2][2];
#define G_SRC(i_, R_, C_) do { const int b_ = ltid() * 16 + (i_) * 8192; if (P::FP8) { R_ = b_ >> 7; C_ = (((b_ >> 4) & 7) ^ g8(R_)) << 4; } else { stage_rc(b_, R_, C_); C_ *= 2; } } while (0)
#define G_GATHER_OFFS(tab_, rv_) do { _Pragma("unroll") for (int i = 0; i < 2; ++i) { int R_, C_; G_SRC(i, R_, C_); const int ra_ = (tab_)[R_], rb_ = (tab_)[HALF + R_];        \
    vAc[0][i] = (unsigned)((R_ < (rv_) ? ra_ : 0) * KB + C_); vAc[1][i] = (unsigned)((HALF + R_ < (rv_) ? rb_ : 0) * KB + C_); } } while (0)
#pragma unroll
  for (int i = 0; i < 2; ++i) { int R_, C_; G_SRC(i, R_, C_); const int rho = R_ & 31, Rb = (R_ & ~31) + 8 * ((rho & 15) >> 2) + 4 * (rho >> 4) + (rho & 3); voffB[i] = (unsigned)(Rb * KB + C_); }
  if (P::GATHER) {
    pol.arow_fill(cur, (int*)(shm + GEMM_AROW_OFF));
    __syncthreads();
    G_GATHER_OFFS(arow, cur.rv);
  } else {
#pragma unroll
    for (int i = 0; i < 2; ++i) { int R_, C_; G_SRC(i, R_, C_); vAc[0][i] = (unsigned)(R_ * KB + C_); vAc[1][i] = vAc[0][i]; }
  }
  const size_t kstep = 128, hstep = (size_t)HALF * KB;
  const unsigned ldsw = (unsigned)wid * 1024u;
  const int aoff = P::FP8 ? (wr * 64 + fr) * 128 + (((2 * fq) ^ g8(fr)) << 4) : lds_byte(wr * 64 + fr, fq * 8);
  const int boff = P::FP8 ? (wc * 32 + fr) * 128 + (((2 * fq) ^ g8(fr)) << 4) : lds_byte(wc * 32 + fr, fq * 8);
  const int aoff1 = (wr * 64 + fr) * 128 + (((2 * fq + 1) ^ g8(fr)) << 4), boff1 = (wc * 32 + fr) * 128 + (((2 * fq + 1) ^ g8(fr)) << 4);
#define G_SA(b, h) (((b) * 2 + (h)) * HTB)
#define G_SB(b, h) ((4 + (b) * 2 + (h)) * HTB)
#define G_STAGE(bufoff, gbase, voff) do { _Pragma("unroll") for (int _i = 0; _i < 2; ++_i) \
    __builtin_amdgcn_global_load_lds((const unsigned*)((const char*)(gbase) + (voff)[_i]), (LAS unsigned*)(lds + (bufoff) + ldsw + _i * 8192), 16, 0, 0); } while (0)
#define G_LD2(o0, o1) __builtin_shufflevector(*(const LAS i32x4*)(lds + (o0)), *(const LAS i32x4*)(lds + (o1)), 0, 1, 2, 3, 4, 5, 6, 7)
#define G_LDA(dst, b, h) do { _Pragma("unroll") for (int m = 0; m < 4; ++m) dst[m] = G_LD2(G_SA(b, h) + aoff + m * 2048, G_SA(b, h) + (P::FP8 ? aoff1 : aoff + 1024) + m * 2048); } while (0)
#define G_LDB(dst, b, h) do { _Pragma("unroll") for (int n = 0; n < 2; ++n) dst[n] = G_LD2(G_SB(b, h) + boff + n * 2048, G_SB(b, h) + (P::FP8 ? boff1 : boff + 1024) + n * 2048); } while (0)
#define G_LO(x_) __builtin_bit_cast(bf16x8, __builtin_shufflevector(x_, x_, 0, 1, 2, 3))
#define G_HI(x_) __builtin_bit_cast(bf16x8, __builtin_shufflevector(x_, x_, 4, 5, 6, 7))
#define G_MMA(ai, bj, At_, Bt_) do { if (P::ROWSKIP && rvw <= 128 * (ai)) break;        \
    __builtin_amdgcn_s_setprio(1); _Pragma("unroll") for (int m = 0; m < 4; ++m) _Pragma("unroll") for (int n = 0; n < 2; ++n) { \
    if (P::FP8) mfma_fp8(acc[ai][bj][m][n], Bt_[n], At_[m], sclw, scla); \
    else { acc[ai][bj][m][n] = __builtin_amdgcn_mfma_f32_16x16x32_bf16(G_LO(Bt_[n]), G_LO(At_[m]), acc[ai][bj][m][n], 0, 0, 0); \
           acc[ai][bj][m][n] = __builtin_amdgcn_mfma_f32_16x16x32_bf16(G_HI(Bt_[n]), G_HI(At_[m]), acc[ai][bj][m][n], 0, 0, 0); } } \
    __builtin_amdgcn_s_setprio(0); } while (0)
#define G_ZERO() do { _Pragma("unroll") for (int a_ = 0; a_ < 2; ++a_) _Pragma("unroll") for (int b_ = 0; b_ < 2; ++b_) _Pragma("unroll") for (int m_ = 0; m_ < 4; ++m_) _Pragma("unroll") for (int n_ = 0; n_ < 2; ++n_) \
    acc[a_][b_][m_][n_] = (f32x4){0.f, 0.f, 0.f, 0.f}; } while (0)
#define WAIT_V(n) asm volatile("s_waitcnt vmcnt(" #n ")" ::: "memory")
#define WAIT_L(n) asm volatile("s_waitcnt lgkmcnt(" #n ")" ::: "memory")
#define BAR __builtin_amdgcn_s_barrier()
#define SCHED __builtin_amdgcn_sched_barrier(0)
  int sclw = P::SCALE_B, scla = P::SCALE_A;
  f32x4 acc[2][2][4][2];
  f32x4 bv[2][2];
  LAS float* btab = (LAS float*)(shm + GEMM_BIAS_OFF);
#define G_BIAS(tab_) do { _Pragma("unroll") for (int b_ = 0; b_ < 2; ++b_) _Pragma("unroll") for (int n_ = 0; n_ < 2; ++n_) { bv[b_][n_] = *(const LAS f32x4*)((tab_) + 128 * b_ + 32 * wc + 8 * fq + 4 * n_); \
    if (b_ == 1 && P::BIAS_LIN1) bv[b_][n_] = bv[b_][n_] + 1.0f; } } while (0)
#define G_INIT() do { _Pragma("unroll") for (int a_ = 0; a_ < 2; ++a_) _Pragma("unroll") for (int b_ = 0; b_ < 2; ++b_) _Pragma("unroll") for (int m_ = 0; m_ < 4; ++m_) _Pragma("unroll") for (int n_ = 0; n_ < 2; ++n_) \
    acc[a_][b_][m_][n_] = bv[b_][n_]; } while (0)
  if (P::HASBIAS) { pol.bias_fill(cur, (float*)(shm + GEMM_BIAS_OFF)); __syncthreads(); G_BIAS(btab); G_INIT(); } else G_ZERO();
  i32x8 At[4], B0[2], B1[2];
  int rvw = P::ROWSKIP ? cur.rv - 64 * wr : 256;
  const char* cA0 = pol.abase(cur, 0); const char* cA1 = pol.abase(cur, 1); const char* cB = pol.bbase(cur);
  G_STAGE(G_SB(0, 0), cB, voffB); G_STAGE(G_SA(0, 0), cA0, vAc[0]); G_STAGE(G_SB(0, 1), cB + hstep, voffB); G_STAGE(G_SA(0, 1), cA1, vAc[1]);
  if (wr == 1) BAR;
  WAIT_V(4); BAR;
  G_STAGE(G_SB(1, 0), cB + kstep, voffB); G_STAGE(G_SA(1, 0), cA0 + kstep, vAc[0]); G_STAGE(G_SB(1, 1), cB + hstep + kstep, voffB);
  WAIT_V(6); BAR;
  for (;;) {
    const bool has_next = pol.get(ui + 1, nxt);
    const char* nA0 = has_next ? pol.abase(nxt, 0) : cA0; const char* nA1 = has_next ? pol.abase(nxt, 1) : cA1; const char* nB = has_next ? pol.bbase(nxt) : cB;
    for (int t = 0; t < nt; t += 2) {
      const bool last = (t == nt - 2);
      const size_t k1 = (size_t)(t + 1) * kstep, k2 = (size_t)(t + 2) * kstep;
      const char* a20 = last ? nA0 : cA0 + k2; const char* a21 = last ? nA1 : cA1 + k2; const char* b2 = last ? nB : cB + k2;
      G_LDB(B0, 0, 0); SCHED; G_LDA(At, 0, 0); G_STAGE(G_SA(1, 1), cA1 + k1, vAc[1]);
      WAIT_L(8); BAR; WAIT_L(0); G_MMA(0, 0, At, B0); BAR; SCHED;
      if (P::GATHER && last && has_next) { LAS int* tab = arow + ((ui + 1) & 1) * 256; G_GATHER_OFFS(tab, nxt.rv); }
      G_LDB(B1, 0, 1); G_STAGE(G_SB(0, 0), b2, voffB);
      BAR; WAIT_L(0); G_MMA(0, 1, At, B1); BAR;
      G_LDA(At, 0, 1); G_STAGE(G_SA(0, 0), a20, vAc[0]);
      BAR; WAIT_L(0); G_MMA(1, 0, At, B0); BAR; SCHED;
      G_STAGE(G_SB(0, 1), b2 + hstep, voffB);
      WAIT_V(6); BAR; G_MMA(1, 1, At, B1); BAR;
      G_LDB(B0, 1, 0); SCHED; G_LDA(At, 1, 0); G_STAGE(G_SA(0, 1), a21, vAc[1]);
      WAIT_L(8); BAR; WAIT_L(0); G_MMA(0, 0, At, B0); BAR; SCHED;
      G_LDB(B1, 1, 1); G_STAGE(G_SB(1, 0), b2 + kstep, voffB);
      BAR; WAIT_L(0); G_MMA(0, 1, At, B1); BAR;
      G_LDA(At, 1, 1); G_STAGE(G_SA(1, 0), a20 + kstep, vAc[0]);
      BAR; WAIT_L(0); G_MMA(1, 0, At, B0); BAR; SCHED;
      G_STAGE(G_SB(1, 1), b2 + hstep + kstep, voffB);
      WAIT_V(6); BAR; G_MMA(1, 1, At, B1); BAR;
      if (P::HASBIAS && has_next && t == 0) pol.bias_dma(nxt, btab + ((ui + 1) & 1) * 256 + ((wid & 3) << 6));
      if (P::GATHER && has_next && t == 0) pol.arow_dma(nxt, arow + ((ui + 1) & 1) * 256 + ((wid & 3) << 6));
    }
    if (P::FP8) asm volatile("s_nop 7\n\ts_nop 7" ::: "memory");
    pol.epi(cur, acc, wr, wc, fr, fq);
    if (!has_next) break;
    if (P::HASBIAS) { G_BIAS(btab + ((ui + 1) & 1) * 256); G_INIT(); } else G_ZERO();
    cur = nxt; cA0 = nA0; cA1 = nA1; cB = nB; ++ui;
    if (P::ROWSKIP) rvw = cur.rv - 64 * wr;
  }
  WAIT_V(0);
  if (wr == 0) BAR;
  __syncthreads();
#undef G_SA
#undef G_SB
#undef G_STAGE
#undef G_LDA
#undef G_LDB
#undef G_MMA
#undef G_LD2
#undef G_SRC
#undef G_GATHER_OFFS
#undef G_LO
#undef G_HI
#undef G_ZERO
#undef G_INIT
#undef G_BIAS
}

constexpr int MOE_TAB_OFF_ = GEMM_AROW_OFF + 2 * 256 * 4;
DEV void st_bf16x4(bf16_t* p, f32x4 v) { u32x2 o; o.x = cvt_pk_bf16(v[0], v[1]); o.y = cvt_pk_bf16(v[2], v[3]); *(u32x2*)p = o; }
DEV void st_bf16x8(bf16_t* p, f32x4 a, f32x4 b) { u32x4 o; o.x = cvt_pk_bf16(a[0], a[1]); o.y = cvt_pk_bf16(a[2], a[3]); o.z = cvt_pk_bf16(b[0], b[1]); o.w = cvt_pk_bf16(b[2], b[3]); *(u32x4*)p = o; }
DEV void st_fp8x8(unsigned char* p, f32x4 a, f32x4 b) { u32x2 o; o.x = cvt_pk4_fp8(a); o.y = cvt_pk4_fp8(b); *(u32x2*)p = o; }

DEV f32x4 sig4(f32x4 v) {
  const f32x4 t = v * -1.4426950408889634f; f32x4 e;
#pragma unroll
  for (int j = 0; j < 4; ++j) e[j] = __builtin_amdgcn_exp2f(t[j]);
  e = e + 1.0f; f32x4 r;
#pragma unroll
  for (int j = 0; j < 4; ++j) r[j] = __builtin_amdgcn_rcpf(e[j]);
  return r;
}
struct EpiIn {
  CParams* p; int pm, pn;
  template <int KIND> DEV void run(const AccT& acc, int wr, int wc, int fr, int fq) const;
  DEV void operator()(const AccT& acc, int wr, int wc, int fr, int fq) const {
    if (pn < 2) run<0>(acc, wr, wc, fr, fq); else if (pn == 2) run<1>(acc, wr, wc, fr, fq); else if (pn == 3) run<2>(acc, wr, wc, fr, fq);
    else if (pn < 8 || pn >= 20) run<3>(acc, wr, wc, fr, fq); else if (pn < 16) run<4>(acc, wr, wc, fr, fq); else run<5>(acc, wr, wc, fr, fq);
  }
};
DEV void row_to_bkey(int row, int& b, int& key) { if (row < NCTX) { b = row >> 8; key = row & 255; } else { const int r = row - NCTX; b = r >> 12; key = CTX + (r & 4095); } }

struct EpiKV {
  CParams* p; int pm, pn;
  DEV void operator()(const AccT& acc, int wr, int wc, int fr, int fq) const {
    CParams& P = *launder(p); const int row0 = pm * BM + wr * 64 + fr;
#pragma unroll
    for (int ai = 0; ai < 2; ++ai)
#pragma unroll
      for (int m = 0; m < 4; ++m) {
        const int row = row0 + ai * HALF + m * 16; int b, key; row_to_bkey(row, b, key);
        const long bh = (long)(b * NH + pn) * KEYS + key; const int c = wc * 32 + 8 * fq;
        st_bf16x8(P.kf + bh * QK + c, acc[ai][0][m][0], acc[ai][0][m][1]);
        st_bf16x8(P.vf + bh * DV + c, acc[ai][1][m][0], acc[ai][1][m][1]);
      }
  }
};
struct EpiQ {
  CParams* p; int pm, pn;
  DEV void operator()(const AccT& acc, int wr, int wc, int fr, int fq) const {
    CParams& P = *launder(p); const int row0 = pm * BM + wr * 64 + fr;
#pragma unroll
    for (int ai = 0; ai < 2; ++ai)
#pragma unroll
      for (int m = 0; m < 4; ++m) {
        const int row = row0 + ai * HALF + m * 16, b = row >> 12, t = row & 4095;
#pragma unroll
        for (int bj = 0; bj < 2; ++bj) {
          const int col = pn * 256 + bj * HALF + wc * 32 + 8 * fq, hh = col / QK, e = col - hh * QK;
          st_bf16x8(P.qf + ((long)(b * NH + hh) * SEQ + t) * QK + e, acc[ai][bj][m][0], acc[ai][bj][m][1]);
        }
      }
  }
};
struct EpiOut {
  CParams* p; int pm, pn;
  DEV void operator()(const AccT& acc, int wr, int wc, int fr, int fq) const;
};
constexpr int STG_OFF = ((MOE_TAB_OFF_ + (3 * MAXTILES + 2) * 4 + 15) / 16) * 16, STG_HALF = 9216;
static_assert(GEMM_BIAS_OFF == STG_OFF + 2 * STG_HALF, "bias tables sit right behind the staging region");
template <int LB> DEV void stage_store_block(const unsigned (&v)[4][LB / 4], unsigned char* dst, long row_stride) {
  extern __shared__ __attribute__((aligned(16))) char shm[];
  constexpr int MP = LB == 8 ? 4 : (LB == 16 ? 2 : 1), PITCH = 16 * LB + 16, ROWS = 16 * MP;
  static_assert(ROWS * PITCH <= STG_HALF, "staging region");
  const int tid = ltid(), wr = tid >> 8, wc = (tid >> 6) & 3, fr = tid & 15, fq = (tid >> 4) & 3;
  char* stg = shm + STG_OFF + wr * STG_HALF;
  const int t4 = tid & 255;
#pragma unroll
  for (int ps = 0; ps < 4 / MP; ++ps) {
#pragma unroll
    for (int mm = 0; mm < MP; ++mm) {
      char* wp = stg + (16 * mm + fr) * PITCH + (4 * wc + fq) * LB; const int m = ps * MP + mm;
      if (LB == 8) *(u32x2*)wp = (u32x2){v[m][0], v[m][1]};
      else { *(u32x4*)wp = (u32x4){v[m][0], v[m][1], v[m][2], v[m][3]}; if (LB == 32) *(u32x4*)(wp + 16) = (u32x4){v[m][LB / 4 - 4], v[m][LB / 4 - 3], v[m][LB / 4 - 2], v[m][LB / 4 - 1]}; }
    }
    asm volatile("s_waitcnt lgkmcnt(0)" ::: "memory"); __builtin_amdgcn_s_barrier(); asm volatile("" ::: "memory");
#pragma unroll
    for (int k = 0; k < 2; ++k) { const int idx = k * 256 + t4, row = idx / LB, ch = idx % LB;
      *(u32x4*)(dst + (long)(ps * ROWS + row) * row_stride + ch * 16) = *(const u32x4*)(stg + row * PITCH + ch * 16); }
    asm volatile("s_waitcnt lgkmcnt(0)" ::: "memory"); __builtin_amdgcn_s_barrier(); asm volatile("" ::: "memory");
  }
}
DEV void pk_bf16x8(unsigned (&o)[4], f32x4 a, f32x4 b) { o[0] = cvt_pk_bf16(a[0], a[1]); o[1] = cvt_pk_bf16(a[2], a[3]); o[2] = cvt_pk_bf16(b[0], b[1]); o[3] = cvt_pk_bf16(b[2], b[3]); }
DEV void pk_f32x8(unsigned (&o)[8], f32x4 a, f32x4 b) {
#pragma unroll
  for (int j = 0; j < 4; ++j) { o[j] = __float_as_uint(a[j]); o[4 + j] = __float_as_uint(b[j]); } }
template <int KIND> DEV void EpiIn::run(const AccT& acc, int wr, int wc, int fr, int fq) const {
  CParams& P = *launder(p);
  const int rowh = pm * BM + wr * 64;
  if (KIND == 2) {
#pragma unroll
    for (int ai = 0; ai < 2; ++ai)
#pragma unroll
      for (int m = 0; m < 4; ++m) { const int row = rowh + fr + ai * HALF + m * 16, c = wc * 32 + 8 * fq;
        if (c < 64) { *(f32x4*)(P.kr + (long)row * ROPE + c) = acc[ai][0][m][0]; *(f32x4*)(P.kr + (long)row * ROPE + c + 4) = acc[ai][0][m][1]; } }
    return;
  }
  if (KIND == 0 && pm < 4) return;
  f32x4 lbv[2][2], oml[2][2];
  if (KIND == 4) {
    const int dir = (pn - 8) >> 2;
#pragma unroll
    for (int bj = 0; bj < 2; ++bj)
#pragma unroll
      for (int n = 0; n < 2; ++n) {
        const int col = ((pn - 8) & 3) * 256 + bj * HALF + wc * 32 + 8 * fq + 4 * n;
        const f32x4 a0 = *(const f32x4*)(P.hgrn_lb + dir * 2048 + col), a1 = *(const f32x4*)(P.hgrn_lb + dir * 2048 + 1024 + col);
#pragma unroll
        for (int j = 0; j < 4; ++j) lbv[bj][n][j] = sigmoidf_(a0[j] - a1[j]);
        oml[bj][n] = 1.0f - lbv[bj][n];
      }
  }
#pragma unroll
  for (int ai = 0; ai < 2; ++ai)
#pragma unroll
    for (int bj = 0; bj < 2; ++bj) {
      const long row = rowh + ai * HALF; const int cb = bj * HALF;
      if (KIND == 4) {
        unsigned vals[4][8];
#pragma unroll
        for (int m = 0; m < 4; ++m) pk_f32x8(vals[m], lbv[bj][0] + oml[bj][0] * sig4(acc[ai][bj][m][0]), lbv[bj][1] + oml[bj][1] * sig4(acc[ai][bj][m][1]));
        stage_store_block<32>(vals, (unsigned char*)(((pn - 8) >> 2 ? P.gb : P.gf) + row * 1024 + ((pn - 8) & 3) * 256 + cb), 1024 * 4);
      } else {
        unsigned vals[4][4];
#pragma unroll
        for (int m = 0; m < 4; ++m) {
          if (KIND == 3) pk_bf16x8(vals[m], acc[ai][bj][m][0] * sig4(acc[ai][bj][m][0]), acc[ai][bj][m][1] * sig4(acc[ai][bj][m][1]));
          else pk_bf16x8(vals[m], acc[ai][bj][m][0], acc[ai][bj][m][1]);
        }
        bf16_t* dst;
        if (KIND == 0) dst = P.cq + (row - NCTX) * QRANK + pn * 256 + cb;
        else if (KIND == 1) dst = P.ckv + row * KVRANK + cb;
        else if (KIND == 3) dst = (pn < 8 ? P.qh + (pn - 4) * 256 : P.gate + (pn - 20) * 256) + row * 1024 + cb;
        else dst = P.vh + row * 1024 + (pn - 16) * 256 + cb;
        stage_store_block<16>(vals, (unsigned char*)dst, (KIND == 0 ? QRANK : (KIND == 1 ? KVRANK : 1024)) * 2);
      }
    }
}
DEV void EpiOut::operator()(const AccT& acc, int wr, int wc, int fr, int fq) const {
  CParams& P = *launder(p);
#pragma unroll
  for (int ai = 0; ai < 2; ++ai)
#pragma unroll
    for (int bj = 0; bj < 2; ++bj) {
      unsigned vals[4][4];
#pragma unroll
      for (int m = 0; m < 4; ++m) pk_bf16x8(vals[m], acc[ai][bj][m][0], acc[ai][bj][m][1]);
      stage_store_block<16>(vals, (unsigned char*)(P.mix + (long)(pm * BM + ai * HALF + wr * 64) * DM + pn * 256 + bj * HALF), DM * 2);
    }
}
struct EpiGU {
  CParams* p; int e, srow0, pn;
  DEV static f32x4 act4(f32x4 g, f32x4 l) {
    constexpr float KS = -1.702f * 1.4426950408889634f;
    f32x4 a;
#pragma unroll
    for (int h2 = 0; h2 < 2; ++h2) {
      f32x2 gl, li1, sg;
      gl.x = fminf(g[2 * h2], 7.f); gl.y = fminf(g[2 * h2 + 1], 7.f);
      li1.x = fminf(fmaxf(l[2 * h2], -6.f), 8.f); li1.y = fminf(fmaxf(l[2 * h2 + 1], -6.f), 8.f);
      const f32x2 t = gl * KS;
      f32x2 d; d.x = __builtin_amdgcn_exp2f(t.x); d.y = __builtin_amdgcn_exp2f(t.y);
      d = d + 1.0f;
      sg.x = __builtin_amdgcn_rcpf(d.x); sg.y = __builtin_amdgcn_rcpf(d.y);
      const f32x2 r = (gl * sg) * li1;
      a[2 * h2] = r.x; a[2 * h2 + 1] = r.y;
    }
    return a;
  }
  DEV void operator()(const AccT& acc, int wr, int wc, int fr, int fq) const {
    CParams& P = *launder(p); const int row0 = srow0 + wr * 64 + fr;
    const int c = wc * 32 + 8 * fq;
#pragma unroll
    for (int ai = 0; ai < 2; ++ai) {
      unsigned vals[4][2];
#pragma unroll
      for (int m = 0; m < 4; ++m) { vals[m][0] = cvt_pk4_fp8(act4(acc[ai][0][m][0], acc[ai][1][m][0])); vals[m][1] = cvt_pk4_fp8(act4(acc[ai][0][m][1], acc[ai][1][m][1])); }
      stage_store_block<8>(vals, P.act8 + (long)(srow0 + ai * HALF + wr * 64) * DFF + pn * 128, DFF);
    }
  }
};
struct EpiDN {
  CParams* p; int e, srow0, pn;
  DEV void operator()(const AccT& acc, int wr, int wc, int fr, int fq) const {
    CParams& P = *launder(p); const int row0 = srow0 + wr * 64 + fr;
#pragma unroll
    for (int bj = 0; bj < 2; ++bj)
#pragma unroll
      for (int ai = 0; ai < 2; ++ai) {
        unsigned vals[4][2];
#pragma unroll
        for (int m = 0; m < 4; ++m) { vals[m][0] = cvt_pk4_fp8(acc[ai][bj][m][0]); vals[m][1] = cvt_pk4_fp8(acc[ai][bj][m][1]); }
        stage_store_block<8>(vals, P.ys8 + (long)(srow0 + ai * HALF + wr * 64) * DM + pn * 256 + bj * HALF, DM);
      }
  }
};

struct PolIn {
  static constexpr bool GATHER = false;
  static constexpr bool FP8 = false, HASBIAS = false, ROWSKIP = false, BIAS_LIN1 = false; static constexpr int SCALE_A = 0, SCALE_B = 0;
  CParams* p; const char* A; const char* B; int wg, nwg, KB, part;
  DEV bool get(int i, Unit& u) const {
    const int id = wg + i * nwg;
    if (part) { if (id >= 64) return false; u.pn = 23; u.pm = 4 + id; u.e = 0; u.r0 = 0; u.rv = 256; return true; }
    if (id >= 1528) return false;
    if (id < 1472) { u.pn = id >> 6; u.pm = 4 + (id & 63); } else { const int v = id - 1472, j = v >> 2; u.pm = v & 3; u.pn = j < 2 ? 2 + j : 6 + j; }
    u.e = 0; u.r0 = 0; u.rv = 256; return true; }
  DEV const char* abase(const Unit& u, int half) const { return A + (size_t)(u.pm * BM + half * HALF) * KB; }
  DEV const char* bbase(const Unit& u) const { return B + (size_t)(u.pn * BM) * KB; }
  DEV void arow_fill(const Unit&, int*) const {}
  DEV void arow_dma(const Unit&, LAS int*) const {}
  DEV void bias_fill(const Unit&, float*) const {}
  DEV void bias_dma(const Unit&, LAS float*) const {}
  DEV void epi(const Unit& u, const AccT& acc, int wr, int wc, int fr, int fq) const { EpiIn e{p, u.pm, u.pn}; e(acc, wr, wc, fr, fq); }
};
DEV void phase2_inproj(CParams& p, int wg, int nwg) { PolIn pol{&p, (const char*)p.h, (const char*)p.wt_in, wg, nwg, DM * 2, 0}; gemm_stream(pol); }

struct PolKV {
  static constexpr bool GATHER = false;
  static constexpr bool FP8 = false, HASBIAS = false, ROWSKIP = false, BIAS_LIN1 = false; static constexpr int SCALE_A = 0, SCALE_B = 0;
  CParams* p; const char* A; const char* B; int wg, nwg, KB;
  DEV bool get(int i, Unit& u) const { const int id = wg + i * nwg; if (id >= 68 * 8) return false; u.pn = id / 68; u.pm = id % 68; u.e = 0; u.r0 = 0; u.rv = 256; return true; }
  DEV const char* abase(const Unit& u, int half) const { return A + (size_t)(u.pm * BM + half * HALF) * KB; }
  DEV const char* bbase(const Unit& u) const { return B + (size_t)(u.pn * BM) * KB; }
  DEV void arow_fill(const Unit&, int*) const {}
  DEV void arow_dma(const Unit&, LAS int*) const {}
  DEV void bias_fill(const Unit&, float*) const {}
  DEV void bias_dma(const Unit&, LAS float*) const {}
  DEV void epi(const Unit& u, const AccT& acc, int wr, int wc, int fr, int fq) const { EpiKV e{p, u.pm, u.pn}; e(acc, wr, wc, fr, fq); }
};
struct PolQ {
  static constexpr bool GATHER = false;
  static constexpr bool FP8 = false, HASBIAS = false, ROWSKIP = false, BIAS_LIN1 = false; static constexpr int SCALE_A = 0, SCALE_B = 0;
  CParams* p; const char* A; const char* B; int wg, nwg, KB;
  DEV bool get(int i, Unit& u) const { const int id = wg + i * nwg; if (id >= 64 * 6) return false; u.pn = id >> 6; u.pm = id & 63; u.e = 0; u.r0 = 0; u.rv = 256; return true; }
  DEV const char* abase(const Unit& u, int half) const { return A + (size_t)(u.pm * BM + half * HALF) * KB; }
  DEV const char* bbase(const Unit& u) const { return B + (size_t)(u.pn * BM) * KB; }
  DEV void arow_fill(const Unit&, int*) const {}
  DEV void arow_dma(const Unit&, LAS int*) const {}
  DEV void bias_fill(const Unit&, float*) const {}
  DEV void bias_dma(const Unit&, LAS float*) const {}
  DEV void epi(const Unit& u, const AccT& acc, int wr, int wc, int fr, int fq) const { EpiQ e{p, u.pm, u.pn}; e(acc, wr, wc, fr, fq); }
};
DEV void phase4_up(CParams& p, int wg, int nwg) {
  if (nwg >= 128) {
    if (wg < 64) { PolIn pol{&p, (const char*)p.h, (const char*)p.wt_in, wg, nwg, DM * 2, 1}; gemm_stream(pol); }
    else {
      { PolKV pol{&p, (const char*)p.ckvn, (const char*)p.wt_ukv, wg - 64, nwg - 64, KVRANK * 2}; gemm_stream(pol); }
      { PolQ pol{&p, (const char*)p.cqn, (const char*)p.wt_uq, (wg - 64 + 32) % (nwg - 64), nwg - 64, QRANK * 2}; gemm_stream(pol); }
    }
  } else {
    { PolIn pol{&p, (const char*)p.h, (const char*)p.wt_in, wg, nwg, DM * 2, 1}; gemm_stream(pol); }
    { PolKV pol{&p, (const char*)p.ckvn, (const char*)p.wt_ukv, wg, nwg, KVRANK * 2}; gemm_stream(pol); }
    { PolQ pol{&p, (const char*)p.cqn, (const char*)p.wt_uq, wg, nwg, QRANK * 2}; gemm_stream(pol); }
  }
}
struct PolOut {
  static constexpr bool GATHER = false;
  static constexpr bool FP8 = false, HASBIAS = false, ROWSKIP = false, BIAS_LIN1 = false; static constexpr int SCALE_A = 0, SCALE_B = 0;
  CParams* p; const char* A; const char* B; int wg, nwg, KB;
  DEV bool get(int i, Unit& u) const { const int id = wg + i * nwg; if (id >= 64 * 8) return false; u.pn = id >> 6; u.pm = id & 63; u.e = 0; u.r0 = 0; u.rv = 256; return true; }
  DEV const char* abase(const Unit& u, int half) const { return A + (size_t)(u.pm * BM + half * HALF) * KB; }
  DEV const char* bbase(const Unit& u) const { return B + (size_t)(u.pn * BM) * KB; }
  DEV void arow_fill(const Unit&, int*) const {}
  DEV void arow_dma(const Unit&, LAS int*) const {}
  DEV void bias_fill(const Unit&, float*) const {}
  DEV void bias_dma(const Unit&, LAS float*) const {}
  DEV void epi(const Unit& u, const AccT& acc, int wr, int wc, int fr, int fq) const { EpiOut e{p, u.pm, u.pn}; e(acc, wr, wc, fr, fq); }
};
DEV void phase6_outproj(CParams& p, int wg, int nwg) { PolOut pol{&p, (const char*)p.aout, (const char*)p.wt_out, wg, nwg, DM * 2}; gemm_stream(pol); }

constexpr int MOE_TAB_OFF = MOE_TAB_OFF_;
DEV int moe_prefix(CParams& p, int* tile_e, int* tile_r0, int* tile_rv) {
  const int t = ltid();
  if (t < 64) {
    const int c = t < NE ? p.cnt[t * CNT_LD] : 0, n = (c + 255) >> 8; int inc = n;
#pragma unroll
    for (int st = 1; st < 32; st <<= 1) { const int v = __shfl_up(inc, st); if ((t & 63) >= st) inc += v; }
    const int first = inc - n;
    if (t < NE) for (int i = 0; i < n; ++i) { tile_e[first + i] = t; tile_r0[first + i] = i * 256; tile_rv[first + i] = min(256, c - i * 256); }
    if (t == NE - 1) tile_e[MAXTILES] = inc;
  }
  __syncthreads();
  return tile_e[MAXTILES];
}
struct PolGU {
  static constexpr bool GATHER = true, FP8 = true, HASBIAS = true, ROWSKIP = false, BIAS_LIN1 = true; static constexpr int SCALE_A = FP8_SCALE_1, SCALE_B = FP8_SCALE_W;
  CParams* p; const char* A; const char* B; const int* tile_e; const int* tile_r0; const int* tile_rv; int ntot, rbase, rstep, pncol, KB, noepi;
  DEV bool get(int i, Unit& u) const {
    u.pm = rstep * i + rbase; u.pn = pncol; if (u.pm >= ntot) return false;
    u.e = __builtin_amdgcn_readfirstlane(tile_e[u.pm]); u.r0 = __builtin_amdgcn_readfirstlane(tile_r0[u.pm]); u.rv = __builtin_amdgcn_readfirstlane(tile_rv[u.pm]); return true; }
  DEV const char* abase(const Unit&, int) const { return A; }
  DEV const char* bbase(const Unit& u) const { return B + ((size_t)u.e * 4096 + u.pn * BM) * KB; }
  DEV void arow_fill(const Unit& u, int* tab) const { const int t = ltid(); if (t < 256) { const int v = p->idx[u.e * NLAT + u.r0 + t]; tab[t] = t < u.rv ? v : 0; } }
  DEV void arow_dma(const Unit& u, LAS int* tabw) const { const int t = ltid() & 255;
    __builtin_amdgcn_global_load_lds((const unsigned*)(p->idx + u.e * NLAT + u.r0 + t), (LAS unsigned*)tabw, 4, 0, 0); }
  DEV const float* bias_src(const Unit& u, int t) const { return p->b_gu + (long)u.e * 4096 + u.pn * 128 + (t < 128 ? t : 2048 + t - 128); }
  DEV void bias_fill(const Unit& u, float* tab) const { const int t = ltid(); if (t < 256) tab[t] = *bias_src(u, t); }
  DEV void bias_dma(const Unit& u, LAS float* tabw) const { __builtin_amdgcn_global_load_lds((const unsigned*)bias_src(u, ltid() & 255), (LAS unsigned*)tabw, 4, 0, 0); }
  DEV void epi(const Unit& u, const AccT& acc, int wr, int wc, int fr, int fq) const { if (noepi) return; EpiGU e{p, u.e, u.pm * 256, u.pn}; e(acc, wr, wc, fr, fq); }
};
struct PolDN {
  static constexpr bool GATHER = false, FP8 = true, HASBIAS = true, ROWSKIP = false, BIAS_LIN1 = false; static constexpr int SCALE_A = FP8_SCALE_1, SCALE_B = FP8_SCALE_W;
  CParams* p; const char* A; const char* B; const int* tile_e; const int* tile_rv; int ntot, rbase, rstep, pncol, KB, noepi;
  DEV bool get(int i, Unit& u) const {
    u.pm = rstep * i + rbase; u.pn = pncol; if (u.pm >= ntot) return false;
    u.e = __builtin_amdgcn_readfirstlane(tile_e[u.pm]); u.r0 = 0; u.rv = __builtin_amdgcn_readfirstlane(tile_rv[u.pm]); return true; }
  DEV const char* abase(const Unit& u, int half) const { return A + (size_t)(u.pm * BM + half * HALF) * KB; }
  DEV const char* bbase(const Unit& u) const { return B + ((size_t)u.e * 2048 + u.pn * BM) * KB; }
  DEV void arow_fill(const Unit&, int*) const {}
  DEV void arow_dma(const Unit&, LAS int*) const {}
  DEV const float* bias_src(const Unit& u, int t) const { return p->b_dn + (long)u.e * 2048 + u.pn * 256 + t; }
  DEV void bias_fill(const Unit& u, float* tab) const { const int t = ltid(); if (t < 256) tab[t] = *bias_src(u, t); }
  DEV void bias_dma(const Unit& u, LAS float* tabw) const { __builtin_amdgcn_global_load_lds((const unsigned*)bias_src(u, ltid() & 255), (LAS unsigned*)tabw, 4, 0, 0); }
  DEV void epi(const Unit& u, const AccT& acc, int wr, int wc, int fr, int fq) const { if (noepi) return; EpiDN e{p, u.e, u.pm * 256, u.pn}; e(acc, wr, wc, fr, fq); }
};
template <int WHICH> DEV void phase_moe(CParams& p, int wg, int nwg, int noepi = 0) {
  extern __shared__ __attribute__((aligned(16))) char shm[];
  int* tile_e = (int*)(shm + MOE_TAB_OFF); int* tile_r0 = tile_e + MAXTILES + 1; int* tile_rv = tile_r0 + MAXTILES;
  const int ntiles = moe_prefix(p, tile_e, tile_r0, tile_rv);
  constexpr int NC = WHICH == 0 ? 16 : 8;
  int rbase, rstep, pncol;
  if (nwg == 256) { const int x = wg & 7, y = wg >> 3; rstep = 256 / NC; if (WHICH == 0) { rbase = 4 * (x >> 1) + (y >> 3); pncol = 8 * (x & 1) + (y & 7); } else { rbase = 4 * x + (y >> 3); pncol = y & 7; } }
  else { rbase = wg / NC; rstep = nwg / NC; pncol = wg % NC; }
  if (WHICH == 0) { PolGU pol{&p, (const char*)p.h2_8, (const char*)p.wt_gu8, tile_e, tile_r0, tile_rv, ntiles, rbase, rstep, pncol, DM, noepi}; gemm_stream(pol); }
  else { PolDN pol{&p, (const char*)p.act8, (const char*)p.wt_dn8, tile_e, tile_rv, ntiles, rbase, rstep, pncol, DFF, noepi}; gemm_stream(pol); }
}
DEV void phase3_rows(CParams& p, int wg, int nwg) {
  const int wid = ltid() >> 6, lane = ltid() & 63;
  for (int row = wg * 8 + wid; row < NROW; row += nwg * 8) {
    if (row >= NCTX) {
      const int lr = row - NCTX;
      const u32x4 raw = *(const u32x4*)(p.cq + (long)lr * QRANK + lane * 8);
      float v[8]; v[0] = bflo(raw.x); v[1] = bfhi(raw.x); v[2] = bflo(raw.y); v[3] = bfhi(raw.y); v[4] = bflo(raw.z); v[5] = bfhi(raw.z); v[6] = bflo(raw.w); v[7] = bfhi(raw.w);
      float ss = 0.f;
#pragma unroll
      for (int j = 0; j < 8; ++j) ss += v[j] * v[j];
      ss = wave_sum(ss); const float rstd = rsqrtf(ss * (1.f / QRANK) + EPS);
      const f32x4 w0 = *(const f32x4*)(p.q_norm + lane * 8), w1 = *(const f32x4*)(p.q_norm + lane * 8 + 4);
      u32x4 o; o.x = cvt_pk_bf16(v[0] * rstd * w0[0], v[1] * rstd * w0[1]); o.y = cvt_pk_bf16(v[2] * rstd * w0[2], v[3] * rstd * w0[3]);
      o.z = cvt_pk_bf16(v[4] * rstd * w1[0], v[5] * rstd * w1[1]); o.w = cvt_pk_bf16(v[6] * rstd * w1[2], v[7] * rstd * w1[3]);
      *(u32x4*)(p.cqn + (long)lr * QRANK + lane * 8) = o;
    }
    {
      const u32x2 raw = *(const u32x2*)(p.ckv + (long)row * KVRANK + lane * 4);
      float v[4]; v[0] = bflo(raw.x); v[1] = bfhi(raw.x); v[2] = bflo(raw.y); v[3] = bfhi(raw.y);
      float ss = v[0] * v[0] + v[1] * v[1] + v[2] * v[2] + v[3] * v[3];
      ss = wave_sum(ss); const float rstd = rsqrtf(ss * (1.f / KVRANK) + EPS);
      const f32x4 w0 = *(const f32x4*)(p.kv_norm + lane * 4);
      u32x2 o; o.x = cvt_pk_bf16(v[0] * rstd * w0[0], v[1] * rstd * w0[1]); o.y = cvt_pk_bf16(v[2] * rstd * w0[2], v[3] * rstd * w0[3]);
      *(u32x2*)(p.ckvn + (long)row * KVRANK + lane * 4) = o;
    }
    {
      const float kv = p.kr[(long)row * ROPE + lane];
      const float other = __shfl_xor(kv, 32);
      float o = kv;
      int b, key; row_to_bkey(row, b, key);
      if (row >= NCTX) {
        const int t = (row - NCTX) & 4095, a = lane & 31;
        const float cs = p.rope[t * 64 + a], sn = p.rope[t * 64 + 32 + a];
        o = lane < 32 ? kv * cs - other * sn : other * sn + kv * cs;
      }
      bf16_t* kd = p.kf + ((long)(b * NH) * KEYS + key) * QK + 128 + lane; const bf16_t ob = f2bf(o);
#pragma unroll
      for (int hh = 0; hh < NH; ++hh) kd[(long)hh * KEYS * QK] = ob;
    }
  }
}

DEV void phase5c_rec(CParams& p, int wg, int nwg) {
  const int wid = ltid() >> 6, lane = ltid() & 63;
  for (int row = wg * 8 + wid; row < NLAT; row += nwg * 8) {
    const bf16_t* a = p.of + (long)row * 1024 + lane * 16; const bf16_t* b = p.ob + (long)row * 1024 + lane * 16;
    const u32x4 a0 = *(const u32x4*)a, a1 = *(const u32x4*)(a + 8), b0 = *(const u32x4*)b, b1 = *(const u32x4*)(b + 8);
    const unsigned aw[8] = {a0.x, a0.y, a0.z, a0.w, a1.x, a1.y, a1.z, a1.w}, bw[8] = {b0.x, b0.y, b0.z, b0.w, b1.x, b1.y, b1.z, b1.w};
    float v[16]; float ss = 0.f;
#pragma unroll
    for (int i = 0; i < 8; ++i) { v[2 * i] = bflo(aw[i]) + bflo(bw[i]); v[2 * i + 1] = bfhi(aw[i]) + bfhi(bw[i]); ss += v[2 * i] * v[2 * i] + v[2 * i + 1] * v[2 * i + 1]; }
    ss += __shfl_xor(ss, 1); ss += __shfl_xor(ss, 2); ss += __shfl_xor(ss, 4);
    const float rstd = rsqrtf(ss * (1.f / DV) + EPS);
    const bf16_t* gp = p.gate + (long)(NCTX + row) * 1024 + lane * 16;
    const u32x4 g0 = *(const u32x4*)gp, g1 = *(const u32x4*)(gp + 8);
    float gt[16]; gt[0] = bflo(g0.x); gt[1] = bfhi(g0.x); gt[2] = bflo(g0.y); gt[3] = bfhi(g0.y); gt[4] = bflo(g0.z); gt[5] = bfhi(g0.z); gt[6] = bflo(g0.w); gt[7] = bfhi(g0.w);
    gt[8] = bflo(g1.x); gt[9] = bfhi(g1.x); gt[10] = bflo(g1.y); gt[11] = bfhi(g1.y); gt[12] = bflo(g1.z); gt[13] = bfhi(g1.z); gt[14] = bflo(g1.w); gt[15] = bfhi(g1.w);
    const float* gn = p.g_norm + (lane & 7) * 16;
    unsigned o[8];
#pragma unroll
    for (int j = 0; j < 8; ++j) o[j] = cvt_pk_bf16(v[2 * j] * rstd * gn[2 * j] * gt[2 * j], v[2 * j + 1] * rstd * gn[2 * j + 1] * gt[2 * j + 1]);
    bf16_t* op = p.aout + (long)row * DM + 1024 + lane * 16;
    *(u32x4*)op = (u32x4){o[0], o[1], o[2], o[3]}; *(u32x4*)(op + 8) = (u32x4){o[4], o[5], o[6], o[7]};
  }
}

constexpr int H2S_LD = 2052;
template <bool ROUTE> DEV void phase7_post(CParams& p, int wg, int nwg) {
  extern __shared__ __attribute__((aligned(16))) char shm[];
  float* h2s = (float*)shm;
  float* red = (float*)(shm + 16 * H2S_LD * 4);
  int* lcnt = (int*)(shm + 16 * H2S_LD * 4 + 8 * 16 * 32 * 4); int* lbase = lcnt + NE; int* rt_e = lbase + NE; int* rt_lp = rt_e + 256;
  const int tid = ltid(), wid = tid >> 6, lane = tid & 63;
  if (tid < NE) lcnt[tid] = 0;
  int gi = 0;
  u32x2 m2[2][8]; f32x4 xv[2][8];
#define P7_LOAD_A(g_) do { const long row_ = (g_) * 16 + wid * 2; const bf16_t* mr = p.mix + row_ * DM + lane * 4; const float* xr = p.x + row_ * DM + lane * 4; \
    _Pragma("unroll") for (int i = 0; i < 8; ++i) m2[0][i] = *(const u32x2*)(mr + i * 256); \
    _Pragma("unroll") for (int i = 0; i < 8; ++i) xv[0][i] = *(const f32x4*)(xr + i * 256); } while (0)
#define P7_LOAD_B(g_) do { const long row_ = (g_) * 16 + wid * 2 + 1; const bf16_t* mr = p.mix + row_ * DM + lane * 4; const float* xr = p.x + row_ * DM + lane * 4; \
    _Pragma("unroll") for (int i = 0; i < 8; ++i) m2[1][i] = *(const u32x2*)(mr + i * 256); \
    _Pragma("unroll") for (int i = 0; i < 8; ++i) xv[1][i] = *(const f32x4*)(xr + i * 256); } while (0)
  if (wg < NLAT / 16) P7_LOAD_A(wg);
  for (int g = wg; g < NLAT / 16; g += nwg, ++gi) {
    {
      P7_LOAD_B(g);
      const int row0 = g * 16 + wid * 2, b = row0 >> 12;
      const float* mod = p.mod + b * 12288;
      float ss[2] = {0.f, 0.f};
#pragma unroll
      for (int rr = 0; rr < 2; ++rr)
#pragma unroll
        for (int i = 0; i < 8; ++i) { const float a0 = bflo(m2[rr][i].x), a1 = bfhi(m2[rr][i].x), a2 = bflo(m2[rr][i].y), a3 = bfhi(m2[rr][i].y); ss[rr] += a0 * a0 + a1 * a1 + a2 * a2 + a3 * a3; }
      ss[0] = wave_sum(ss[0]); ss[1] = wave_sum(ss[1]);
      const float rstd[2] = {rsqrtf(ss[0] * (1.f / DM) + EPS), rsqrtf(ss[1] * (1.f / DM) + EPS)};
      float s2[2] = {0.f, 0.f};
      __builtin_amdgcn_sched_barrier(0);
#pragma unroll
      for (int i = 0; i < 8; ++i) {
        const int c0 = i * 256 + lane * 4;
        const f32x4 w = *(const f32x4*)(p.ln_mix_post + c0), gm = *(const f32x4*)(mod + 4096 + c0);
#pragma unroll
        for (int rr = 0; rr < 2; ++rr) {
          const f32x4 mv = {bflo(m2[rr][i].x), bfhi(m2[rr][i].x), bflo(m2[rr][i].y), bfhi(m2[rr][i].y)};
#pragma unroll
          for (int j = 0; j < 4; ++j) { xv[rr][i][j] = xv[rr][i][j] + gm[j] * (mv[j] * rstd[rr] * w[j]); s2[rr] += xv[rr][i][j] * xv[rr][i][j]; }
          st_bf16x4(p.x1 + (long)(row0 + rr) * DM + c0, xv[rr][i]);
        }
      }
      s2[0] = wave_sum(s2[0]); s2[1] = wave_sum(s2[1]);
      const float rstd2[2] = {rsqrtf(s2[0] * (1.f / DM) + EPS), rsqrtf(s2[1] * (1.f / DM) + EPS)};
      __builtin_amdgcn_sched_barrier(0);
#pragma unroll
      for (int i = 0; i < 8; ++i) {
        const int c0 = i * 256 + lane * 4;
        const f32x4 w = *(const f32x4*)(p.ln_ffn_pre + c0), s1 = *(const f32x4*)(mod + 8192 + c0), s0 = *(const f32x4*)(mod + 6144 + c0);
#pragma unroll
        for (int rr = 0; rr < 2; ++rr) {
          f32x4 y;
#pragma unroll
          for (int j = 0; j < 4; ++j) y[j] = xv[rr][i][j] * rstd2[rr] * w[j] * (1.f + s1[j]) + s0[j];
          *(unsigned*)(p.h2_8 + (long)(row0 + rr) * DM + c0) = cvt_pk4_fp8(y);
          *(f32x4*)(h2s + (wid * 2 + rr) * H2S_LD + c0) = y;
        }
      }
    }
    {
      f32x4 a0 = {0.f, 0.f, 0.f, 0.f}, a1 = {0.f, 0.f, 0.f, 0.f};
      const int r16 = lane & 15, kq = lane >> 4;
      const float* ap = h2s + r16 * H2S_LD + wid * 256 + kq;
      const float* bp = p.router_w + (long)(wid * 256 + kq) * NE + r16; asm volatile("" : "+v"(bp));
      float bw0[64], bw1[64];
#pragma unroll
      for (int s = 0; s < 64; ++s) { bw0[s] = bp[(long)(4 * s) * NE]; bw1[s] = bp[(long)(4 * s) * NE + 16]; }
      asm volatile("" ::: "memory");
      if (g + nwg < NLAT / 16) P7_LOAD_A(g + nwg);
      __syncthreads();
#pragma unroll
      for (int s = 0; s < 64; ++s) {
        const float av = ap[4 * s];
        a0 = __builtin_amdgcn_mfma_f32_16x16x4f32(av, bw0[s], a0, 0, 0, 0);
        a1 = __builtin_amdgcn_mfma_f32_16x16x4f32(av, bw1[s], a1, 0, 0, 0);
      }
#pragma unroll
      for (int j = 0; j < 4; ++j) { red[(wid * 16 + 4 * kq + j) * 32 + r16] = a0[j]; red[(wid * 16 + 4 * kq + j) * 32 + 16 + r16] = a1[j]; }
    }
    __syncthreads();
    {
      const int r = tid >> 5, e = tid & 31; float sl = p.router_b[e];
#pragma unroll
      for (int w = 0; w < 8; ++w) sl += red[(w * 16 + r) * 32 + e];
      if (ROUTE) {
        const int row = g * 16 + r;
        float sv[4]; int sel[4];
#pragma unroll
        for (int k = 0; k < 4; ++k) {
          float bv = sl; int bi = e;
#pragma unroll
          for (int st = 1; st < 32; st <<= 1) { const float ov = __shfl_xor(bv, st); const int oi = __shfl_xor(bi, st); const bool take = ov > bv || (ov == bv && oi < bi); bv = take ? ov : bv; bi = take ? oi : bi; }
          sv[k] = bv; sel[k] = bi; if (e == bi) sl = -3.0e38f;
        }
        const float e1 = __expf(sv[1] - sv[0]), e2 = __expf(sv[2] - sv[0]), e3 = __expf(sv[3] - sv[0]), inv = 1.f / (1.f + e1 + e2 + e3);
        if (e < 4) {
          const int se = e == 0 ? sel[0] : (e == 1 ? sel[1] : (e == 2 ? sel[2] : sel[3]));
          const float gk = (e == 0 ? 1.f : (e == 1 ? e1 : (e == 2 ? e2 : e3))) * inv;
          const int li = (gi & 3) * 64 + r * 4 + e;
          rt_e[li] = se; rt_lp[li] = atomicAdd(&lcnt[se], 1);
          p.tok_e[row * 4 + e] = se; p.tok_gate[row * 4 + e] = gk;
        }
      }
    }
    if (ROUTE && ((gi & 3) == 3 || g + nwg >= NLAT / 16)) {
      __syncthreads();
      if (tid < NE) { const int c = lcnt[tid]; lbase[tid] = c ? atomicAdd(p.cnt + tid * CNT_LD, c) : 0; lcnt[tid] = 0; }
      __syncthreads();
      const int nent = ((gi & 3) + 1) * 64;
      if (tid < nent) {
        const int se = rt_e[tid], pos = lbase[se] + rt_lp[tid], row = (g - ((gi & 3) - (tid >> 6)) * nwg) * 16 + ((tid >> 2) & 15);
        p.idx[se * NLAT + pos] = row; p.tok_pos[row * 4 + (tid & 3)] = pos;
      }
    }
  }
#undef P7_LOAD_A
#undef P7_LOAD_B
}

DEV void phase11_final(CParams& p, int wg, int nwg) {
  extern __shared__ __attribute__((aligned(16))) char shm[];
  int* rowbase = (int*)shm;
  if (ltid() < 64) {
    const int t = ltid(), n = t < NE ? (p.cnt[t * CNT_LD] + 255) >> 8 : 0; int inc = n;
#pragma unroll
    for (int st = 1; st < 32; st <<= 1) { const int v = __shfl_up(inc, st); if (t >= st) inc += v; }
    if (t < NE) rowbase[t] = (inc - n) * 256;
  }
  __syncthreads();
  const int wid = ltid() >> 6, lane = ltid() & 63;
  i32x4 te_n, tp_n; f32x4 tg_n;
  { const int r0 = wg * 8 + wid; if (r0 < NLAT) { te_n = *(const i32x4*)(p.tok_e + r0 * 4); tp_n = *(const i32x4*)(p.tok_pos + r0 * 4); tg_n = *(const f32x4*)(p.tok_gate + r0 * 4); } }
  for (int row = wg * 8 + wid; row < NLAT; row += nwg * 8) {
    const int b = row >> 12; const float* mod = p.mod + b * 12288;
    const i32x4 te = te_n, tp = tp_n; const f32x4 tg = tg_n;
    { const int rn = row + nwg * 8; if (rn < NLAT) { te_n = *(const i32x4*)(p.tok_e + rn * 4); tp_n = *(const i32x4*)(p.tok_pos + rn * 4); tg_n = *(const f32x4*)(p.tok_gate + rn * 4); } }
    f32x4 y[2][4]; u32x4 xr[2][2];
#pragma unroll
    for (int i = 0; i < 2; ++i) { const bf16_t* xp = p.x1 + (long)row * DM + 1024 * i + lane * 16; xr[i][0] = *(const u32x4*)xp; xr[i][1] = *(const u32x4*)(xp + 8); }
#pragma unroll
    for (int i = 0; i < 2; ++i)
#pragma unroll
      for (int j = 0; j < 4; ++j) y[i][j] = (f32x4){0.f, 0.f, 0.f, 0.f};
#pragma unroll
    for (int k = 0; k < 4; ++k) {
      const int e = te[k], pos = tp[k]; const float gt = tg[k];
      const unsigned char* yr = p.ys8 + (long)(rowbase[e] + pos) * DM + lane * 16;
#pragma unroll
      for (int i = 0; i < 2; ++i) {
        const u32x4 r = *(const u32x4*)(yr + 1024 * i); const unsigned rw[4] = {r.x, r.y, r.z, r.w};
#pragma unroll
        for (int j = 0; j < 4; ++j) { const f32x2 lo = __builtin_amdgcn_cvt_pk_f32_fp8(rw[j], false), hi = __builtin_amdgcn_cvt_pk_f32_fp8(rw[j], true);
          y[i][j][0] += gt * lo.x; y[i][j][1] += gt * lo.y; y[i][j][2] += gt * hi.x; y[i][j][3] += gt * hi.y; }
      }
    }
    float ss = 0.f;
#pragma unroll
    for (int i = 0; i < 2; ++i)
#pragma unroll
      for (int j = 0; j < 4; ++j) ss += y[i][j][0] * y[i][j][0] + y[i][j][1] * y[i][j][1] + y[i][j][2] * y[i][j][2] + y[i][j][3] * y[i][j][3];
    ss = wave_sum(ss); const float rstd = rsqrtf(ss * (1.f / DM) + EPS);
#pragma unroll
    for (int i = 0; i < 2; ++i)
#pragma unroll
      for (int j = 0; j < 4; ++j) {
        const int c0 = 1024 * i + lane * 16 + 4 * j;
        const f32x4 w = *(const f32x4*)(p.ln_ffn_post + c0), gf = *(const f32x4*)(mod + 10240 + c0);
        const unsigned x01 = xr[i][j >> 1][(j & 1) * 2], x23 = xr[i][j >> 1][(j & 1) * 2 + 1]; const f32x4 xx = {bflo(x01), bfhi(x01), bflo(x23), bfhi(x23)};
        f32x4 o;
#pragma unroll
        for (int jj = 0; jj < 4; ++jj) o[jj] = xx[jj] + gf[jj] * (y[i][j][jj] * rstd * w[jj]);
        *(f32x4*)(p.out + (long)row * DM + c0) = o;
      }
  }
}
namespace att {
constexpr int NW = 8, QBLK = 32, KVBLK = 64;
constexpr float SCALE = 0.07216878364870322f;
constexpr float THR = 8.f;
constexpr int SHM_V = KVBLK * DV * 2, SHM_K = KVBLK * 512;
constexpr int LDS_BYTES = 2 * SHM_V + 2 * SHM_K + NW * 64 * 4;
#define KSWZ2(row, colB) ((row) * 512 + ((colB) ^ (((row) & 15) << 4)))
#define SBAR() __builtin_amdgcn_sched_barrier(0)
DEV int crow(int r, int hi) { return (r & 3) + 8 * (r >> 2) + 4 * hi; }

DEV void partialSM(f32x16& p0, f32x16& p1, float& m_reg, float& mn, float& alpha) {
  constexpr float C = SCALE * 1.4426950408889634f;
  float pmax = p0[0];
#pragma unroll
  for (int r = 1; r < 16; ++r) pmax = fmaxf(pmax, p0[r]);
#pragma unroll
  for (int r = 0; r < 16; ++r) pmax = fmaxf(pmax, p1[r]);
  { auto rr = __builtin_amdgcn_permlane32_swap(__float_as_uint(pmax), __float_as_uint(pmax), false, false);
    pmax = fmaxf(__uint_as_float(rr[0]), __uint_as_float(rr[1])); }
  if (__builtin_expect(__all(pmax - m_reg <= THR / SCALE), 1)) { mn = m_reg; alpha = 1.f; }
  else { mn = fmaxf(m_reg, pmax); alpha = __builtin_amdgcn_exp2f((m_reg - mn) * C); m_reg = mn; }
  const float mnC = -mn * C;
#pragma unroll
  for (int r = 0; r < 16; ++r) p0[r] = fmaf(p0[r], C, mnC);
#pragma unroll
  for (int r = 0; r < 16; ++r) p1[r] = fmaf(p1[r], C, mnC);
#pragma unroll
  for (int r = 0; r < 16; ++r) p0[r] = __builtin_amdgcn_exp2f(p0[r]);
}
DEV void finishSM(f32x16& p0, f32x16& p1, float alpha, float& l_reg, bf16x8& pa0, bf16x8& pa1, bf16x8& pa2, bf16x8& pa3) {
#pragma unroll
  for (int r = 0; r < 16; ++r) p1[r] = __builtin_amdgcn_exp2f(p1[r]);
  float ps = 0;
#pragma unroll
  for (int r = 0; r < 16; ++r) ps += p0[r];
#pragma unroll
  for (int r = 0; r < 16; ++r) ps += p1[r];
  { auto rr = __builtin_amdgcn_permlane32_swap(__float_as_uint(ps), __float_as_uint(ps), false, false);
    ps = __uint_as_float(rr[0]) + __uint_as_float(rr[1]); }
  l_reg = l_reg * alpha + ps;
#define PK4(P, BASE, OUT) do { unsigned a0 = cvt_pk_bf16(P[BASE + 0], P[BASE + 1]), a1 = cvt_pk_bf16(P[BASE + 2], P[BASE + 3]);   \
    unsigned b0 = cvt_pk_bf16(P[BASE + 4], P[BASE + 5]), b1 = cvt_pk_bf16(P[BASE + 6], P[BASE + 7]);                              \
    auto r0 = __builtin_amdgcn_permlane32_swap(a0, b0, false, false); auto r1 = __builtin_amdgcn_permlane32_swap(a1, b1, false, false); \
    u32x4 w = {r0[0], r1[0], r0[1], r1[1]}; OUT = *reinterpret_cast<bf16x8*>(&w); } while (0)
  PK4(p0, 0, pa0); PK4(p0, 8, pa1); PK4(p1, 0, pa2); PK4(p1, 8, pa3);
#undef PK4
}
DEV void qkt(f32x16& p0, f32x16& p1, const char* Ks, const bf16x8* qr, int r32, int hi) {
  p0 = f32x16{}; p1 = f32x16{};
  __builtin_amdgcn_s_setprio(1);
#pragma unroll
  for (int d0 = 0; d0 < 12; ++d0) { const int cb = (d0 * 16 + hi * 8) * 2;
    const bf16x8 b0 = *reinterpret_cast<const bf16x8*>(Ks + KSWZ2(r32, cb));
    const bf16x8 b1 = *reinterpret_cast<const bf16x8*>(Ks + KSWZ2(32 + r32, cb));
    p0 = __builtin_amdgcn_mfma_f32_32x32x16_bf16(b0, qr[d0], p0, 0, 0, 0);
    p1 = __builtin_amdgcn_mfma_f32_32x32x16_bf16(b1, qr[d0], p1, 0, 0, 0); }
  __builtin_amdgcn_s_setprio(0);
}
DEV int v_st(int k, int c) { const int kk = (k & ~0xC) | ((k & 4) << 1) | ((k & 8) >> 1); return ((kk >> 3) * 4 + (c >> 5)) * 512 + ((kk & 7) * 32 + (c & 31)) * 2; }
DEV int v_rd_base(int lane) { return ((lane & 3) << 3) | (((lane >> 2) & 3) << 6) | (((lane >> 4) & 1) << 5) | (((lane >> 5) & 1) << 8); }
constexpr int v_rd_off(int d0, int ks, int half) { return d0 * 512 + ks * 4096 + half * 2048; }
template <int OFF> DEV s16x4 tr_read(int vb) { s16x4 r; asm volatile("ds_read_b64_tr_b16 %0, %1 offset:%2" : "=&v"(r) : "v"(vb), "i"(OFF) : "memory"); return r; }
struct VFrag { s16x4 l0, h0, l1, h1, l2, h2, l3, h3; };
template <int D0> DEV void pv_read(VFrag& f, int vb) {
  f.l0 = tr_read<v_rd_off(D0, 0, 0)>(vb); f.h0 = tr_read<v_rd_off(D0, 0, 1)>(vb); f.l1 = tr_read<v_rd_off(D0, 1, 0)>(vb); f.h1 = tr_read<v_rd_off(D0, 1, 1)>(vb);
  f.l2 = tr_read<v_rd_off(D0, 2, 0)>(vb); f.h2 = tr_read<v_rd_off(D0, 2, 1)>(vb); f.l3 = tr_read<v_rd_off(D0, 3, 0)>(vb); f.h3 = tr_read<v_rd_off(D0, 3, 1)>(vb);
}
DEV void pv_mma(f32x16& od, const VFrag& f, bf16x8 pa0, bf16x8 pa1, bf16x8 pa2, bf16x8 pa3) {
#define PK(L, H) (bf16x8){L[0], L[1], L[2], L[3], H[0], H[1], H[2], H[3]}
  __builtin_amdgcn_s_setprio(1);
  od = __builtin_amdgcn_mfma_f32_32x32x16_bf16(pa0, PK(f.l0, f.h0), od, 0, 0, 0);
  od = __builtin_amdgcn_mfma_f32_32x32x16_bf16(pa1, PK(f.l1, f.h1), od, 0, 0, 0);
  od = __builtin_amdgcn_mfma_f32_32x32x16_bf16(pa2, PK(f.l2, f.h2), od, 0, 0, 0);
  od = __builtin_amdgcn_mfma_f32_32x32x16_bf16(pa3, PK(f.l3, f.h3), od, 0, 0, 0);
  __builtin_amdgcn_s_setprio(0);
#undef PK
}
#define PV_WAIT(n) do { asm volatile("s_waitcnt lgkmcnt(" #n ")" ::: "memory"); SBAR(); } while (0)
DEV void pv_d0(f32x16* o, int vb, bf16x8 pa0, bf16x8 pa1, bf16x8 pa2, bf16x8 pa3) {
  VFrag fa, fb;
  pv_read<0>(fa, vb);
  pv_read<1>(fb, vb); PV_WAIT(8); pv_mma(o[0], fa, pa0, pa1, pa2, pa3); SBAR();
  pv_read<2>(fa, vb); PV_WAIT(8); pv_mma(o[1], fb, pa0, pa1, pa2, pa3); SBAR();
  pv_read<3>(fb, vb); PV_WAIT(8); pv_mma(o[2], fa, pa0, pa1, pa2, pa3); SBAR();
  PV_WAIT(0); pv_mma(o[3], fb, pa0, pa1, pa2, pa3);
}

DEV void attn_unit(const bf16_t* __restrict__ Qb, const bf16_t* __restrict__ Kh, const bf16_t* __restrict__ Vh, const float* __restrict__ rp, bf16_t* __restrict__ Ob, CParams& fp, int fwg, int fbase, int fn) {
  extern __shared__ __attribute__((aligned(16))) char shm[];
  const int tid = ltid(), wid = tid >> 6, lane = tid & 63, r32 = lane & 31, hi = lane >> 5;
  char* V_lds = shm; char* K_lds = shm + 2 * SHM_V;
  float* ws = (float*)(shm + 2 * SHM_V + 2 * SHM_K) + wid * 64; float* li_l = ws; float* al_l = ws + 32;
  float m_reg = -1e30f, l_reg = 0; f32x16 o[4] = {}; bf16x8 qr[12];
  {
    const bf16_t* Qw = Qb + (long)(wid * QBLK + r32) * QK + hi * 8;
#pragma unroll
    for (int d0 = 0; d0 < 12; ++d0) qr[d0] = *reinterpret_cast<const bf16x8*>(Qw + d0 * 16);
    const float* rr = rp + (long)(wid * QBLK + r32) * 64;
#pragma unroll
    for (int dd = 0; dd < 2; ++dd) {
      const int a0 = 16 * dd + 8 * hi;
      const f32x4 c0 = *(const f32x4*)(rr + a0), c1 = *(const f32x4*)(rr + a0 + 4), s0 = *(const f32x4*)(rr + 32 + a0), s1 = *(const f32x4*)(rr + 32 + a0 + 4);
      float cs[8] = {c0[0], c0[1], c0[2], c0[3], c1[0], c1[1], c1[2], c1[3]}, sn[8] = {s0[0], s0[1], s0[2], s0[3], s1[0], s1[1], s1[2], s1[3]};
      const bf16x8 x1 = qr[8 + dd], x2 = qr[10 + dd]; bf16x8 y1, y2;
#pragma unroll
      for (int j = 0; j < 8; j += 2) {
        const float a1 = bf2f((bf16_t)x1[j]), a2 = bf2f((bf16_t)x2[j]), b1 = bf2f((bf16_t)x1[j + 1]), b2 = bf2f((bf16_t)x2[j + 1]);
        const unsigned u1 = cvt_pk_bf16(a1 * cs[j] - a2 * sn[j], b1 * cs[j + 1] - b2 * sn[j + 1]);
        const unsigned u2 = cvt_pk_bf16(a1 * sn[j] + a2 * cs[j], b1 * sn[j + 1] + b2 * cs[j + 1]);
        y1[j] = (short)(u1 & 0xffff); y1[j + 1] = (short)(u1 >> 16); y2[j] = (short)(u2 & 0xffff); y2[j + 1] = (short)(u2 >> 16);
      }
      qr[8 + dd] = y1; qr[10 + dd] = y2;
    }
  }
  const int sr = tid >> 4, sc = (tid & 15) * 8, vst0 = v_st(sr, sc), vst1 = v_st(32 + sr, sc);
  int kst[3];
#pragma unroll
  for (int i = 0; i < 3; ++i) { const int id = tid + 512 * i, row = id / 24, ch = id % 24; kst[i] = KSWZ2(row, ch * 16); }
  const int vb0 = (int)(uintptr_t)V_lds + v_rd_base(lane);
  bf16x8 vs0, vs1, ks0, ks1, ks2;
#define SLOAD(k0) do { vs0 = *reinterpret_cast<const bf16x8*>(Vh + (long)((k0) + sr) * DV + sc); vs1 = *reinterpret_cast<const bf16x8*>(Vh + (long)((k0) + 32 + sr) * DV + sc); \
    const bf16_t* kp_ = Kh + (long)(k0) * QK + tid * 8; ks0 = *reinterpret_cast<const bf16x8*>(kp_); ks1 = *reinterpret_cast<const bf16x8*>(kp_ + 4096); ks2 = *reinterpret_cast<const bf16x8*>(kp_ + 8192); } while (0)
#define SWRITE(b) do { *(bf16x8*)(V_lds + (b) * SHM_V + vst0) = vs0; *(bf16x8*)(V_lds + (b) * SHM_V + vst1) = vs1; \
    *(bf16x8*)(K_lds + (b) * SHM_K + kst[0]) = ks0; *(bf16x8*)(K_lds + (b) * SHM_K + kst[1]) = ks1; *(bf16x8*)(K_lds + (b) * SHM_K + kst[2]) = ks2; } while (0)
#define SWAIT() asm volatile("s_waitcnt vmcnt(0)" ::: "memory")
#define RESC(a) do { if (__any((a) < 1.f)) { if (hi == 0) al_l[r32] = (a); asm volatile("s_waitcnt lgkmcnt(0)" ::: "memory"); \
    _Pragma("unroll") for (int d = 0; d < 4; ++d) _Pragma("unroll") for (int r = 0; r < 16; ++r) o[d][r] *= al_l[crow(r, hi)]; } } while (0)
  f32x16 p0, p1; float mn, al; bf16x8 pa0, pa1, pa2, pa3; constexpr int NTL = KEYS / KVBLK;
  f32x4 fld[4];
  if (fn > 0) fill_load(fp, fwg, fbase, fld);
  SLOAD(0); SWAIT(); SWRITE(0); SLOAD(KVBLK); __syncthreads();
#pragma unroll 1
  for (int j = 0; j < NTL; ++j) {
    const int cb = j & 1;
    if (j + 1 < NTL) { if (j >= 2 && j < fn) asm volatile("s_waitcnt vmcnt(5)" ::: "memory"); else SWAIT(); SWRITE(cb ^ 1); }
    if (j + 2 < NTL) SLOAD((j + 2) * KVBLK);
    if (j > 0 && j <= fn) fill_store(fp, fwg, fbase + j - 1, (j - 1) & 1);
    SBAR(); qkt(p0, p1, K_lds + cb * SHM_K, qr, r32, hi);
    partialSM(p0, p1, m_reg, mn, al);
    RESC(al);
    finishSM(p0, p1, al, l_reg, pa0, pa1, pa2, pa3); SBAR();
    pv_d0(o, vb0 + cb * SHM_V, pa0, pa1, pa2, pa3);
    if (j < fn) { fill_write(fld, j & 1); if (j + 1 < fn) fill_load(fp, fwg, fbase + j + 1, fld); }
    __syncthreads();
  }
  if (fn == NTL) fill_store(fp, fwg, fbase + NTL - 1, (NTL - 1) & 1);
  if (hi == 0) li_l[r32] = l_reg;
  asm volatile("s_waitcnt lgkmcnt(0)" ::: "memory");
  float rli[16];
#pragma unroll
  for (int r = 0; r < 16; ++r) rli[r] = __builtin_amdgcn_rcpf(li_l[crow(r, hi)]);
  bf16_t* Ow = Ob + (long)(wid * QBLK) * DM;
  constexpr int OPITCH = DV * 2 + 16;
  char* ost = shm + wid * (QBLK * OPITCH);
#pragma unroll
  for (int r = 0; r < 16; ++r) { const int orow = crow(r, hi);
#pragma unroll
    for (int d0 = 0; d0 < 4; ++d0) *(bf16_t*)(ost + orow * OPITCH + (d0 * 32 + r32) * 2) = f2bf(o[d0][r] * rli[r]); }
  asm volatile("s_waitcnt lgkmcnt(0)" ::: "memory");
#pragma unroll
  for (int k = 0; k < 8; ++k) { const int idx = k * 64 + lane, row = idx >> 4, ch = idx & 15;
    *(u32x4*)(Ow + (long)row * DM + ch * 8) = *(const u32x4*)(ost + row * OPITCH + ch * 16); }
  __syncthreads();
#undef SLOAD
#undef SWRITE
#undef SWAIT
#undef RESC
}
}

DEV void phase5a_attn(CParams& p, int u, int fwg = 0, int fbase = 0, int fn = 0) {
  const int qb = u & 15, h = (u >> 4) & 7, b = u >> 7;
  const long bh = b * NH + h;
  att::attn_unit(p.qf + (bh * SEQ + qb * 256) * QK, p.kf + bh * KEYS * QK, p.vf + bh * KEYS * DV, p.rope + (long)(qb * 256) * 64,
                 p.aout + (long)(b * SEQ + qb * 256) * DM + h * DV, p, fwg, fbase, fn);
}
namespace hg {
constexpr int LQ = 136, LS = 72;
constexpr int O_QT = 0, O_KT = O_QT + 64 * LQ * 2, O_KHT = O_KT + 64 * LQ * 2, O_VT = O_KHT + 128 * LS * 2, O_ST = O_VT + 32 * LS * 2, BUF = O_ST + 32 * LQ * 2;
constexpr int LDS_BYTES = 2 * BUF;
DEV bf16x8 ld8(const char* p) { return *reinterpret_cast<const bf16x8*>(p); }
DEV int qk_off(int row, int colb) { return row * (LQ * 2) + ((((colb >> 4) ^ ((row >> 3) & 7)) << 4) | (colb & 15)); }
DEV bf16x8 ld44(const char* p0, const char* p1) { const s16x4 a = *reinterpret_cast<const s16x4*>(p0), b = *reinterpret_cast<const s16x4*>(p1); return (bf16x8){a[0], a[1], a[2], a[3], b[0], b[1], b[2], b[3]}; }

DEV void hgrn_unit(CParams& p, int u, int wg, bool fill) {
  extern __shared__ __attribute__((aligned(16))) char shm[];
  const int sl = u & 3, dir = (u >> 2) & 1, h = (u >> 3) & 7, b = u >> 6;
  const int tid = ltid(), wid = tid >> 6, lane = tid & 63, fr = lane & 15, fq = lane >> 4;
  const int dp = lane & 7, seg = lane >> 3, d0 = 16 * wid + 2 * dp;
  const float* G = dir ? p.gb : p.gf;
  bf16_t* O = dir ? p.ob : p.of;
  const int sgn = dir ? -1 : 1;
#define HG_ROW0(c_, r0_) do { if ((c_) < 4) r0_ = dir ? b * 256 + 255 - 64 * (c_) : b * 256 + 64 * (c_); \
    else r0_ = dir ? NCTX + b * 4096 + 4095 - 64 * ((c_) - 4) : NCTX + b * 4096 + 64 * ((c_) - 4); } while (0)
#define HG_LOAD(c_, G_, Q_, V_) do { int r0n_; HG_ROW0(c_, r0n_); \
    _Pragma("unroll") for (int ii = 0; ii < 8; ++ii) { const long row_ = r0n_ + sgn * (8 * seg + ii); G_[ii] = *(const f32x2*)(G + row_ * 1024 + h * 128 + d0); Q_[ii] = *(const unsigned*)(p.qh + row_ * 1024 + h * 128 + d0); } \
    { const long row_ = r0n_ + sgn * (tid >> 3); V_ = *(const u32x2*)(p.vh + row_ * 1024 + h * 128 + sl * 32 + (tid & 7) * 4); } } while (0)
  f32x4 S[2] = {{0.f, 0.f, 0.f, 0.f}, {0.f, 0.f, 0.f, 0.f}};
  float dec = 0.f;
  f32x2 g[8]; unsigned q[8]; u32x2 v;
  f32x2 gN[8]; unsigned qN[8]; u32x2 vN;
#define HG_ELEM(cn_, LATN_) do { char* bufn = shm + ((cn_) & 1) * BUF; \
    { bf16_t* VT = (bf16_t*)(bufn + O_VT); const int i = tid >> 3, e4 = (tid & 7) * 4; \
      VT[(e4 + 0) * LS + i] = (bf16_t)(v.x & 0xffff); VT[(e4 + 1) * LS + i] = (bf16_t)(v.x >> 16); VT[(e4 + 2) * LS + i] = (bf16_t)(v.y & 0xffff); VT[(e4 + 3) * LS + i] = (bf16_t)(v.y >> 16); } \
    f32x2 cp[8]; cp[0] = g[0]; \
    _Pragma("unroll") for (int ii = 1; ii < 8; ++ii) cp[ii] = cp[ii - 1] * g[ii]; \
    f32x2 inc = cp[7]; \
    _Pragma("unroll") for (int st = 8; st < 64; st <<= 1) { const float t0 = __shfl_up(inc[0], st), t1 = __shfl_up(inc[1], st); if (lane >= st) { inc[0] *= t0; inc[1] *= t1; } } \
    f32x2 off; { const float t0 = __shfl_up(inc[0], 8), t1 = __shfl_up(inc[1], 8); off[0] = lane >= 8 ? t0 : 1.f; off[1] = lane >= 8 ? t1 : 1.f; } \
    f32x2 BL, R; BL[0] = __shfl(inc[0], dp + 56); BL[1] = __shfl(inc[1], dp + 56); R[0] = __shfl(inc[0], dp + 24); R[1] = __shfl(inc[1], dp + 24); \
    const float Ri0 = __builtin_amdgcn_rcpf(fmaxf(R[0], 1e-35f)), Ri1 = __builtin_amdgcn_rcpf(fmaxf(R[1], 1e-35f)); \
    const float ebl0 = BL[0] * Ri0, ebl1 = BL[1] * Ri1; \
    const float b0s = __shfl(BL[0], fr >> 1), b1s = __shfl(BL[1], fr >> 1), r0s = __shfl(R[0], fr >> 1), r1s = __shfl(R[1], fr >> 1); \
    dec = (fr & 1) ? b1s : b0s; \
    if (LATN_) { const float er = (fr & 1) ? r1s : r0s; bf16_t* ST = (bf16_t*)(bufn + O_ST); \
      _Pragma("unroll") for (int eb = 0; eb < 2; ++eb) _Pragma("unroll") for (int j = 0; j < 4; ++j) ST[(eb * 16 + 4 * fq + j) * LQ + wid * 16 + fr] = f2bf(S[eb][j] * er); } \
    unsigned kh0[4], kh1[4]; \
    _Pragma("unroll") for (int ii = 0; ii < 8; ii += 2) { float k0v[2], k1v[2]; \
      _Pragma("unroll") for (int z = 0; z < 2; ++z) { const int i = 8 * seg + ii + z; \
        const float E0 = fminf(fmaxf(off[0] * cp[ii + z][0] * Ri0, 1e-30f), 1e30f), E1 = fminf(fmaxf(off[1] * cp[ii + z][1] * Ri1, 1e-30f), 1e30f); \
        const float Ei0 = __builtin_amdgcn_rcpf(E0), Ei1 = __builtin_amdgcn_rcpf(E1); \
        const float kt0 = (1.f - g[ii + z][0]) * Ei0, kt1 = (1.f - g[ii + z][1]) * Ei1; \
        *(unsigned*)(bufn + O_KT + qk_off(i, d0 * 2)) = cvt_pk_bf16(kt0, kt1); \
        if (LATN_) *(unsigned*)(bufn + O_QT + qk_off(i, d0 * 2)) = cvt_pk_bf16(bflo(q[ii + z]) * E0, bfhi(q[ii + z]) * E1); \
        k0v[z] = kt0 * ebl0; k1v[z] = kt1 * ebl1; } \
      kh0[ii >> 1] = cvt_pk_bf16(k0v[0], k0v[1]); kh1[ii >> 1] = cvt_pk_bf16(k1v[0], k1v[1]); } \
    *(u32x4*)(bufn + O_KHT + (d0 * LS + 8 * seg) * 2) = (u32x4){kh0[0], kh0[1], kh0[2], kh0[3]}; \
    *(u32x4*)(bufn + O_KHT + ((d0 + 1) * LS + 8 * seg) * 2) = (u32x4){kh1[0], kh1[1], kh1[2], kh1[3]}; } while (0)
#define HG_MMA(c_, LATC_) do { const char* bufc = shm + ((c_) & 1) * BUF; \
    if (LATC_) { const int tb = wid >> 1, eb = wid & 1; f32x4 P[4]; bf16x8 qt[4];        \
      _Pragma("unroll") for (int ks = 0; ks < 4; ++ks) qt[ks] = ld8(bufc + O_QT + qk_off(tb * 16 + fr, 64 * ks + 16 * fq)); \
      _Pragma("unroll") for (int sb = 0; sb < 4; ++sb) { P[sb] = (f32x4){0.f, 0.f, 0.f, 0.f}; \
        if (sb <= tb) { \
          _Pragma("unroll") for (int ks = 0; ks < 4; ++ks) { \
            const bf16x8 a = ld8(bufc + O_KT + qk_off(sb * 16 + fr, 64 * ks + 16 * fq)); \
            P[sb] = __builtin_amdgcn_mfma_f32_16x16x32_bf16(a, qt[ks], P[sb], 0, 0, 0); }        \
          if (sb == tb) { _Pragma("unroll") for (int j = 0; j < 4; ++j) P[sb][j] = (4 * fq + j <= fr) ? P[sb][j] : 0.f; } } } \
      f32x4 acc = {0.f, 0.f, 0.f, 0.f}; \
      _Pragma("unroll") for (int pr = 0; pr < 2; ++pr) {        \
        if (2 * pr <= tb) { \
          const u32x4 pw = {cvt_pk_bf16(P[2 * pr][0], P[2 * pr][1]), cvt_pk_bf16(P[2 * pr][2], P[2 * pr][3]), cvt_pk_bf16(P[2 * pr + 1][0], P[2 * pr + 1][1]), cvt_pk_bf16(P[2 * pr + 1][2], P[2 * pr + 1][3])}; \
          const char* vrow = bufc + O_VT + ((eb * 16 + fr) * LS + 32 * pr + 4 * fq) * 2; \
          acc = __builtin_amdgcn_mfma_f32_16x16x32_bf16(ld44(vrow, vrow + 32), __builtin_bit_cast(bf16x8, pw), acc, 0, 0, 0); } } \
      _Pragma("unroll") for (int ks = 0; ks < 4; ++ks) { \
        const bf16x8 a = ld8(bufc + O_ST + ((eb * 16 + fr) * LQ + 32 * ks + 8 * fq) * 2); \
        acc = __builtin_amdgcn_mfma_f32_16x16x32_bf16(a, qt[ks], acc, 0, 0, 0); } \
      int r0; HG_ROW0(c_, r0); const long row = r0 + sgn * (tb * 16 + fr) - NCTX; \
      st_bf16x4(O + row * 1024 + h * 128 + sl * 32 + eb * 16 + 4 * fq, acc); }        \
    { bf16x8 kh[2]; _Pragma("unroll") for (int ks = 0; ks < 2; ++ks) kh[ks] = ld8(bufc + O_KHT + ((wid * 16 + fr) * LS + 32 * ks + 8 * fq) * 2); \
    _Pragma("unroll") for (int eb = 0; eb < 2; ++eb) { f32x4 acc = S[eb] * dec; \
      _Pragma("unroll") for (int ks = 0; ks < 2; ++ks) { \
        const bf16x8 a = ld8(bufc + O_VT + ((eb * 16 + fr) * LS + 32 * ks + 8 * fq) * 2); \
        acc = __builtin_amdgcn_mfma_f32_16x16x32_bf16(a, kh[ks], acc, 0, 0, 0); } \
      S[eb] = acc; } } } while (0)
#define HG_STEP(c_, LATC_, LATN_, FLD_) do { HG_LOAD((c_) + 2 < 68 ? (c_) + 2 : 67, gN, qN, vN); if (fill && (c_) > 0 && (c_) <= FILL_HG) fill_store(p, wg, (c_) - 1, ((c_) - 1) & 1); \
    HG_MMA(c_, LATC_); HG_ELEM((c_) + 1, LATN_); if (fill && (c_) < FILL_HG) { fill_write(FLD_, (c_) & 1); if ((c_) + 2 < FILL_HG) fill_load(p, wg, (c_) + 2, FLD_); } __syncthreads(); \
    _Pragma("unroll") for (int ii = 0; ii < 8; ++ii) { g[ii] = gN[ii]; q[ii] = qN[ii]; } v = vN; } while (0)
  f32x4 fldA[4], fldB[4];
  if (fill && FILL_HG > 0) { fill_load(p, wg, 0, fldA); if (FILL_HG > 1) fill_load(p, wg, 1, fldB); }
  HG_LOAD(0, g, q, v);
  HG_ELEM(0, false);
  HG_LOAD(1, g, q, v);
  __syncthreads();
  HG_STEP(0, false, false, fldA); HG_STEP(1, false, false, fldB); HG_STEP(2, false, false, fldA);
  HG_STEP(3, false, true, fldB);
#pragma unroll 1
  for (int c = 4; c < 66; c += 2) { HG_STEP(c, true, true, fldA); HG_STEP(c + 1, true, true, fldB); }
  HG_STEP(66, true, true, fldA);
  HG_MMA(67, true);
  __syncthreads();
  if (fill && FILL_HG == 67) fill_store(p, wg, 66, 0);
#undef HG_ELEM
#undef HG_MMA
#undef HG_STEP
#undef HG_ROW0
#undef HG_LOAD
}
}

#define XB_TMO      128
#define XB_XCNT(j)  (256  + 64 * (j))
#define XB_XSUB(j)  (1280 + 64 * (j))
#define XB_XGEN(j)  (2304 + 64 * (j))
#define XB_TOP      3328
#define XB_TOPGEN   3392
#define XCD_BAR_WORDS 3456
#define XB_SPIN_CAP (1u << 21)

__device__ __forceinline__ unsigned xb_ld(unsigned* p)              { return __hip_atomic_load(p, __ATOMIC_RELAXED, __HIP_MEMORY_SCOPE_AGENT); }
__device__ __forceinline__ unsigned xb_add(unsigned* p, unsigned v) { return __hip_atomic_fetch_add(p, v, __ATOMIC_RELAXED, __HIP_MEMORY_SCOPE_AGENT); }
__device__ __forceinline__ unsigned xb_xcc_id() { return (unsigned)__builtin_amdgcn_s_getreg((3 << 11) | 20) & 0xFu; }
#define XB_SPIN(cond, bar) do { unsigned _sp = 0; while (cond) { __builtin_amdgcn_s_sleep(1); \
    if ((++_sp & 255u) == 0u) { if (xb_ld(&(bar)[XB_TMO])) break; if (_sp > XB_SPIN_CAP) { atomicAdd(&(bar)[XB_TMO], 1u); break; } } } } while (0)

struct XcdBarrier {
    unsigned* bar; unsigned x;
    volatile LAS unsigned* st;
};

__device__ __forceinline__ XcdBarrier xcd_barrier_post(unsigned* bar, volatile LAS unsigned* st) {
    XcdBarrier b; b.bar = bar; b.x = xb_xcc_id(); b.st = st;
    if (threadIdx.x == 0) (void)xb_add(&bar[XB_XCNT(b.x)], 1u);
    return b;
}
__device__ __forceinline__ void xcd_barrier_complete(unsigned* bar, unsigned x, unsigned& nloc, unsigned& nx) {
    const unsigned G = gridDim.x * gridDim.y * gridDim.z;
    unsigned sum, cnt, mine, sp = 0u;
    for (;;) {
        sum = 0u; cnt = 0u; mine = 0u;
#pragma unroll
        for (unsigned j = 0; j < 16; ++j) { const unsigned c = xb_ld(&bar[XB_XCNT(j)]); sum += c; cnt += (c > 0u) ? 1u : 0u; mine = (j == x) ? c : mine; }
        if (sum == G) break;
        __builtin_amdgcn_s_sleep(1);
        if ((++sp & 255u) == 0u) { if (xb_ld(&bar[XB_TMO])) break; if (sp > XB_SPIN_CAP) { atomicAdd(&bar[XB_TMO], 1u); break; } }
    }
    nloc = mine > 0u ? mine : 1u; nx = cnt > 0u ? cnt : 1u;
}

__device__ __forceinline__ void xcd_barrier(const XcdBarrier& b) {
    asm volatile("s_waitcnt vmcnt(0)" ::: "memory");
    __syncthreads();
    if (threadIdx.x == 0) {
        unsigned* bar = b.bar;
        __builtin_amdgcn_s_waitcnt(0);
        unsigned nloc = b.st[0], nx = b.st[1];
        if (nloc == 0u) { xcd_barrier_complete(bar, b.x, nloc, nx); b.st[0] = nloc; b.st[1] = nx; }
        const unsigned old = xb_add(&bar[XB_XSUB(b.x)], 1u);
        const unsigned gen = old / nloc;
        if (old + 1u == (gen + 1u) * nloc) {
            __builtin_amdgcn_fence(__ATOMIC_RELEASE, "agent");
            asm volatile("s_waitcnt vmcnt(0)" ::: "memory");
            const unsigned og = xb_add(&bar[XB_TOP], 1u);
            const unsigned tg = og / nx;
            if (og + 1u == (tg + 1u) * nx) xb_add(&bar[XB_TOPGEN], 1u);
            else XB_SPIN(xb_ld(&bar[XB_TOPGEN]) == tg, bar);
            __builtin_amdgcn_fence(__ATOMIC_ACQUIRE, "agent");
            xb_add(&bar[XB_XGEN(b.x)], 1u);
            asm volatile("s_waitcnt vmcnt(0)" ::: "memory");
        } else {
            XB_SPIN(xb_ld(&bar[XB_XGEN(b.x)]) == gen, bar);
            __builtin_amdgcn_fence(__ATOMIC_ACQUIRE, "agent");
            asm volatile("s_waitcnt vmcnt(0)" ::: "memory");
        }
    }
    __syncthreads();
}


constexpr int LDS_MAX = 160 * 1024;
constexpr int XB_LDS_OFF = LDS_MAX - 16;

__global__ void __launch_bounds__(NT, 2) k_mega(Params p) {
  extern __shared__ __attribute__((aligned(16))) char shm[];
  const int wg = blockIdx.x, nwg = gridDim.x;
  CParams* kp = KARGS;
  if (threadIdx.x == 0) *(uint4*)(shm + XB_LDS_OFF) = make_uint4(0u, 0u, 0u, 0u);
  __syncthreads();
  XcdBarrier bar = xcd_barrier_post(kp->bar, (volatile LAS unsigned*)(shm + XB_LDS_OFF));
  phase0(*launder(kp), wg, nwg);
  xcd_barrier(bar);
  phase1_rows(*launder(kp), wg, nwg);
  xcd_barrier(bar);
  phase2_inproj(*launder(kp), wg, nwg);
  xcd_barrier(bar);
  phase3_rows(*launder(kp), wg, nwg);
  xcd_barrier(bar);
  phase4_up(*launder(kp), wg, nwg);
  xcd_barrier(bar);
  if (nwg == 256) {
    const int x = wg & 7, y = wg >> 3; const bool late = (y >> 2) & 1;
    if (!late) hg::hgrn_unit(*launder(kp), 4 * (x + 8 * (y >> 2)) + (y & 3), wg, true);
    phase5a_attn(*launder(kp), 16 * (2 * x + (y >> 4)) + (y & 15), wg, FILL_HG, FILL_A0);
    if (late) hg::hgrn_unit(*launder(kp), 4 * (x + 8 * (y >> 2)) + (y & 3), wg, true);
    phase5a_attn(*launder(kp), 16 * (16 + 2 * x + (y >> 4)) + (y & 15), wg, FILL_HG + FILL_A0, FILL_A1);
  } else {
    for (int u = wg; u < 256; u += nwg) hg::hgrn_unit(*launder(kp), u, wg, false);
    for (int u = wg; u < 512; u += nwg) phase5a_attn(*launder(kp), u);
  }
  xcd_barrier(bar);
  phase5c_rec(*launder(kp), wg, nwg);
  xcd_barrier(bar);
  phase6_outproj(*launder(kp), wg, nwg);
  xcd_barrier(bar);
  phase7_post<true>(*launder(kp), wg, nwg);
  xcd_barrier(bar);
  phase_moe<0>(*launder(kp), wg, nwg);
  xcd_barrier(bar);
  phase_moe<1>(*launder(kp), wg, nwg);
  xcd_barrier(bar);
  phase11_final(*launder(kp), wg, nwg);
}

static size_t carve(size_t& off, size_t bytes) { const size_t o = off; off += (bytes + 255) & ~(size_t)255; return o; }

extern "C" void kernel_launch(void* const* d_in, const int* in_sizes, int n_in, void* d_out, int out_size, void* d_ws, size_t ws_size, hipStream_t stream) {
  Params p{};
  p.x = (const float*)d_in[0]; p.c = (const float*)d_in[1]; p.ctx = (const float*)d_in[2]; p.c_ctx = (const float*)d_in[3]; p.w_mod = (const float*)d_in[4]; p.b_mod = (const float*)d_in[5];
  p.ln_mix_pre = (const float*)d_in[6]; p.ln_mix_post = (const float*)d_in[7]; p.ln_ffn_pre = (const float*)d_in[8]; p.ln_ffn_post = (const float*)d_in[9]; p.w_in = (const float*)d_in[10];
  p.q_norm = (const float*)d_in[11]; p.kv_norm = (const float*)d_in[12]; p.w_uq = (const float*)d_in[13]; p.w_ukv = (const float*)d_in[14]; p.hgrn_lb = (const float*)d_in[15];
  p.g_norm = (const float*)d_in[16]; p.w_out = (const float*)d_in[17]; p.router_w = (const float*)d_in[18]; p.router_b = (const float*)d_in[19]; p.w_gu = (const float*)d_in[20];
  p.b_gu = (const float*)d_in[21]; p.w_dn = (const float*)d_in[22]; p.b_dn = (const float*)d_in[23];
  p.out = (float*)d_out;
  char* ws = (char*)d_ws; size_t off = 0;
  p.bar = (unsigned*)(ws + carve(off, 16384));
  p.cnt = (int*)(ws + carve(off, NE * CNT_LD * 4));
  const size_t zero_bytes = off;
  p.wt_in = (bf16_t*)(ws + carve(off, (size_t)INCP * 2048 * 2)); p.wt_uq = (bf16_t*)(ws + carve(off, (size_t)1536 * 512 * 2)); p.wt_ukv = (bf16_t*)(ws + carve(off, (size_t)2048 * 256 * 2));
  p.wt_out = (bf16_t*)(ws + carve(off, (size_t)2048 * 2048 * 2)); p.wt_gu8 = (unsigned char*)(ws + carve(off, (size_t)NE * 4096 * 2048)); p.wt_dn8 = (unsigned char*)(ws + carve(off, (size_t)NE * 2048 * 2048));
  p.mod = (float*)(ws + carve(off, 5 * 12288 * 4)); p.rope = (float*)(ws + carve(off, 4096 * 64 * 4));
  p.h = (bf16_t*)(ws + carve(off, (size_t)NROW * DM * 2));
  p.cq = (bf16_t*)(ws + carve(off, (size_t)NLAT * QRANK * 2)); p.cqn = (bf16_t*)(ws + carve(off, (size_t)NLAT * QRANK * 2));
  p.ckv = (bf16_t*)(ws + carve(off, (size_t)NROW * KVRANK * 2)); p.ckvn = (bf16_t*)(ws + carve(off, (size_t)NROW * KVRANK * 2));
  p.kr = (float*)(ws + carve(off, (size_t)NROW * ROPE * 4));
  p.qh = (bf16_t*)(ws + carve(off, (size_t)NROW * 1024 * 2)); p.gf = (float*)(ws + carve(off, (size_t)NROW * 1024 * 4)); p.gb = (float*)(ws + carve(off, (size_t)NROW * 1024 * 4));
  p.vh = (bf16_t*)(ws + carve(off, (size_t)NROW * 1024 * 2)); p.gate = (bf16_t*)(ws + carve(off, (size_t)NROW * 1024 * 2));
  p.qf = (bf16_t*)(ws + carve(off, (size_t)NBATCH * NH * SEQ * QK * 2)); p.kf = (bf16_t*)(ws + carve(off, (size_t)NBATCH * NH * KEYS * QK * 2)); p.vf = (bf16_t*)(ws + carve(off, (size_t)NBATCH * NH * KEYS * DV * 2));
  p.aout = (bf16_t*)(ws + carve(off, (size_t)NLAT * DM * 2)); p.of = (bf16_t*)(ws + carve(off, (size_t)NLAT * 1024 * 2)); p.ob = (bf16_t*)(ws + carve(off, (size_t)NLAT * 1024 * 2));
  p.mix = (bf16_t*)(ws + carve(off, (size_t)NLAT * DM * 2)); p.x1 = (bf16_t*)(ws + carve(off, (size_t)NLAT * DM * 2)); p.h2_8 = (unsigned char*)(ws + carve(off, (size_t)NLAT * DM));
  p.tok_e = (int*)(ws + carve(off, (size_t)NLAT * 4 * 4)); p.tok_pos = (int*)(ws + carve(off, (size_t)NLAT * 4 * 4)); p.tok_gate = (float*)(ws + carve(off, (size_t)NLAT * 4 * 4));
  p.idx = (int*)(ws + carve(off, (size_t)NE * NLAT * 4));
  p.act8 = (unsigned char*)(ws + carve(off, (size_t)MAXSLOT * DFF)); p.ys8 = (unsigned char*)(ws + carve(off, (size_t)MAXSLOT * DM));
  if (off > ws_size) { fprintf(stderr, "kernel_launch: workspace too small: need %zu have %zu\n", off, ws_size); return; }
  static int grid = 0;
  if (!grid) {
    if (hipFuncSetAttribute((const void*)k_mega, hipFuncAttributeMaxDynamicSharedMemorySize, LDS_MAX) != hipSuccess) { fprintf(stderr, "kernel_launch: hipFuncSetAttribute failed\n"); return; }
    int dev = 0, cus = 0, per_cu = 0;
    (void)hipGetDevice(&dev);
    (void)hipDeviceGetAttribute(&cus, hipDeviceAttributeMultiprocessorCount, dev);
    (void)hipOccupancyMaxActiveBlocksPerMultiprocessor(&per_cu, k_mega, NT, LDS_MAX);
    if (per_cu < 1 || cus < 1) { fprintf(stderr, "kernel_launch: occupancy query says %d blocks per CU on %d CUs\n", per_cu, cus); return; }
    grid = cus & ~15;
  }
  (void)hipMemsetAsync(ws, 0, zero_bytes, stream);
  hipLaunchKernelGGL(k_mega, dim3(grid), dim3(NT), LDS_MAX, stream, p);
  const hipError_t le = hipPeekAtLastError();
  if (le != hipSuccess) fprintf(stderr, "kernel_launch: launch failed: %s\n", hipGetErrorName(le));
}
```
